# Optimizing an MI355X kernel written in HIP

```python
import jax, jax.numpy as jnp
from jax import lax
import numpy as np

D_MODEL = 1024
BATCH = 16
SEQ = 4096
DEPTH = 4

N_BRANCHES = 4
BRANCH_WIDTH = 512
RMS_EPS = 1e-6
S5_GROUP = 16
S5_GROUPS = BRANCH_WIDTH // S5_GROUP
S5_STATE = 64
S5_DT_MIN = 1e-3
S5_DT_MAX = 1e-1
POOL_WINDOWS = (2, 4, 8, 16)
POOL_GROUP = BRANCH_WIDTH // len(POOL_WINDOWS)
SCONV_WIDTH = 3
MLSTM_HEADS = 4
MLSTM_HEAD_DIM = BRANCH_WIDTH // MLSTM_HEADS
MLSTM_CONV_WIDTH = 4
MLSTM_CHUNK = 64
MLSTM_F_BIAS_LO = 3.0
MLSTM_F_BIAS_HI = 6.0

IN_SIZES = (BRANCH_WIDTH, BRANCH_WIDTH,
            BRANCH_WIDTH, BRANCH_WIDTH,
            BRANCH_WIDTH, BRANCH_WIDTH, BRANCH_WIDTH, BRANCH_WIDTH,
            2 * BRANCH_WIDTH, BRANCH_WIDTH, BRANCH_WIDTH, MLSTM_HEADS, MLSTM_HEADS, BRANCH_WIDTH,
            N_BRANCHES * D_MODEL)
N_IN = sum(IN_SIZES)

kernel_name = 'hybrid_s5_pool_sconv_mlstm_gated_parallel'


def rms_norm(x, w):
    x32 = x.astype(jnp.float32)
    y = x32 * lax.rsqrt(jnp.mean(x32 * x32, axis=-1, keepdims=True) + RMS_EPS)
    return (y * w.astype(jnp.float32)).astype(x.dtype)


def causal_depthwise_conv(x, w):
    k_width = w.shape[0]
    s = x.shape[1]
    xp = jnp.pad(x, ((0, 0), (k_width - 1, 0), (0, 0)))
    return sum(xp[:, k:k + s, :] * w[k] for k in range(k_width))


def s5_ssm(u, a_re, a_im, log_dt, b_re, b_im, c_re, c_im, d_skip):
    bsz, s, _ = u.shape
    f32 = jnp.float32
    u32 = u.astype(f32)
    lam = lax.complex(a_re.astype(f32), a_im.astype(f32))
    dt = jnp.exp(log_dt.astype(f32))[:, None]
    a_bar = jnp.exp(lam * dt)
    b_mat = lax.complex(b_re.astype(f32), b_im.astype(f32))
    b_bar = ((a_bar - 1.0) / lam)[..., None] * b_mat
    c_mat = lax.complex(c_re.astype(f32), c_im.astype(f32))
    ug = u32.reshape(bsz, s, S5_GROUPS, S5_GROUP).astype(jnp.complex64)
    bu = jnp.einsum('bsgp,gnp->bsgn', ug, b_bar)
    a_seq = jnp.broadcast_to(a_bar, (s, S5_GROUPS, S5_STATE))

    def combine(left, right):
        a_l, x_l = left
        a_r, x_r = right
        return a_r * a_l, a_r * x_l + x_r

    def scan_one(bu_b):
        return lax.associative_scan(combine, (a_seq, bu_b), axis=0)[1]

    states = jax.vmap(scan_one)(bu)
    y = jnp.einsum('bsgn,gpn->bsgp', states, c_mat).real.reshape(bsz, s, BRANCH_WIDTH)
    y = y + d_skip.astype(f32) * u32
    return y.astype(u.dtype)


def pool_mixer(u, pool_w, pool_scale):
    bsz, s, _ = u.shape
    u32 = u.astype(jnp.float32).reshape(bsz, s, len(POOL_WINDOWS), POOL_GROUP)
    cs = jnp.cumsum(u32, axis=1)
    t = jnp.arange(1, s + 1, dtype=jnp.float32)[None, :, None]
    outs = []
    for gi, win in enumerate(POOL_WINDOWS):
        cs_g = cs[:, :, gi]
        prev = jnp.pad(cs_g, ((0, 0), (win, 0), (0, 0)))[:, :s]
        outs.append((cs_g - prev) / jnp.minimum(t, win) - u32[:, :, gi])
    pooled = jnp.stack(outs, axis=2)
    mixed = jnp.einsum('bsgc,gcd->bsgd', pooled, pool_w.astype(jnp.float32))
    return (mixed.reshape(bsz, s, BRANCH_WIDTH) * pool_scale.astype(jnp.float32)).astype(u.dtype)


def mlstm_mixer(qk, v, o_pre, i_pre, f_pre, conv_w, b_i, b_f, norm_w):
    bsz, s, _ = v.shape
    hh, dh, ll = MLSTM_HEADS, MLSTM_HEAD_DIM, MLSTM_CHUNK
    nc = s // ll
    f32 = jnp.float32
    qk = jax.nn.silu(causal_depthwise_conv(qk, conv_w)).astype(f32)
    q, k = jnp.split(qk, 2, axis=-1)
    q = q * (dh ** -0.5)

    def chunk_heads(t):
        return t.astype(f32).reshape(bsz, nc, ll, hh, dh).transpose(0, 3, 1, 2, 4)

    def chunk_gate(t):
        return t.astype(f32).reshape(bsz, nc, ll, hh).transpose(0, 3, 1, 2)

    qc, kc, vc = chunk_heads(q), chunk_heads(k), chunk_heads(v)
    i_log = chunk_gate(i_pre + b_i)
    log_f = jax.nn.log_sigmoid(chunk_gate(f_pre + b_f))
    b = jnp.cumsum(log_f, axis=-1)
    g = b[..., -1]

    a = g[..., None] - b + i_log
    m_loc = jnp.max(a, axis=-1)
    w_loc = jnp.exp(a - m_loc[..., None])
    c_loc = jnp.einsum('bhcl,bhcld,bhcle->bhcde', w_loc, kc, vc)
    n_loc = jnp.einsum('bhcl,bhcld->bhcd', w_loc, kc)

    def step(carry, inp):
        c_st, n_st, m_st = carry
        g_c, m_c, c_c, n_c = inp
        m_new = jnp.maximum(g_c + m_st, m_c)
        s_old = jnp.exp(g_c + m_st - m_new)
        s_new = jnp.exp(m_c - m_new)
        c_next = s_old[..., None, None] * c_st + s_new[..., None, None] * c_c
        n_next = s_old[..., None] * n_st + s_new[..., None] * n_c
        return (c_next, n_next, m_new), (c_st, n_st, m_st)

    init = (jnp.zeros((bsz, hh, dh, dh), f32), jnp.zeros((bsz, hh, dh), f32), jnp.zeros((bsz, hh), f32))
    xs = (jnp.moveaxis(g, 2, 0), jnp.moveaxis(m_loc, 2, 0), jnp.moveaxis(c_loc, 2, 0), jnp.moveaxis(n_loc, 2, 0))
    _, (c_prev, n_prev, m_prev) = lax.scan(step, init, xs)
    c_prev = jnp.moveaxis(c_prev, 0, 2)
    n_prev = jnp.moveaxis(n_prev, 0, 2)
    m_prev = jnp.moveaxis(m_prev, 0, 2)

    causal = jnp.tril(jnp.ones((ll, ll), dtype=bool))
    d_log = jnp.where(causal, b[..., :, None] - b[..., None, :] + i_log[..., None, :], -jnp.inf)
    e_log = b + m_prev[..., None]
    m_t = jnp.maximum(jnp.max(d_log, axis=-1), e_log)
    w_intra = jnp.exp(d_log - m_t[..., None]) * jnp.einsum('bhcld,bhcmd->bhclm', qc, kc)
    s_inter = jnp.exp(e_log - m_t)
    num = (jnp.einsum('bhclm,bhcme->bhcle', w_intra, vc)
           + s_inter[..., None] * jnp.einsum('bhcld,bhcde->bhcle', qc, c_prev))
    den = jnp.sum(w_intra, axis=-1) + s_inter * jnp.einsum('bhcld,bhcd->bhcl', qc, n_prev)
    h = num / jnp.maximum(jnp.abs(den), jnp.exp(-m_t))[..., None]
    h = h.transpose(0, 2, 3, 1, 4).reshape(bsz, s, hh, dh)
    h = h * jax.nn.sigmoid(o_pre.astype(f32)).reshape(bsz, s, hh, dh)
    h = h * lax.rsqrt(jnp.mean(h * h, axis=-1, keepdims=True) + RMS_EPS)
    return (h.reshape(bsz, s, BRANCH_WIDTH) * norm_w.astype(f32)).astype(v.dtype)


def setup_inputs(seed: int = 0) -> dict:
    key = jax.random.key(seed)
    ks = jax.random.split(key, 22)
    f32 = jnp.float32
    W, G, N, P, H = BRANCH_WIDTH, S5_GROUPS, S5_STATE, S5_GROUP, MLSTM_HEADS
    nrm = lambda k, shape: jax.random.normal(k, shape, f32)
    x = nrm(ks[0], (BATCH, SEQ, D_MODEL))
    norm_pre_w = 1.0 + 0.02 * nrm(ks[1], (DEPTH, D_MODEL))
    norm_post_w = 1.0 + 0.02 * nrm(ks[2], (DEPTH, D_MODEL))
    w_in = nrm(ks[3], (DEPTH, D_MODEL, N_IN)) * D_MODEL ** -0.5
    s5_A_re = -0.5 + 0.01 * nrm(ks[4], (DEPTH, G, N))
    s5_A_im = jnp.pi * jnp.arange(N, dtype=f32)[None, None, :] + 0.01 * nrm(ks[5], (DEPTH, G, N))
    s5_log_dt = jax.random.uniform(ks[6], (DEPTH, G), f32, float(np.log(S5_DT_MIN)), float(np.log(S5_DT_MAX)))
    s5_B_re = nrm(ks[7], (DEPTH, G, N, P)) * (2 * P) ** -0.5
    s5_B_im = nrm(ks[8], (DEPTH, G, N, P)) * (2 * P) ** -0.5
    s5_C_re = nrm(ks[9], (DEPTH, G, P, N)) * N ** -0.5
    s5_C_im = nrm(ks[10], (DEPTH, G, P, N)) * N ** -0.5
    s5_D = nrm(ks[11], (DEPTH, W))
    s5_w_glu = nrm(ks[12], (DEPTH, W, W)) * W ** -0.5
    pool_w = nrm(ks[13], (DEPTH, len(POOL_WINDOWS), POOL_GROUP, POOL_GROUP)) * POOL_GROUP ** -0.5
    pool_scale = 1.0 + 0.02 * nrm(ks[14], (DEPTH, W))
    sconv_w = nrm(ks[15], (DEPTH, SCONV_WIDTH, W)) * SCONV_WIDTH ** -0.5
    mlstm_conv_w = nrm(ks[16], (DEPTH, MLSTM_CONV_WIDTH, 2 * W)) * MLSTM_CONV_WIDTH ** -0.5
    mlstm_b_i = 0.1 * nrm(ks[17], (DEPTH, H))
    mlstm_b_f = jnp.linspace(MLSTM_F_BIAS_LO, MLSTM_F_BIAS_HI, H, dtype=f32)[None, :] + 0.01 * nrm(ks[18], (DEPTH, H))
    mlstm_norm_w = 1.0 + 0.02 * nrm(ks[19], (DEPTH, W))
    w_branch = nrm(ks[20], (DEPTH, N_BRANCHES, W, D_MODEL)) * W ** -0.5
    w_out = nrm(ks[21], (DEPTH, D_MODEL, D_MODEL)) * D_MODEL ** -0.5
    return {'x': x, 'norm_pre_w': norm_pre_w, 'norm_post_w': norm_post_w, 'w_in': w_in,
            's5_A_re': s5_A_re, 's5_A_im': s5_A_im, 's5_log_dt': s5_log_dt,
            's5_B_re': s5_B_re, 's5_B_im': s5_B_im, 's5_C_re': s5_C_re, 's5_C_im': s5_C_im,
            's5_D': s5_D, 's5_w_glu': s5_w_glu, 'pool_w': pool_w, 'pool_scale': pool_scale,
            'sconv_w': sconv_w, 'mlstm_conv_w': mlstm_conv_w, 'mlstm_b_i': mlstm_b_i,
            'mlstm_b_f': mlstm_b_f, 'mlstm_norm_w': mlstm_norm_w, 'w_branch': w_branch, 'w_out': w_out}


def reference(x, norm_pre_w, norm_post_w, w_in, s5_A_re, s5_A_im, s5_log_dt, s5_B_re, s5_B_im,
              s5_C_re, s5_C_im, s5_D, s5_w_glu, pool_w, pool_scale, sconv_w, mlstm_conv_w,
              mlstm_b_i, mlstm_b_f, mlstm_norm_w, w_branch, w_out):
    bsz, s, _ = x.shape
    split_points = np.cumsum(IN_SIZES)[:-1].tolist()
    for l in range(DEPTH):
        h = rms_norm(x, norm_pre_w[l])
        proj = h @ w_in[l]
        (s5_u, s5_z, pool_u, pool_z, sc_x, sc_b, sc_c, sc_z,
         ml_qk, ml_v, ml_o, ml_i, ml_f, ml_z, gate_pre) = jnp.split(proj, split_points, axis=-1)
        y_a = s5_ssm(s5_u, s5_A_re[l], s5_A_im[l], s5_log_dt[l], s5_B_re[l], s5_B_im[l],
                     s5_C_re[l], s5_C_im[l], s5_D[l])
        y_a = jax.nn.gelu(y_a)
        y_a = y_a * jax.nn.sigmoid(y_a @ s5_w_glu[l])
        y_b = pool_mixer(pool_u, pool_w[l], pool_scale[l])
        y_c = sc_b * causal_depthwise_conv(sc_c * sc_x, sconv_w[l])
        y_d = mlstm_mixer(ml_qk, ml_v, ml_o, ml_i, ml_f, mlstm_conv_w[l], mlstm_b_i[l],
                          mlstm_b_f[l], mlstm_norm_w[l])
        gates = jax.nn.sigmoid(gate_pre).reshape(bsz, s, N_BRANCHES, D_MODEL)
        branches = ((y_a, s5_z), (y_b, pool_z), (y_c, sc_z), (y_d, ml_z))
        merged = sum(gates[:, :, bi] * ((y * jax.nn.silu(z)) @ w_branch[l, bi])
                     for bi, (y, z) in enumerate(branches))
        out = merged @ w_out[l]
        x = x + rms_norm(out, norm_post_w[l])
    return x
```

```cpp
#include <hip/hip_runtime.h>
#include <cstdio>
#include <cstdint>

#ifndef MK_ONE_LAUNCH
#define MK_ONE_LAUNCH 0
#endif

#define GAS __attribute__((address_space(1)))
#define LAS __attribute__((address_space(3)))
typedef unsigned short bf16;
typedef short bf16x8 __attribute__((ext_vector_type(8)));
typedef short s16x4 __attribute__((ext_vector_type(4)));
typedef float f32x4 __attribute__((ext_vector_type(4)));
typedef float f32x2 __attribute__((ext_vector_type(2)));
typedef unsigned u32x4 __attribute__((ext_vector_type(4)));
typedef unsigned u32x2 __attribute__((ext_vector_type(2)));

constexpr int D = 1024, BATCH = 16, SEQ = 4096, DEPTH = 4, BW = 512, NIN = 10760, NP = 10752;
constexpr int NG = 32, NS = 64, HEADS = 4, DH = 128, CH = 64, NCH = SEQ / CH;
constexpr int HB = 8, MH = HB * SEQ;
constexpr int NPASS = BATCH / HB;
constexpr float RMS_EPS = 1e-6f;
constexpr float LOG2E = 1.4426950408889634f;

constexpr size_t MiB = 1u << 20;
constexpr size_t WS_CTL = 0, CTL_ZERO_BYTES = 1 * MiB;
constexpr size_t WS_W1T = 1 * MiB;
constexpr size_t WS_WBT = 85 * MiB;
constexpr size_t WS_WOT = 101 * MiB;
constexpr size_t WS_WGT = 109 * MiB;
constexpr size_t WS_WPT = 111 * MiB;
constexpr size_t WS_S5T = 113 * MiB;
constexpr size_t WS_E = 115 * MiB;
constexpr size_t WS_IF = 123 * MiB;
constexpr size_t WS_SSQ = 124 * MiB;
constexpr size_t WS_OSS = 126 * MiB;
constexpr size_t WS_H = 128 * MiB;
constexpr size_t WS_SEG = 192 * MiB;
constexpr size_t SEG_BYTES = (size_t)MH * BW * 2;
constexpr size_t WS_GATE = 608 * MiB;
constexpr size_t WS_POOL = 864 * MiB;
constexpr size_t WS_QKA = 896 * MiB;
constexpr size_t WS_END = 960 * MiB;
static_assert(WS_W1T + (size_t)DEPTH * NP * D * 2 <= WS_WBT && WS_SEG + 13 * SEG_BYTES <= WS_GATE && WS_GATE + 4 * (size_t)MH * D * 2 <= WS_POOL, "ws map");
constexpr size_t S5T_LAYER = 512 * 1024;
constexpr size_t S5T_A = 0, S5T_A64 = 16384, S5T_B = 32768, S5T_C = 32768 + 131072;
enum { SG_S5U = 0, SG_S5Z = 1, SG_PU = 2, SG_PZ = 3, SG_SCX = 4, SG_SCB = 5, SG_SCC = 6, SG_SCZ = 7, SG_QK = 8, SG_V = 10, SG_O = 11, SG_MZ = 12 };

constexpr int NWAVES = 8, NTHR = 512;
constexpr int LDS_BYTES = 147456;
constexpr int LDS_MISC = 143 * 1024;

__device__ __forceinline__ unsigned f2bf(float f) { unsigned u = __builtin_bit_cast(unsigned, f); return (u + 0x7fffu + ((u >> 16) & 1u)) >> 16; }
__device__ __forceinline__ float bflo(unsigned w) { return __builtin_bit_cast(float, w << 16); }
__device__ __forceinline__ float bfhi(unsigned w) { return __builtin_bit_cast(float, w & 0xffff0000u); }
typedef __bf16 bf16x2_t __attribute__((ext_vector_type(2)));
__device__ __forceinline__ unsigned cvt_pk_bf16(float lo, float hi) { const f32x2 v = {lo, hi}; const bf16x2_t r = __builtin_convertvector(v, bf16x2_t); return __builtin_bit_cast(unsigned, r); }
__device__ __forceinline__ float fsigmoid(float v) { return __builtin_amdgcn_rcpf(1.0f + __builtin_amdgcn_exp2f(-v * LOG2E)); }
__device__ __forceinline__ float fexp(float v) { return __builtin_amdgcn_exp2f(v * LOG2E); }
__device__ __forceinline__ int fresh_lane() { int l; asm volatile("v_mbcnt_lo_u32_b32 %0, -1, 0\n\tv_mbcnt_hi_u32_b32 %0, -1, %0" : "=v"(l)); return l; }
__device__ __forceinline__ float shfl_idx(float v, int src) { return __builtin_bit_cast(float, __builtin_amdgcn_ds_bpermute(src << 2, __builtin_bit_cast(int, v))); }
__device__ __forceinline__ float shfl_x(float v, int mask, int lane) { return shfl_idx(v, lane ^ mask); }
__device__ __forceinline__ float wave_sum(float v, int lane) {
#pragma unroll
    for (int o = 1; o < 64; o <<= 1) v += shfl_x(v, o, lane);
    return v;
}
#define LDS_WAIT() asm volatile("s_waitcnt lgkmcnt(0)" ::: "memory")
#define VM_WAIT() asm volatile("s_waitcnt vmcnt(0)" ::: "memory")
#define WAVE_SYNC() do { asm volatile("s_waitcnt lgkmcnt(0)" ::: "memory"); __builtin_amdgcn_wave_barrier(); } while (0)

#define XB_TMO      128
#define XB_XCNT(j)  (256  + 64 * (j))
#define XB_XSUB(j)  (1280 + 64 * (j))
#define XB_XGEN(j)  (2304 + 64 * (j))
#define XB_TOP      3328
#define XB_TOPGEN   3392
#define XCD_BAR_WORDS 3456
#define XB_SPIN_CAP (1u << 18)
__device__ __forceinline__ unsigned xb_ld(unsigned* p)              { return __hip_atomic_load(p, __ATOMIC_RELAXED, __HIP_MEMORY_SCOPE_AGENT); }
__device__ __forceinline__ unsigned xb_add(unsigned* p, unsigned v) { return __hip_atomic_fetch_add(p, v, __ATOMIC_RELAXED, __HIP_MEMORY_SCOPE_AGENT); }
__device__ __forceinline__ unsigned xb_xcc_id() { return (unsigned)__builtin_amdgcn_s_getreg((3 << 11) | 20) & 0xFu; }
#define XB_SPIN(cond, bar) do { unsigned _sp = 0; while (cond) { __builtin_amdgcn_s_sleep(1); \
    if ((++_sp & 255u) == 0u) { if (xb_ld(&(bar)[XB_TMO])) break; if (_sp > XB_SPIN_CAP) { atomicAdd(&(bar)[XB_TMO], 1u); break; } } } } while (0)
struct XcdBarrier { unsigned* bar; unsigned x; volatile LAS unsigned* st; };
__device__ __forceinline__ XcdBarrier xcd_barrier_post(unsigned* bar, volatile LAS unsigned* st) {
    XcdBarrier b; b.bar = bar; b.x = xb_xcc_id(); b.st = st;
    if (threadIdx.x == 0) (void)xb_add(&bar[XB_XCNT(b.x)], 1u);
    return b;
}
__device__ __forceinline__ void xcd_barrier_complete(unsigned* bar, unsigned x, unsigned& nloc, unsigned& nx) {
    const unsigned G = gridDim.x * gridDim.y * gridDim.z;
    unsigned sum, cnt, mine, sp = 0u;
    for (;;) {
        sum = 0u; cnt = 0u; mine = 0u;
#pragma unroll
        for (unsigned j = 0; j < 16; ++j) { const unsigned c = xb_ld(&bar[XB_XCNT(j)]); sum += c; cnt += (c > 0u) ? 1u : 0u; mine = (j == x) ? c : mine; }
        if (sum == G) break;
        __builtin_amdgcn_s_sleep(1);
        if ((++sp & 255u) == 0u) { if (xb_ld(&bar[XB_TMO])) break; if (sp > XB_SPIN_CAP) { atomicAdd(&bar[XB_TMO], 1u); break; } }
    }
    nloc = mine > 0u ? mine : 1u; nx = cnt > 0u ? cnt : 1u;
}
__device__ __forceinline__ void xcd_barrier(const XcdBarrier& b) {
    asm volatile("s_waitcnt vmcnt(0)" ::: "memory");
    __syncthreads();
    if (threadIdx.x == 0) {
        unsigned* bar = b.bar;
        __builtin_amdgcn_s_waitcnt(0);
        unsigned nloc = b.st[0], nx = b.st[1];
        if (nloc == 0u) { xcd_barrier_complete(bar, b.x, nloc, nx); b.st[0] = nloc; b.st[1] = nx; }
        const unsigned old = xb_add(&bar[XB_XSUB(b.x)], 1u);
        const unsigned gen = old / nloc;
        if (old + 1u == (gen + 1u) * nloc) {
            __builtin_amdgcn_fence(__ATOMIC_RELEASE, "agent");
            asm volatile("s_waitcnt vmcnt(0)" ::: "memory");
            const unsigned og = xb_add(&bar[XB_TOP], 1u);
            const unsigned tg = og / nx;
            if (og + 1u == (tg + 1u) * nx) xb_add(&bar[XB_TOPGEN], 1u);
            else XB_SPIN(xb_ld(&bar[XB_TOPGEN]) == tg, bar);
            __builtin_amdgcn_fence(__ATOMIC_ACQUIRE, "agent");
            xb_add(&bar[XB_XGEN(b.x)], 1u);
            asm volatile("s_waitcnt vmcnt(0)" ::: "memory");
        } else {
            XB_SPIN(xb_ld(&bar[XB_XGEN(b.x)]) == gen, bar);
            __builtin_amdgcn_fence(__ATOMIC_ACQUIRE, "agent");
            asm volatile("s_waitcnt vmcnt(0)" ::: "memory");
        }
    }
    __syncthreads();
}

namespace pg8 {
constexpr int BM = 256, BK = 64, HALF = 128, HTB = HALF * BK * 2, STAGE_BYTES = 8 * HTB, NXCD = 8, WGM = 8;
__host__ __device__ __forceinline__ int lds_byte(int r, int c) { const int st = (r >> 4) * 2 + (c >> 5), rr = r & 15, cc = c & 31, ob = rr * 64 + cc * 2; return st * 1024 + (ob ^ (((ob >> 9) & 1) << 5)); }
__host__ __device__ __forceinline__ void stage_rc(int b, int& R, int& C) { const int st = b / 1024, sb = b % 1024, swz = sb ^ (((sb >> 9) & 1) << 5); R = (st >> 1) * 16 + swz / 64; C = (st & 1) * 32 + (swz % 64) / 2; }
__host__ __device__ __forceinline__ int perm32(int rho) { const int n = rho >> 4, i = rho & 15; return 8 * (i >> 2) + 4 * n + (i & 3); }
struct Unit { int pm, pn; };
struct StaticOrder {
    int nM, nN, nwg, G, c;
    __device__ void init(int M, int N, int G_, int c_) { nM = M / BM; nN = N / BM; nwg = nM * nN; G = G_; c = c_; }
    __device__ bool next(int i, Unit& u) const {
        const long L = (long)i * G + c; if (L >= nwg) return false;
        int wgid = (int)L; { const int q = nwg / NXCD, r = nwg % NXCD, xcd = wgid % NXCD, off = wgid / NXCD; wgid = (xcd < r ? xcd * (q + 1) : r * (q + 1) + (xcd - r) * q) + off; }
        const int nig = WGM * nN, gid = wgid / nig, fm = gid * WGM, gsz = (nM - fm) < WGM ? (nM - fm) : WGM;
        u.pm = fm + ((wgid % nig) % gsz); u.pn = (wgid % nig) / gsz; return true;
    }
};
template <class Epi, int GN, int GK, int LDA, int LDB>
__device__ __forceinline__ void gemm_phase(LAS unsigned char* lds, const bf16* gA, const bf16* gBt, const int G, const int cid, const int tid, const Epi& E) {
    const int wid = __builtin_amdgcn_readfirstlane(tid >> 6), lane = tid & 63, wr = wid >> 2, wc = wid & 3, fr = lane & 15, fq = lane >> 4;
    constexpr int nt = GK / BK;
    StaticOrder S; S.init(MH, GN, G, cid);
    unsigned voffA[2], voffB[2];
#pragma unroll
    for (int i = 0; i < 2; ++i) { int R, C; stage_rc(tid * 16 + i * 8192, R, C); const int Rb = (R & ~31) + perm32(R & 31);
        voffA[i] = (unsigned)(R * LDA + C) * 2u; voffB[i] = (unsigned)(Rb * LDB + C) * 2u; }
    constexpr size_t kstep = (size_t)(BK * 2);
    constexpr size_t hstepA = (size_t)HALF * LDA * 2, hstepB = (size_t)HALF * LDB * 2;
    constexpr size_t tstepA = 2 * hstepA, tstepB = 2 * hstepB;
    const unsigned ldsw = (unsigned)wid * 1024u;
    const int aoff = lds_byte(wr * 64 + fr, fq * 8), boff = lds_byte(wc * 32 + fr, fq * 8);
#define PG8_SA(b, h) (((b) * 2 + (h)) * HTB)
#define PG8_SB(b, h) ((4 + (b) * 2 + (h)) * HTB)
#define PG8_STAGE(bufoff, gbase, voff) do { _Pragma("unroll") for (int _i = 0; _i < 2; ++_i) \
        __builtin_amdgcn_global_load_lds((const unsigned*)((const char*)(gbase) + (voff)[_i]), (LAS unsigned*)(lds + (bufoff) + ldsw + _i * 8192), 16, 0, 0); } while (0)
#define PG8_LDA(dst, b, h) do { _Pragma("unroll") for (int m = 0; m < 4; ++m) _Pragma("unroll") for (int k = 0; k < 2; ++k) dst[m][k] = *(const LAS bf16x8*)(lds + PG8_SA(b, h) + aoff + m * 2048 + k * 1024); } while (0)
#define PG8_LDB(dst, b, h) do { _Pragma("unroll") for (int n = 0; n < 2; ++n) _Pragma("unroll") for (int k = 0; k < 2; ++k) dst[n][k] = *(const LAS bf16x8*)(lds + PG8_SB(b, h) + boff + n * 2048 + k * 1024); } while (0)
#define PG8_MMA(ai, bj, At, Bt) do { __builtin_amdgcn_s_setprio(1); _Pragma("unroll") for (int m = 0; m < 4; ++m) _Pragma("unroll") for (int n = 0; n < 2; ++n) _Pragma("unroll") for (int k = 0; k < 2; ++k) \
        acc[ai][bj][m][n] = __builtin_amdgcn_mfma_f32_16x16x32_bf16(Bt[n][k], At[m][k], acc[ai][bj][m][n], 0, 0, 0); __builtin_amdgcn_s_setprio(0); } while (0)
#define PG8_WAIT_V(n) asm volatile("s_waitcnt vmcnt(" #n ")" ::: "memory")
#define PG8_WAIT_L(n) asm volatile("s_waitcnt lgkmcnt(" #n ")" ::: "memory")
#define PG8_BAR __builtin_amdgcn_s_barrier()
#define PG8_SCHED __builtin_amdgcn_sched_barrier(0)
    Unit cur, nxt; int ui = 0;
    if (!S.next(0, cur)) return;
    f32x4 acc[2][2][4][2];
#pragma unroll
    for (int a = 0; a < 2; ++a)
#pragma unroll
        for (int b = 0; b < 2; ++b)
#pragma unroll
            for (int m = 0; m < 4; ++m)
#pragma unroll
                for (int n = 0; n < 2; ++n) acc[a][b][m][n] = (f32x4){0.f, 0.f, 0.f, 0.f};
    bf16x8 At[4][2], B0[2][2], B1[2][2];
    const char* cA = (const char*)gA + (size_t)cur.pm * tstepA; const char* cB = (const char*)gBt + (size_t)cur.pn * tstepB;
    PG8_STAGE(PG8_SB(0, 0), cB, voffB); PG8_STAGE(PG8_SB(0, 1), cB + hstepB, voffB); PG8_STAGE(PG8_SA(0, 0), cA, voffA); PG8_STAGE(PG8_SA(0, 1), cA + hstepA, voffA);
    if (wr == 1) PG8_BAR;
    PG8_WAIT_V(2); PG8_BAR;
    PG8_STAGE(PG8_SB(1, 0), cB + kstep, voffB); PG8_STAGE(PG8_SA(1, 0), cA + kstep, voffA); PG8_STAGE(PG8_SB(1, 1), cB + hstepB + kstep, voffB);
    PG8_WAIT_V(6); PG8_BAR;
    for (;;) {
        const bool has_next = S.next(ui + 1, nxt);
        const char* nA = has_next ? (const char*)gA + (size_t)nxt.pm * tstepA : cA; const char* nB = has_next ? (const char*)gBt + (size_t)nxt.pn * tstepB : cB;
        for (int t = 0; t < nt; t += 2) {
            const bool last = (t == nt - 2);
            const char* a1 = cA + (size_t)(t + 1) * kstep;
            const char* a2 = last ? nA : cA + (size_t)(t + 2) * kstep; const char* b2 = last ? nB : cB + (size_t)(t + 2) * kstep;
            const char* a3 = a2 + kstep; const char* b3 = b2 + kstep;
            PG8_LDB(B0, 0, 0); PG8_LDB(B1, 0, 1); PG8_SCHED; PG8_LDA(At, 0, 0); PG8_STAGE(PG8_SA(1, 1), a1 + hstepA, voffA);
            PG8_WAIT_V(8); PG8_WAIT_L(0); PG8_BAR; PG8_MMA(0, 0, At, B0); PG8_MMA(0, 1, At, B1); PG8_BAR; PG8_SCHED;
            PG8_LDA(At, 0, 1); PG8_STAGE(PG8_SB(0, 0), b2, voffB); PG8_STAGE(PG8_SB(0, 1), b2 + hstepB, voffB); PG8_STAGE(PG8_SA(0, 0), a2, voffA);
            PG8_WAIT_V(8); PG8_WAIT_L(0); PG8_BAR; PG8_MMA(1, 0, At, B0); PG8_MMA(1, 1, At, B1); PG8_BAR; PG8_SCHED;
            PG8_LDB(B0, 1, 0); PG8_LDB(B1, 1, 1); PG8_SCHED; PG8_LDA(At, 1, 0); PG8_STAGE(PG8_SA(0, 1), a2 + hstepA, voffA);
            PG8_WAIT_V(8); PG8_WAIT_L(0); PG8_BAR; PG8_MMA(0, 0, At, B0); PG8_MMA(0, 1, At, B1); PG8_BAR; PG8_SCHED;
            PG8_LDA(At, 1, 1); PG8_STAGE(PG8_SB(1, 0), b3, voffB); PG8_STAGE(PG8_SB(1, 1), b3 + hstepB, voffB); PG8_STAGE(PG8_SA(1, 0), a3, voffA);
            PG8_WAIT_V(8); PG8_WAIT_L(0); PG8_BAR; PG8_MMA(1, 0, At, B0); PG8_MMA(1, 1, At, B1); PG8_BAR; PG8_SCHED;
        }
        if (wr == 0) PG8_BAR;
        E(acc, cur, wr, wc);
        if (!has_next) break;
#pragma unroll
        for (int a = 0; a < 2; ++a)
#pragma unroll
            for (int b = 0; b < 2; ++b)
#pragma unroll
                for (int m = 0; m < 4; ++m)
#pragma unroll
                    for (int n = 0; n < 2; ++n) acc[a][b][m][n] = (f32x4){0.f, 0.f, 0.f, 0.f};
        cur = nxt; cA = nA; cB = nB; ++ui;
        if (wr == 1) PG8_BAR;
    }
    PG8_WAIT_V(0);
    PG8_BAR;
#undef PG8_SA
#undef PG8_SB
#undef PG8_STAGE
#undef PG8_LDA
#undef PG8_LDB
#undef PG8_MMA
#undef PG8_WAIT_V
#undef PG8_WAIT_L
#undef PG8_BAR
#undef PG8_SCHED
}
}

__device__ __forceinline__ void unpack8(const u32x4 w, float (&f)[8]) {
    f[0] = bflo(w.x); f[1] = bfhi(w.x); f[2] = bflo(w.y); f[3] = bfhi(w.y); f[4] = bflo(w.z); f[5] = bfhi(w.z); f[6] = bflo(w.w); f[7] = bfhi(w.w);
}
__device__ __forceinline__ u32x4 pack8(const float (&f)[8]) {
    u32x4 w; w.x = cvt_pk_bf16(f[0], f[1]); w.y = cvt_pk_bf16(f[2], f[3]); w.z = cvt_pk_bf16(f[4], f[5]); w.w = cvt_pk_bf16(f[6], f[7]); return w;
}
__device__ __forceinline__ void acc8(const f32x4 a, const f32x4 b, float (&f)[8]) { f[0] = a[0]; f[1] = a[1]; f[2] = a[2]; f[3] = a[3]; f[4] = b[0]; f[5] = b[1]; f[6] = b[2]; f[7] = b[3]; }

#define EPI_ROWS(LD_) _Pragma("unroll") for (int ai = 0; ai < 2; ++ai) _Pragma("unroll") for (int m = 0; m < 4; ++m) _Pragma("unroll") for (int bj = 0; bj < 2; ++bj)
#define EPI_OFF(LD_) (((unsigned)(row0 + ai * 128 + m * 16) * (unsigned)(LD_) + (unsigned)(col0 + bj * 128)) * 2u)
struct EpiProj {
    bf16* seg; bf16* gate;
    template <int ACT, int LD> __device__ __forceinline__ void body(const f32x4 (&acc)[2][2][4][2], unsigned char* base, int row0, int col0) const {
        EPI_ROWS(LD) { float v[8]; acc8(acc[ai][bj][m][0], acc[ai][bj][m][1], v);
            if (ACT == 1) {
#pragma unroll
                for (int e = 0; e < 8; ++e) v[e] = v[e] * fsigmoid(v[e]); }
            if (ACT == 2) {
#pragma unroll
                for (int e = 0; e < 8; ++e) v[e] = fsigmoid(v[e]); }
            *(u32x4*)(base + EPI_OFF(LD)) = pack8(v); }
    }
    __device__ __forceinline__ void operator()(const f32x4 (&acc)[2][2][4][2], const pg8::Unit& u, int wr, int wc) const {
        const int lane_ = fresh_lane(), fr = lane_ & 15, fq = lane_ >> 4;
        const int pn = u.pn; const int row0 = u.pm * 256 + wr * 64 + fr;
        if (pn < 26) { const int sg = pn >> 1; unsigned char* base = (unsigned char*)(seg + (size_t)sg * MH * BW); const int col0 = (pn & 1) * 256 + wc * 32 + 8 * fq;
            const int act = (sg == SG_S5Z || sg == SG_PZ || sg == SG_SCZ || sg == SG_MZ) ? 1 : (sg == SG_O ? 2 : 0);
            if (act == 0) body<0, BW>(acc, base, row0, col0); else if (act == 1) body<1, BW>(acc, base, row0, col0); else body<2, BW>(acc, base, row0, col0); }
        else { const int gg = pn - 26; unsigned char* base = (unsigned char*)(gate + (size_t)(gg >> 2) * MH * D); const int col0 = (gg & 3) * 256 + wc * 32 + 8 * fq;
            body<2, D>(acc, base, row0, col0); }
    }
};
struct EpiGlu {
    const bf16* ya; bf16* io;
    __device__ __forceinline__ void operator()(const f32x4 (&acc)[2][2][4][2], const pg8::Unit& u, int wr, int wc) const {
        const int lane_ = fresh_lane(), fr = lane_ & 15, fq = lane_ >> 4;
        const int row0 = u.pm * 256 + wr * 64 + fr, col0 = u.pn * 256 + wc * 32 + 8 * fq;
        const unsigned char* yb = (const unsigned char*)ya; unsigned char* ib = (unsigned char*)io;
        EPI_ROWS(BW) { const unsigned off = EPI_OFF(BW); float v[8], y[8], z[8]; acc8(acc[ai][bj][m][0], acc[ai][bj][m][1], v);
            unpack8(*(const u32x4*)(yb + off), y); unpack8(*(const u32x4*)(ib + off), z);
#pragma unroll
            for (int e = 0; e < 8; ++e) v[e] = y[e] * fsigmoid(v[e]) * z[e];
            *(u32x4*)(ib + off) = pack8(v); }
    }
};
struct EpiPool {
    const float* scale; bf16* io;
    __device__ __forceinline__ void operator()(const f32x4 (&acc)[2][2][4][2], const pg8::Unit& u, int wr, int wc) const {
        const int lane_ = fresh_lane(), fr = lane_ & 15, fq = lane_ >> 4;
        const int row0 = u.pm * 256 + wr * 64 + fr, col0 = u.pn * 256 + wc * 32 + 8 * fq;
        unsigned char* ib = (unsigned char*)io;
        float sc[2][8];
#pragma unroll
        for (int bj = 0; bj < 2; ++bj) { const f32x4 s0 = *(const f32x4*)(scale + col0 + bj * 128), s1 = *(const f32x4*)(scale + col0 + bj * 128 + 4); acc8(s0, s1, sc[bj]); }
        EPI_ROWS(BW) { const unsigned off = EPI_OFF(BW); float v[8], z[8]; acc8(acc[ai][bj][m][0], acc[ai][bj][m][1], v);
            unpack8(*(const u32x4*)(ib + off), z);
#pragma unroll
            for (int e = 0; e < 8; ++e) v[e] = v[e] * sc[bj][e] * z[e];
            *(u32x4*)(ib + off) = pack8(v); }
    }
};
struct EpiBranch {
    const bf16* gate; bf16* merged; int first;
    __device__ __forceinline__ void operator()(const f32x4 (&acc)[2][2][4][2], const pg8::Unit& u, int wr, int wc) const {
        const int lane_ = fresh_lane(), fr = lane_ & 15, fq = lane_ >> 4;
        const int row0 = u.pm * 256 + wr * 64 + fr, col0 = u.pn * 256 + wc * 32 + 8 * fq;
        const unsigned char* gb = (const unsigned char*)gate; unsigned char* mb = (unsigned char*)merged;
        if (first) {
            EPI_ROWS(D) { const unsigned off = EPI_OFF(D); float v[8], g[8]; acc8(acc[ai][bj][m][0], acc[ai][bj][m][1], v); unpack8(*(const u32x4*)(gb + off), g);
#pragma unroll
                for (int e = 0; e < 8; ++e) v[e] = v[e] * g[e];
                *(u32x4*)(mb + off) = pack8(v); }
        } else {
            EPI_ROWS(D) { const unsigned off = EPI_OFF(D); float v[8], g[8], o[8]; acc8(acc[ai][bj][m][0], acc[ai][bj][m][1], v); unpack8(*(const u32x4*)(gb + off), g); unpack8(*(const u32x4*)(mb + off), o);
#pragma unroll
                for (int e = 0; e < 8; ++e) v[e] = o[e] + v[e] * g[e];
                *(u32x4*)(mb + off) = pack8(v); }
        }
    }
};
struct EpiOut {
    bf16* out; float* oss;
    __device__ __forceinline__ void operator()(const f32x4 (&acc)[2][2][4][2], const pg8::Unit& u, int wr, int wc) const {
        const int lane_ = fresh_lane(), fr = lane_ & 15, fq = lane_ >> 4;
        const int row0 = u.pm * 256 + wr * 64 + fr, col0 = u.pn * 256 + wc * 32 + 8 * fq;
        unsigned char* ob = (unsigned char*)out;
#pragma unroll
        for (int ai = 0; ai < 2; ++ai)
#pragma unroll
            for (int m = 0; m < 4; ++m) { const int row = row0 + ai * 128 + m * 16; float s = 0.f;
#pragma unroll
                for (int bj = 0; bj < 2; ++bj) { float v[8]; acc8(acc[ai][bj][m][0], acc[ai][bj][m][1], v);
#pragma unroll
                    for (int e = 0; e < 8; ++e) s += v[e] * v[e];
                    *(u32x4*)(ob + EPI_OFF(D)) = pack8(v); }
                s += shfl_x(s, 16, lane_); s += shfl_x(s, 32, lane_);
                if (fq == 0) oss[(unsigned)row * 16u + u.pn * 4 + wc] = s; }
    }
};

struct Args { const float* in[22]; float* out; unsigned char* ws; int ph_lo, ph_hi; };
struct Ctx { int tid, lane, wave, G, bx, vcu, gw, NGW, gt, NGT; unsigned char* ws; };
#define MAKE_CTX(c) Ctx c; do { int wv_ = wave0; asm volatile("" : "+s"(wv_)); const int t_ = wv_ * 64 + fresh_lane(); int g_ = gridDim.x, b_ = blockIdx.x; asm volatile("" : "+s"(g_), "+s"(b_)); unsigned char* w_ = a.ws; asm volatile("" : "+s"(w_)); \
    c.tid = t_; c.lane = t_ & 63; c.wave = wv_; c.G = g_; c.bx = b_; c.vcu = (g_ % 8 == 0) ? (b_ % 8) * (g_ / 8) + b_ / 8 : b_; \
    c.gw = c.vcu * NWAVES + c.wave; c.NGW = g_ * NWAVES; c.gt = c.gw * 64 + c.lane; c.NGT = c.NGW * 64; c.ws = w_; } while (0)
enum { I_X = 0, I_NPRE, I_NPOST, I_WIN, I_ARE, I_AIM, I_LDT, I_BRE, I_BIM, I_CRE, I_CIM, I_S5D, I_WGLU, I_POOLW, I_POOLS, I_SCW, I_MCW, I_MBI, I_MBF, I_MNW, I_WBR, I_WOUT };

__device__ __forceinline__ void transpose_item(const float* W, int ldw, int k0s, int n0s, bf16* WT, int ldt, int n0d, int k0d, LAS float* scr, int lane, bool zero) {
    if (!zero) {
#pragma unroll 8
        for (int i = 0; i < 32; ++i) { const int kk = 2 * i + (lane >> 5); scr[kk * 33 + (lane & 31)] = W[(size_t)(k0s + kk) * ldw + n0s + (lane & 31)]; }
    } else {
#pragma unroll 8
        for (int i = 0; i < 32; ++i) { const int kk = 2 * i + (lane >> 5); scr[kk * 33 + (lane & 31)] = 0.f; }
    }
    LDS_WAIT(); __builtin_amdgcn_wave_barrier();
    const int c = lane & 7;
#pragma unroll
    for (int j = 0; j < 4; ++j) { const int n = (lane >> 3) + 8 * j; const LAS float* s = scr + (8 * c) * 33 + n;
        u32x4 o; o.x = cvt_pk_bf16(s[0 * 33], s[1 * 33]); o.y = cvt_pk_bf16(s[2 * 33], s[3 * 33]); o.z = cvt_pk_bf16(s[4 * 33], s[5 * 33]); o.w = cvt_pk_bf16(s[6 * 33], s[7 * 33]);
        *(u32x4*)(WT + (size_t)(n0d + n) * ldt + k0d + 8 * c) = o; }
    LDS_WAIT(); __builtin_amdgcn_wave_barrier();
}
__device__ __forceinline__ void phase_prologue(const Args& a, const Ctx& c, LAS unsigned char* lds) {
    unsigned char* ws = c.ws; const int gw = c.gw, NGW = c.NGW, wave = c.wave, lane = c.lane;
    LAS float* scr = (LAS float*)(lds + wave * 16384);
    constexpr int I_W1 = DEPTH * 16 * 336, I_WB = DEPTH * 4 * 8 * 32, I_WO = DEPTH * 16 * 32, I_WG = DEPTH * 8 * 16, I_WP = DEPTH * 8 * 16;
    constexpr int NIT = I_W1 + I_WB + I_WO + I_WG + I_WP;
    for (int it = gw; it < NIT; it += NGW) {
        int r = it;
        if (r < I_W1) { const int l = r / 5376, q = r % 5376, kb = q / 336, nb = q % 336, n0d = nb * 32, n0s = n0d + (n0d >= 6144 ? 8 : 0);
            transpose_item(a.in[I_WIN] + (size_t)l * D * NIN, NIN, kb * 64, n0s, (bf16*)(ws + WS_W1T) + (size_t)l * NP * D, D, n0d, kb * 64, scr, lane, false); continue; }
        r -= I_W1;
        if (r < I_WB) { const int lb = r / 256, q = r % 256, kb = q / 32, nb = q % 32;
            transpose_item(a.in[I_WBR] + (size_t)lb * BW * D, D, kb * 64, nb * 32, (bf16*)(ws + WS_WBT) + (size_t)lb * D * BW, BW, nb * 32, kb * 64, scr, lane, false); continue; }
        r -= I_WB;
        if (r < I_WO) { const int l = r / 512, q = r % 512, kb = q / 32, nb = q % 32;
            transpose_item(a.in[I_WOUT] + (size_t)l * D * D, D, kb * 64, nb * 32, (bf16*)(ws + WS_WOT) + (size_t)l * D * D, D, nb * 32, kb * 64, scr, lane, false); continue; }
        r -= I_WO;
        if (r < I_WG) { const int l = r / 128, q = r % 128, kb = q / 16, nb = q % 16;
            transpose_item(a.in[I_WGLU] + (size_t)l * BW * BW, BW, kb * 64, nb * 32, (bf16*)(ws + WS_WGT) + (size_t)l * BW * BW, BW, nb * 32, kb * 64, scr, lane, false); continue; }
        r -= I_WG;
        { const int l = r / 128, q = r % 128, kb = q / 16, nb = q % 16, k0 = kb * 64, n0 = nb * 32, gk = k0 >> 7, gn = n0 >> 7;
            transpose_item(a.in[I_POOLW] + (size_t)(l * 4 + gk) * 128 * 128, 128, k0 & 127, n0 & 127, (bf16*)(ws + WS_WPT) + (size_t)l * BW * BW, BW, n0, k0, scr, lane, gk != gn); }
    }
    const int gt = gw * 64 + lane, NGT = NGW * 64;
    for (int i = gt; i < DEPTH * NG * NS; i += NGT) {
        const int l = i / (NG * NS), g = (i / NS) % NG, n = i % NS;
        const float lr = a.in[I_ARE][i], li = a.in[I_AIM][i], dt = __expf(a.in[I_LDT][l * NG + g]);
        const float er = __expf(lr * dt);
        const double rev = (double)li * (double)dt * 0.15915494309189535; const float fr = (float)(rev - __builtin_rint(rev));
        const float ar = er * __builtin_amdgcn_cosf(fr), ai = er * __builtin_amdgcn_sinf(fr);
        const float e64 = __expf(64.f * lr * dt);
        const double rev64 = rev * 64.0; const float fr64 = (float)(rev64 - __builtin_rint(rev64));
        const float ar64 = e64 * __builtin_amdgcn_cosf(fr64), ai64 = e64 * __builtin_amdgcn_sinf(fr64);
        unsigned char* T = ws + WS_S5T + (size_t)l * S5T_LAYER;
        ((f32x2*)(T + S5T_A))[g * NS + n] = (f32x2){ar, ai};
        ((f32x2*)(T + S5T_A64))[g * NS + n] = (f32x2){ar64, ai64};
        const float nr = ar - 1.f, ni = ai, den = 1.f / (lr * lr + li * li);
        const float cr = (nr * lr + ni * li) * den, ci = (ni * lr - nr * li) * den;
        bf16* TB = (bf16*)(T + S5T_B) + (size_t)(g * 128 + 2 * n) * 16;
        const float* Bre = a.in[I_BRE] + (size_t)i * 16; const float* Bim = a.in[I_BIM] + (size_t)i * 16;
#pragma unroll
        for (int q = 0; q < 16; ++q) { const float br = Bre[q], bi = Bim[q]; TB[q] = (bf16)f2bf(cr * br - ci * bi); TB[16 + q] = (bf16)f2bf(cr * bi + ci * br); }
        bf16* TC = (bf16*)(T + S5T_C) + (size_t)g * 16 * 128;
        const float* Cre = a.in[I_CRE] + (size_t)(l * NG + g) * 16 * NS; const float* Cim = a.in[I_CIM] + (size_t)(l * NG + g) * 16 * NS;
#pragma unroll
        for (int p = 0; p < 16; ++p) { TC[p * 128 + 2 * n] = (bf16)f2bf(Cre[p * NS + n]); TC[p * 128 + 2 * n + 1] = (bf16)f2bf(-Cim[p * NS + n]); }
    }
}

template <bool DO_RES, bool DO_H>
__device__ __forceinline__ void phase_norm(const Args& a, const Ctx& c, LAS unsigned char* lds, int layer, int pass) {
    unsigned char* ws = c.ws; const int gw = c.gw, NGW = c.NGW, lane = c.lane;
    LAS float* wif = (LAS float*)lds;
    if (DO_H) {
        const float* win = a.in[I_WIN] + (size_t)layer * D * NIN + 6144;
        for (int i = c.tid; i < 8192; i += NTHR) { const int cc = i >> 3, jj = i & 7; wif[jj * 1024 + cc] = win[(size_t)cc * NIN + jj]; }
        __syncthreads();
    }
    const float* xsrc = (DO_H && layer <= 1) ? a.in[I_X] : a.out;
    f32x4 wpre[4], wpost[4];
#pragma unroll
    for (int j = 0; j < 4; ++j) {
        wpre[j] = DO_H ? *(const f32x4*)(a.in[I_NPRE] + (size_t)layer * D + 4 * lane + 256 * j) : (f32x4){0.f, 0.f, 0.f, 0.f};
        wpost[j] = DO_RES ? *(const f32x4*)(a.in[I_NPOST] + (size_t)(DO_H ? layer - 1 : layer) * D + 4 * lane + 256 * j) : (f32x4){0.f, 0.f, 0.f, 0.f};
    }
    const bf16* OUT = (const bf16*)(ws + WS_QKA); const float* OSS = (const float*)(ws + WS_OSS);
    bf16* Hb = (bf16*)(ws + WS_H); float* IF = (float*)(ws + WS_IF);
    for (int r = gw; r < MH; r += NGW) {
        const size_t grow = (size_t)pass * MH + r;
        f32x4 v[4];
#pragma unroll
        for (int j = 0; j < 4; ++j) v[j] = *(const f32x4*)(xsrc + grow * D + 4 * lane + 256 * j);
        if (DO_RES) {
            float ss = 0.f;
#pragma unroll
            for (int j = 0; j < 4; ++j) { const f32x4 p = *(const f32x4*)(OSS + (size_t)r * 16 + 4 * j); ss += (p[0] + p[1]) + (p[2] + p[3]); }
            const float rs = __builtin_amdgcn_rsqf(ss * (1.f / D) + RMS_EPS);
#pragma unroll
            for (int j = 0; j < 4; ++j) { const u32x2 o = *(const u32x2*)(OUT + (size_t)r * D + 4 * lane + 256 * j);
                v[j][0] += bflo(o.x) * rs * wpost[j][0]; v[j][1] += bfhi(o.x) * rs * wpost[j][1]; v[j][2] += bflo(o.y) * rs * wpost[j][2]; v[j][3] += bfhi(o.y) * rs * wpost[j][3]; }
#pragma unroll
            for (int j = 0; j < 4; ++j) *(f32x4*)(a.out + grow * D + 4 * lane + 256 * j) = v[j];
        }
        if (DO_H) {
            float s = 0.f;
#pragma unroll
            for (int j = 0; j < 4; ++j) s += (v[j][0] * v[j][0] + v[j][1] * v[j][1]) + (v[j][2] * v[j][2] + v[j][3] * v[j][3]);
            const float rstd = __builtin_amdgcn_rsqf(wave_sum(s, lane) * (1.f / D) + RMS_EPS);
#pragma unroll
            for (int j = 0; j < 4; ++j) { v[j] = v[j] * rstd * wpre[j];
                u32x2 o; o.x = cvt_pk_bf16(v[j][0], v[j][1]); o.y = cvt_pk_bf16(v[j][2], v[j][3]);
                *(u32x2*)(Hb + (size_t)r * D + 4 * lane + 256 * j) = o; }
            float mine = 0.f;
#pragma unroll
            for (int jj = 0; jj < 8; ++jj) { float d = 0.f;
#pragma unroll
                for (int j = 0; j < 4; ++j) { const f32x4 w = *(const LAS f32x4*)(wif + jj * 1024 + 4 * lane + 256 * j); d += (v[j][0] * w[0] + v[j][1] * w[1]) + (v[j][2] * w[2] + v[j][3] * w[3]); }
                d = wave_sum(d, lane); mine = (lane == jj) ? d : mine; }
            if (lane < 8) IF[(size_t)r * 8 + lane] = mine;
        }
    }
    if (DO_H) __syncthreads();
}

__device__ __forceinline__ void ld8(const bf16* p, float (&f)[8]) { unpack8(*(const u32x4*)p, f); }
__device__ __forceinline__ void phase_ew(const Args& a, const Ctx& cx, int layer) {
    unsigned char* ws = cx.ws; const int gt = cx.gt, NGT = cx.NGT;
    bf16* SEG = (bf16*)(ws + WS_SEG);
    {
        bf16* QKA = (bf16*)(ws + WS_QKA); const float* cw = a.in[I_MCW] + (size_t)layer * 4 * 1024;
        for (int id = gt; id < (MH / 16) * 128; id += NGT) {
            const int cg = id & 127, run = id >> 7, c = cg * 8, r0 = run * 16;
            const bf16* src = SEG + (size_t)(SG_QK + (cg >> 6)) * MH * BW + (c & 511);
            float w[4][8];
#pragma unroll
            for (int k = 0; k < 4; ++k) { const f32x4 w0 = *(const f32x4*)(cw + k * 1024 + c), w1 = *(const f32x4*)(cw + k * 1024 + c + 4); acc8(w0, w1, w[k]); }
            const float scale = (cg < 64) ? 0.08838834764831845f : 1.0f;
            const bool halo = (r0 & (SEQ - 1)) != 0;
            float x0[8], x1[8], x2[8], x3[8];
            if (halo) { ld8(src + (size_t)(r0 - 3) * BW, x0); ld8(src + (size_t)(r0 - 2) * BW, x1); ld8(src + (size_t)(r0 - 1) * BW, x2); }
            else {
#pragma unroll
                for (int e = 0; e < 8; ++e) { x0[e] = 0.f; x1[e] = 0.f; x2[e] = 0.f; } }
#pragma unroll 4
            for (int i = 0; i < 16; ++i) {
                ld8(src + (size_t)(r0 + i) * BW, x3); float y[8];
#pragma unroll
                for (int e = 0; e < 8; ++e) { const float t = w[0][e] * x0[e] + w[1][e] * x1[e] + w[2][e] * x2[e] + w[3][e] * x3[e]; y[e] = t * fsigmoid(t) * scale; x0[e] = x1[e]; x1[e] = x2[e]; x2[e] = x3[e]; }
                *(u32x4*)(QKA + (size_t)(r0 + i) * D + c) = pack8(y);
            }
        }
    }
    {
        const float* cw = a.in[I_SCW] + (size_t)layer * 3 * BW;
        const bf16* X = SEG + (size_t)SG_SCX * MH * BW; const bf16* Bb = SEG + (size_t)SG_SCB * MH * BW; const bf16* Cc = SEG + (size_t)SG_SCC * MH * BW; bf16* Z = SEG + (size_t)SG_SCZ * MH * BW;
        for (int id = gt; id < (MH / 16) * 64; id += NGT) {
            const int cg = id & 63, run = id >> 6, c = cg * 8, r0 = run * 16;
            float w[3][8];
#pragma unroll
            for (int k = 0; k < 3; ++k) { const f32x4 w0 = *(const f32x4*)(cw + k * BW + c), w1 = *(const f32x4*)(cw + k * BW + c + 4); acc8(w0, w1, w[k]); }
            const bool halo = (r0 & (SEQ - 1)) != 0;
            float p0[8], p1[8], p2[8];
            if (halo) { float xa[8], ca[8]; ld8(X + (size_t)(r0 - 2) * BW + c, xa); ld8(Cc + (size_t)(r0 - 2) * BW + c, ca);
#pragma unroll
                for (int e = 0; e < 8; ++e) p0[e] = xa[e] * ca[e];
                ld8(X + (size_t)(r0 - 1) * BW + c, xa); ld8(Cc + (size_t)(r0 - 1) * BW + c, ca);
#pragma unroll
                for (int e = 0; e < 8; ++e) p1[e] = xa[e] * ca[e]; }
            else {
#pragma unroll
                for (int e = 0; e < 8; ++e) { p0[e] = 0.f; p1[e] = 0.f; } }
#pragma unroll 4
            for (int i = 0; i < 16; ++i) { const size_t off = (size_t)(r0 + i) * BW + c;
                float xa[8], ca[8], bb[8], zz[8], y[8]; ld8(X + off, xa); ld8(Cc + off, ca); ld8(Bb + off, bb); ld8(Z + off, zz);
#pragma unroll
                for (int e = 0; e < 8; ++e) { p2[e] = xa[e] * ca[e]; y[e] = bb[e] * (w[0][e] * p0[e] + w[1][e] * p1[e] + w[2][e] * p2[e]) * zz[e]; p0[e] = p1[e]; p1[e] = p2[e]; }
                *(u32x4*)(Z + off) = pack8(y); }
        }
    }
    {
        const bf16* U = SEG + (size_t)SG_PU * MH * BW; bf16* PO = (bf16*)(ws + WS_POOL);
        for (int id = gt; id < (MH / 32) * 64; id += NGT) {
            const int cg = id & 63, run = id >> 6, c = cg * 8, r0 = run * 32, win = 2 << (cg >> 4), pos0 = r0 & (SEQ - 1);
            float s[8];
#pragma unroll
            for (int e = 0; e < 8; ++e) s[e] = 0.f;
            for (int j = 1; j <= win; ++j) if (pos0 - j >= 0) { float t[8]; ld8(U + (size_t)(r0 - j) * BW + c, t);
#pragma unroll
                for (int e = 0; e < 8; ++e) s[e] += t[e]; }
            for (int i = 0; i < 32; ++i) { const int pos = pos0 + i; const size_t off = (size_t)(r0 + i) * BW + c;
                float cur[8], old[8], y[8]; ld8(U + off, cur);
                if (pos - win >= 0) ld8(U + off - (size_t)win * BW, old); else {
#pragma unroll
                    for (int e = 0; e < 8; ++e) old[e] = 0.f; }
                const int cnt = (pos + 1 < win) ? pos + 1 : win; const float inv = 1.0f / (float)cnt;
#pragma unroll
                for (int e = 0; e < 8; ++e) { s[e] += cur[e] - old[e]; y[e] = s[e] * inv - cur[e]; }
                *(u32x4*)(PO + off) = pack8(y); }
        }
    }
}
__device__ __forceinline__ void phase_ydfix(const Args& a, const Ctx& cx, int layer) {
    unsigned char* ws = cx.ws; const int gt = cx.gt, NGT = cx.NGT; bf16* SEG = (bf16*)(ws + WS_SEG);
    const bf16* HG = SEG + (size_t)SG_O * MH * BW; bf16* Z = SEG + (size_t)SG_MZ * MH * BW; const float* SSQ = (const float*)(ws + WS_SSQ); const float* nw = a.in[I_MNW] + (size_t)layer * BW;
    for (int id = gt; id < MH * 64; id += NGT) {
        const int cg = id & 63, r = id >> 6, c = cg * 8, hd = cg >> 4;
        const f32x4 q = *(const f32x4*)(SSQ + (size_t)r * 16 + hd * 4);
        const float rs = __builtin_amdgcn_rsqf(((q[0] + q[1]) + (q[2] + q[3])) * (1.f / DH) + RMS_EPS);
        float h[8], z[8], w[8]; const size_t off = (size_t)r * BW + c; ld8(HG + off, h); ld8(Z + off, z);
        const f32x4 w0 = *(const f32x4*)(nw + c), w1 = *(const f32x4*)(nw + c + 4); acc8(w0, w1, w);
#pragma unroll
        for (int e = 0; e < 8; ++e) h[e] = h[e] * rs * w[e] * z[e];
        *(u32x4*)(Z + off) = pack8(h);
    }
}

constexpr int S5_UYS = 1040;
constexpr int S5_OFF_BU = 64 * S5_UYS;
constexpr int S5_WS = 272;
constexpr int S5_OFF_X = S5_OFF_BU + 8 * 16 * S5_WS;
static_assert(S5_OFF_X + 8 * 16 * S5_WS <= LDS_MISC, "S5 LDS");
template <bool PASS2>
__device__ __forceinline__ void phase_s5(const Args& a, const Ctx& cx, LAS unsigned char* lds, int layer) {
    unsigned char* ws = cx.ws; const int vcu = cx.vcu, G = cx.G;
    const int tid = cx.tid, wave = cx.wave, lane = cx.lane, fr = lane & 15, fq = lane >> 4;
    bf16* U = (bf16*)(ws + WS_SEG) + (size_t)SG_S5U * MH * BW;
    f32x2* E = (f32x2*)(ws + WS_E);
    const unsigned char* T = ws + WS_S5T + (size_t)layer * S5T_LAYER;
    const f32x2* TA = (const f32x2*)(T + S5T_A); const f32x2* TA64 = (const f32x2*)(T + S5T_A64);
    const bf16* TB = (const bf16*)(T + S5T_B); const bf16* TC = (const bf16*)(T + S5T_C);
    const float* Dk = a.in[I_S5D] + (size_t)layer * BW;
    LAS unsigned char* UY = lds; LAS unsigned char* BUs = lds + S5_OFF_BU + wave * 16 * S5_WS; LAS unsigned char* Xs = lds + S5_OFF_X + wave * 16 * S5_WS;
    for (int unit = vcu; unit < HB * NCH; unit += G) {
        const int b = unit / NCH, c = unit % NCH; const size_t row0 = (size_t)b * SEQ + (size_t)c * CH;
#pragma unroll
        for (int j = 0; j < 8; ++j) { const int id = tid + NTHR * j, r = id >> 6, pc = id & 63;
            *(LAS u32x4*)(UY + r * S5_UYS + pc * 16) = *(const u32x4*)(U + (row0 + r) * BW + pc * 8); }
        __syncthreads();
#pragma unroll 1
        for (int gi = 0; gi < 4; ++gi) {
            const int g = wave + 8 * gi;
            const f32x2 av = TA[g * NS + lane]; const float ar = av[0], ai = av[1];
            s16x4 Bf[8];
#pragma unroll
            for (int ct = 0; ct < 8; ++ct) Bf[ct] = *(const s16x4*)(TB + (size_t)(g * 128 + ct * 16 + fr) * 16 + fq * 4);
            float sr = 0.f, si = 0.f;
            bf16x8 Cf[4]; float dk[4];
            if (PASS2) {
#pragma unroll
                for (int s = 0; s < 4; ++s) Cf[s] = *(const bf16x8*)(TC + (size_t)(g * 16 + fr) * 128 + s * 32 + fq * 8);
#pragma unroll
                for (int r = 0; r < 4; ++r) dk[r] = Dk[g * 16 + fq * 4 + r];
                const f32x2 a64 = TA64[g * NS + lane];
                const f32x2* Eb = E + ((size_t)b * NCH * NG + g) * NS + lane;
                for (int j = 0; j < c; ++j) { const f32x2 e = Eb[(size_t)j * NG * NS]; const float nr = a64[0] * sr - a64[1] * si + e[0], ni = a64[0] * si + a64[1] * sr + e[1]; sr = nr; si = ni; }
            }
#pragma unroll 1
            for (int tb = 0; tb < 4; ++tb) {
                LAS unsigned char* up = UY + (tb * 16 + fr) * S5_UYS + (g * 16 + fq * 4) * 2;
                const s16x4 Uf = *(const LAS s16x4*)up;
#pragma unroll
                for (int ct = 0; ct < 8; ++ct) {
                    const f32x4 d = __builtin_amdgcn_mfma_f32_16x16x16bf16_1k(Bf[ct], Uf, (f32x4){0.f, 0.f, 0.f, 0.f}, 0, 0, 0);
                    u32x2 w; w.x = cvt_pk_bf16(d[0], d[1]); w.y = cvt_pk_bf16(d[2], d[3]);
                    *(LAS u32x2*)(BUs + fr * S5_WS + (ct * 16 + fq * 4) * 2) = w;
                }
                WAVE_SYNC();
#pragma unroll
                for (int t = 0; t < 16; ++t) {
                    const unsigned w = *(const LAS unsigned*)(BUs + t * S5_WS + lane * 4);
                    const float nr = ar * sr - ai * si + bflo(w), ni = ar * si + ai * sr + bfhi(w); sr = nr; si = ni;
                    if (PASS2) *(LAS unsigned*)(Xs + t * S5_WS + lane * 4) = cvt_pk_bf16(sr, si);
                }
                if (PASS2) {
                    WAVE_SYNC();
                    f32x4 y = (f32x4){0.f, 0.f, 0.f, 0.f};
#pragma unroll
                    for (int s = 0; s < 4; ++s) { const bf16x8 Xf = *(const LAS bf16x8*)(Xs + fr * S5_WS + (s * 32 + fq * 8) * 2);
                        y = __builtin_amdgcn_mfma_f32_16x16x32_bf16(Cf[s], Xf, y, 0, 0, 0); }
                    const u32x2 uw = __builtin_bit_cast(u32x2, Uf);
                    const float u0 = bflo(uw.x), u1 = bfhi(uw.x), u2 = bflo(uw.y), u3 = bfhi(uw.y);
                    float o[4] = {y[0] + dk[0] * u0, y[1] + dk[1] * u1, y[2] + dk[2] * u2, y[3] + dk[3] * u3};
#pragma unroll
                    for (int r = 0; r < 4; ++r) { const float x = o[r]; o[r] = x * fsigmoid(1.5957691216057308f * (x + 0.044715f * x * x * x)); }
                    u32x2 w; w.x = cvt_pk_bf16(o[0], o[1]); w.y = cvt_pk_bf16(o[2], o[3]);
                    *(LAS u32x2*)up = w;
                }
                WAVE_SYNC();
            }
            if (!PASS2) E[(((size_t)b * NCH + c) * NG + g) * NS + lane] = (f32x2){sr, si};
        }
        __syncthreads();
        if (PASS2) {
#pragma unroll
            for (int j = 0; j < 8; ++j) { const int id = tid + NTHR * j, r = id >> 6, pc = id & 63;
                *(u32x4*)(U + (row0 + r) * BW + pc * 8) = *(const LAS u32x4*)(UY + r * S5_UYS + pc * 16); }
            __syncthreads();
        }
    }
}

constexpr int ML_KS = 272, ML_TS = 144, ML_CS = 272;
constexpr int ML_OFF_KT = 64 * ML_KS, ML_OFF_VT = ML_OFF_KT + 128 * ML_TS, ML_OFF_VW = ML_OFF_VT + 48 * ML_TS, ML_BUF = ML_OFF_VW + 48 * ML_TS;
constexpr int ML_OFF_CS = 2 * ML_BUF, ML_CSB = 48 * ML_CS;
static_assert(ML_OFF_CS + 2 * ML_CSB <= LDS_MISC, "mLSTM LDS");
__device__ __forceinline__ float wave_incl_sum(float v, int lane) {
#pragma unroll
    for (int o = 1; o < 64; o <<= 1) { const float t = shfl_idx(v, lane - o); v = (lane >= o) ? v + t : v; }
    return v;
}
__device__ __forceinline__ float wave_incl_max(float v, int lane) {
#pragma unroll
    for (int o = 1; o < 64; o <<= 1) { const float t = shfl_idx(v, lane - o); v = (lane >= o) ? fmaxf(v, t) : v; }
    return v;
}
__device__ __forceinline__ float wave_max(float v, int lane) {
#pragma unroll
    for (int o = 1; o < 64; o <<= 1) v = fmaxf(v, shfl_x(v, o, lane));
    return v;
}
__device__ __forceinline__ void phase_mlstm(const Args& a, const Ctx& cx, LAS unsigned char* lds, int layer) {
    unsigned char* ws = cx.ws; const int vcu = cx.vcu, G = cx.G;
    const int tid = cx.tid, wave = cx.wave, lane = cx.lane, fr = lane & 15, fq = lane >> 4;
    const bf16* QKA = (const bf16*)(ws + WS_QKA); const bf16* V = (const bf16*)(ws + WS_SEG) + (size_t)SG_V * MH * BW; bf16* O = (bf16*)(ws + WS_SEG) + (size_t)SG_O * MH * BW;
    const float* IF = (const float*)(ws + WS_IF); float* SSQ = (float*)(ws + WS_SSQ);
    for (int i = tid; i < 2 * 16 * (ML_TS / 4); i += NTHR) { const int bfi = i / (16 * (ML_TS / 4)), q = i % (16 * (ML_TS / 4)), row = q / (ML_TS / 4), w = q % (ML_TS / 4);
        *(LAS unsigned*)(lds + bfi * ML_BUF + ML_OFF_VT + (32 + row) * ML_TS + w * 4) = (row == 0) ? 0x3F803F80u : 0u;
        *(LAS unsigned*)(lds + bfi * ML_BUF + ML_OFF_VW + (32 + row) * ML_TS + w * 4) = 0u; }
    for (int unit = vcu; unit < HB * 16; unit += G) {
        const int es = unit & 3, hd = (unit >> 2) & 3, b = unit >> 4; const size_t row0 = (size_t)b * SEQ;
        const float b_i = a.in[I_MBI][layer * 4 + hd], b_f = a.in[I_MBF][layer * 4 + hd];
        const int colq = hd * 128, colk = 512 + hd * 128, colv = hd * 128 + es * 32;
        for (int i = tid; i < ML_CSB / 4; i += NTHR) *(LAS unsigned*)(lds + ML_OFF_CS + i * 4) = 0u;
        u32x4 kreg[2], vreg = (u32x4){0u, 0u, 0u, 0u}; bf16x8 qcur[4], qnext[4]; u32x2 ocur[2], onext[2]; float gi, gf;
#pragma unroll
        for (int s4 = 0; s4 < 4; ++s4) { qcur[s4] = (bf16x8){0, 0, 0, 0, 0, 0, 0, 0}; qnext[s4] = qcur[s4]; }
        ocur[0] = ocur[1] = onext[0] = onext[1] = (u32x2){0u, 0u};
        float gb, gu, gpm, gg, gmloc, gwloc;
        f32x4 C[2][3];
#pragma unroll
        for (int i = 0; i < 2; ++i)
#pragma unroll
            for (int j = 0; j < 3; ++j) C[i][j] = (f32x4){0.f, 0.f, 0.f, 0.f};
        float m_prev = 0.f;
#define ML_LOAD(s_, QD, OD) do { const size_t rs_ = row0 + (size_t)(s_) * CH; \
        _Pragma("unroll") for (int j_ = 0; j_ < 2; ++j_) { const int id_ = tid + NTHR * j_, l_ = id_ & 63, pc_ = id_ >> 6; kreg[j_] = *(const u32x4*)(QKA + (rs_ + l_) * D + colk + pc_ * 8); } \
        if (tid < 256) vreg = *(const u32x4*)(V + (rs_ + lane) * BW + colv + (tid >> 6) * 8); \
        gi = IF[(rs_ + lane) * 8 + hd]; gf = IF[(rs_ + lane) * 8 + 4 + hd]; \
        if (wave < 4) { _Pragma("unroll") for (int s4 = 0; s4 < 4; ++s4) QD[s4] = *(const bf16x8*)(QKA + (rs_ + 16 * wave + fr) * D + colq + s4 * 32 + fq * 8); \
            _Pragma("unroll") for (int et = 0; et < 2; ++et) OD[et] = *(const u32x2*)(O + (rs_ + 16 * wave + fr) * BW + colv + et * 16 + fq * 4); } } while (0)
#define ML_GATES() do { const float x_ = gf + b_f; const float lf_ = fminf(x_, 0.f) - __logf(1.f + __expf(-fabsf(x_))); const float il_ = gi + b_i; \
        gb = wave_incl_sum(lf_, lane); gg = shfl_idx(gb, 63); const float a_ = gg - gb + il_; gmloc = wave_max(a_, lane); gwloc = __expf(a_ - gmloc); gu = il_ - gb; gpm = wave_incl_max(gu, lane); } while (0)
#define ML_WRITE(nb_) do { LAS unsigned char* B_ = lds + (nb_) * ML_BUF; \
        _Pragma("unroll") for (int j_ = 0; j_ < 2; ++j_) { const int pc_ = (tid + NTHR * j_) >> 6; *(LAS u32x4*)(B_ + lane * ML_KS + pc_ * 16) = kreg[j_]; \
            const unsigned kw_[4] = {kreg[j_].x, kreg[j_].y, kreg[j_].z, kreg[j_].w}; \
            _Pragma("unroll") for (int e_ = 0; e_ < 8; ++e_) *(LAS bf16*)(B_ + ML_OFF_KT + (pc_ * 8 + e_) * ML_TS + lane * 2) = (bf16)((e_ & 1) ? (kw_[e_ >> 1] >> 16) : (kw_[e_ >> 1] & 0xffffu)); } \
        if (tid < 256) { const int pc_ = tid >> 6; const unsigned vw_[4] = {vreg.x, vreg.y, vreg.z, vreg.w}; \
            _Pragma("unroll") for (int e_ = 0; e_ < 8; ++e_) { const unsigned hv_ = (e_ & 1) ? (vw_[e_ >> 1] >> 16) : (vw_[e_ >> 1] & 0xffffu); \
                *(LAS bf16*)(B_ + ML_OFF_VT + (pc_ * 8 + e_) * ML_TS + lane * 2) = (bf16)hv_; \
                *(LAS bf16*)(B_ + ML_OFF_VW + (pc_ * 8 + e_) * ML_TS + lane * 2) = (bf16)f2bf(gwloc * bflo(hv_)); } } \
        if (wave == 4) *(LAS bf16*)(B_ + ML_OFF_VW + 32 * ML_TS + lane * 2) = (bf16)f2bf(gwloc); } while (0)
        ML_LOAD(0, qcur, ocur);
        ML_GATES();
        ML_WRITE(0);
#pragma unroll 1
        for (int s = 0; s < NCH; ++s) {
            const int cb = s & 1;
            __syncthreads();
            const size_t rs = row0 + (size_t)s * CH;
            if (s + 1 < NCH) ML_LOAD(s + 1, qnext, onext);
            LAS unsigned char* Bc = lds + cb * ML_BUF; LAS unsigned char* Cc = lds + ML_OFF_CS + cb * ML_CSB; LAS unsigned char* Cn = lds + ML_OFF_CS + (cb ^ 1) * ML_CSB;
            const float elog = gb + m_prev, mt_t = fmaxf(gb + gpm, elog), sint_t = __expf(elog - mt_t), en_t = __expf(-mt_t);
            const float m_new = fmaxf(gg + m_prev, gmloc), s_old = __expf(gg + m_prev - m_new), s_new = __expf(gmloc - m_new);
            if (wave < 4) {
                const int lb = wave, l = 16 * lb + fr;
                const float bl = shfl_idx(gb, l), mt = shfl_idx(mt_t, l), sint = shfl_idx(sint_t, l), enl = shfl_idx(en_t, l);
                f32x4 numT[3];
#pragma unroll
                for (int et = 0; et < 3; ++et) numT[et] = (f32x4){0.f, 0.f, 0.f, 0.f};
#pragma unroll
                for (int pp = 0; pp < 2; ++pp) {
                    const int mb0 = 2 * pp, mb1 = mb0 + 1;
                    if (mb0 <= lb) {
                        f32x4 st0 = (f32x4){0.f, 0.f, 0.f, 0.f}, st1 = (f32x4){0.f, 0.f, 0.f, 0.f};
#pragma unroll
                        for (int s4 = 0; s4 < 4; ++s4) { const bf16x8 kf = *(const LAS bf16x8*)(Bc + (mb0 * 16 + fr) * ML_KS + (s4 * 32 + fq * 8) * 2);
                            st0 = __builtin_amdgcn_mfma_f32_16x16x32_bf16(kf, qcur[s4], st0, 0, 0, 0); }
                        if (mb1 <= lb) {
#pragma unroll
                            for (int s4 = 0; s4 < 4; ++s4) { const bf16x8 kf = *(const LAS bf16x8*)(Bc + (mb1 * 16 + fr) * ML_KS + (s4 * 32 + fq * 8) * 2);
                                st1 = __builtin_amdgcn_mfma_f32_16x16x32_bf16(kf, qcur[s4], st1, 0, 0, 0); }
                        }
                        float w0[4], w1[4];
#pragma unroll
                        for (int r = 0; r < 4; ++r) { const int m0 = mb0 * 16 + 4 * fq + r, m1 = mb1 * 16 + 4 * fq + r;
                            const float e0 = __expf(bl + shfl_idx(gu, m0) - mt) * st0[r], e1 = __expf(bl + shfl_idx(gu, m1) - mt) * st1[r];
                            w0[r] = (m0 <= l) ? e0 : 0.f; w1[r] = (m1 <= l && mb1 <= lb) ? e1 : 0.f; }
                        u32x4 wp; wp.x = cvt_pk_bf16(w0[0], w0[1]); wp.y = cvt_pk_bf16(w0[2], w0[3]); wp.z = cvt_pk_bf16(w1[0], w1[1]); wp.w = cvt_pk_bf16(w1[2], w1[3]);
                        const bf16x8 wf = __builtin_bit_cast(bf16x8, wp);
#pragma unroll
                        for (int et = 0; et < 3; ++et) {
                            const u32x2 v0 = *(const LAS u32x2*)(Bc + ML_OFF_VT + (et * 16 + fr) * ML_TS + (mb0 * 16 + 4 * fq) * 2), v1 = *(const LAS u32x2*)(Bc + ML_OFF_VT + (et * 16 + fr) * ML_TS + (mb1 * 16 + 4 * fq) * 2);
                            const u32x4 vp = (u32x4){v0.x, v0.y, v1.x, v1.y};
                            numT[et] = __builtin_amdgcn_mfma_f32_16x16x32_bf16(__builtin_bit_cast(bf16x8, vp), wf, numT[et], 0, 0, 0); }
                    }
                }
                f32x4 tot[3];
#pragma unroll
                for (int et = 0; et < 3; ++et) { f32x4 it = (f32x4){0.f, 0.f, 0.f, 0.f};
#pragma unroll
                    for (int s4 = 0; s4 < 4; ++s4) { const bf16x8 cf = *(const LAS bf16x8*)(Cc + (et * 16 + fr) * ML_CS + (s4 * 32 + fq * 8) * 2);
                        it = __builtin_amdgcn_mfma_f32_16x16x32_bf16(cf, qcur[s4], it, 0, 0, 0); }
                    tot[et] = numT[et] + it * sint; }
                const float den = shfl_idx(tot[2][0], fr);
                const float inv = 1.0f / fmaxf(fabsf(den), enl);
                float ssq = 0.f;
#pragma unroll
                for (int et = 0; et < 2; ++et) { const float h0 = tot[et][0] * inv * bflo(ocur[et].x), h1 = tot[et][1] * inv * bfhi(ocur[et].x), h2 = tot[et][2] * inv * bflo(ocur[et].y), h3 = tot[et][3] * inv * bfhi(ocur[et].y);
                    ssq += (h0 * h0 + h1 * h1) + (h2 * h2 + h3 * h3);
                    u32x2 w; w.x = cvt_pk_bf16(h0, h1); w.y = cvt_pk_bf16(h2, h3);
                    *(u32x2*)(O + (rs + l) * BW + colv + et * 16 + fq * 4) = w; }
                ssq += shfl_x(ssq, 16, lane); ssq += shfl_x(ssq, 32, lane);
                if (fq == 0) SSQ[(rs + l) * 16 + hd * 4 + es] = ssq;
            } else {
                const int jw = wave - 4;
#pragma unroll
                for (int dti = 0; dti < 2; ++dti) { const int dt = 2 * jw + dti;
                    bf16x8 ktf[2];
#pragma unroll
                    for (int s2 = 0; s2 < 2; ++s2) ktf[s2] = *(const LAS bf16x8*)(Bc + ML_OFF_KT + (dt * 16 + fr) * ML_TS + (s2 * 32 + fq * 8) * 2);
#pragma unroll
                    for (int et = 0; et < 3; ++et) { f32x4 cl = (f32x4){0.f, 0.f, 0.f, 0.f};
#pragma unroll
                        for (int s2 = 0; s2 < 2; ++s2) { const bf16x8 vwf = *(const LAS bf16x8*)(Bc + ML_OFF_VW + (et * 16 + fr) * ML_TS + (s2 * 32 + fq * 8) * 2);
                            cl = __builtin_amdgcn_mfma_f32_16x16x32_bf16(ktf[s2], vwf, cl, 0, 0, 0); }
                        C[dti][et] = C[dti][et] * s_old + cl * s_new;
                        u32x2 w; w.x = cvt_pk_bf16(C[dti][et][0], C[dti][et][1]); w.y = cvt_pk_bf16(C[dti][et][2], C[dti][et][3]);
                        *(LAS u32x2*)(Cn + (et * 16 + fr) * ML_CS + (dt * 16 + 4 * fq) * 2) = w; }
                }
            }
            m_prev = m_new;
            if (s + 1 < NCH) {
                ML_GATES();
                ML_WRITE(cb ^ 1);
#pragma unroll
                for (int s4 = 0; s4 < 4; ++s4) qcur[s4] = qnext[s4];
                ocur[0] = onext[0]; ocur[1] = onext[1];
            }
        }
        __syncthreads();
#undef ML_LOAD
#undef ML_GATES
#undef ML_WRITE
    }
}

constexpr int NPH_IT = 9, NPHASES = 1 + NPH_IT * NPASS * DEPTH;
constexpr int CW_BAR = 4096;
__global__ void __launch_bounds__(NTHR, 2) mk_fwd(Args a) {
    extern __shared__ __attribute__((aligned(16))) unsigned char lds_raw[];
    LAS unsigned char* lds = (LAS unsigned char*)lds_raw;
    const int lo = a.ph_lo, hi = a.ph_hi;
    const int wave0 = __builtin_amdgcn_readfirstlane(threadIdx.x >> 6);
    if (threadIdx.x < 16) ((LAS unsigned*)(lds + LDS_MISC))[threadIdx.x] = 0u;
    __syncthreads();
    XcdBarrier bar; bar.bar = (unsigned*)(a.ws + WS_CTL) + CW_BAR; bar.x = 0; bar.st = (volatile LAS unsigned*)(lds + LDS_MISC);
    if (hi - lo > 1) bar = xcd_barrier_post((unsigned*)(a.ws + WS_CTL) + CW_BAR, (volatile LAS unsigned*)(lds + LDS_MISC));
#define IN(k) (lo <= (k) && (k) < hi)
#define SEAM(k) do { if (IN(k) && IN((k) + 1)) xcd_barrier(bar); } while (0)
#define P_SEG(c, sg) ((bf16*)((c).ws + WS_SEG) + (size_t)(sg) * MH * BW)
    if (IN(0)) { MAKE_CTX(c); phase_prologue(a, c, lds); }
    SEAM(0);
#pragma unroll 1
    for (int it = 0; it < NPASS * DEPTH; ++it) {
        const int base = 1 + NPH_IT * it, pass = it / DEPTH, layer = it % DEPTH;
        if (hi <= base || lo >= base + NPH_IT) continue;
        if (IN(base + 0)) { MAKE_CTX(c); if (layer == 0) phase_norm<false, true>(a, c, lds, layer, pass); else phase_norm<true, true>(a, c, lds, layer, pass); }
        SEAM(base + 0);
        if (IN(base + 1)) { MAKE_CTX(c);
            EpiProj E{P_SEG(c, 0), (bf16*)(c.ws + WS_GATE)};
            pg8::gemm_phase<EpiProj, NP, D, D, D>(lds, (const bf16*)(c.ws + WS_H), (const bf16*)(c.ws + WS_W1T) + (size_t)layer * NP * D, c.G, c.bx, c.tid, E);
        }
        SEAM(base + 1);
        if (IN(base + 2)) { { MAKE_CTX(c); phase_ew(a, c, layer); } { MAKE_CTX(c); phase_s5<false>(a, c, lds, layer); } }
        SEAM(base + 2);
        if (IN(base + 3)) { MAKE_CTX(c); phase_s5<true>(a, c, lds, layer); }
        SEAM(base + 3);
        if (IN(base + 4)) { MAKE_CTX(c); phase_mlstm(a, c, lds, layer); }
        SEAM(base + 4);
        if (IN(base + 5)) {
            { MAKE_CTX(c); EpiGlu E{P_SEG(c, SG_S5U), P_SEG(c, SG_S5Z)};
              pg8::gemm_phase<EpiGlu, BW, BW, BW, BW>(lds, P_SEG(c, SG_S5U), (const bf16*)(c.ws + WS_WGT) + (size_t)layer * BW * BW, c.G, c.bx, c.tid, E); }
            { MAKE_CTX(c); EpiPool E{a.in[I_POOLS] + (size_t)layer * BW, P_SEG(c, SG_PZ)};
              pg8::gemm_phase<EpiPool, BW, BW, BW, BW>(lds, (const bf16*)(c.ws + WS_POOL), (const bf16*)(c.ws + WS_WPT) + (size_t)layer * BW * BW, c.G, c.bx, c.tid, E); }
            { MAKE_CTX(c); phase_ydfix(a, c, layer); }
        }
        SEAM(base + 5);
        if (IN(base + 6)) {
#pragma unroll 1
            for (int bi = 0; bi < 4; ++bi) { MAKE_CTX(c);
                const int sg = (bi == 0) ? SG_S5Z : (bi == 1) ? SG_PZ : (bi == 2) ? SG_SCZ : SG_MZ;
                EpiBranch E{(const bf16*)(c.ws + WS_GATE) + (size_t)bi * MH * D, P_SEG(c, SG_QK), bi == 0 ? 1 : 0};
                pg8::gemm_phase<EpiBranch, D, BW, BW, BW>(lds, P_SEG(c, sg), (const bf16*)(c.ws + WS_WBT) + (size_t)(layer * 4 + bi) * D * BW, c.G, c.bx, c.tid, E);
            }
        }
        SEAM(base + 6);
        if (IN(base + 7)) { MAKE_CTX(c);
            EpiOut E{(bf16*)(c.ws + WS_QKA), (float*)(c.ws + WS_OSS)};
            pg8::gemm_phase<EpiOut, D, D, D, D>(lds, P_SEG(c, SG_QK), (const bf16*)(c.ws + WS_WOT) + (size_t)layer * D * D, c.G, c.bx, c.tid, E);
        }
        SEAM(base + 7);
        if (layer == DEPTH - 1) {
            if (IN(base + 8)) { MAKE_CTX(c); phase_norm<true, false>(a, c, lds, layer, pass); }
            SEAM(base + 8);
        }
    }
#undef IN
#undef SEAM
}


#ifndef MK_DEBUG
#define MK_DEBUG 0
#endif
#if MK_DEBUG
__global__ void dbg_scan(const unsigned* p, size_t nwords, int is_bf16, int code, unsigned* flag) {
    bool bad = false;
    for (size_t i = (size_t)blockIdx.x * blockDim.x + threadIdx.x; i < nwords; i += (size_t)gridDim.x * blockDim.x) { const unsigned w = p[i];
        if (is_bf16) bad |= ((w & 0x7f80u) == 0x7f80u) || ((w & 0x7f800000u) == 0x7f800000u); else bad |= ((w & 0x7f800000u) == 0x7f800000u); }
    if (bad) flag[code] = 1u;
}
__global__ void dbg_fix(float* out, const float* x, size_t n, const unsigned* flag) {
    int c = 0; for (int k = 1; k < 32; ++k) if (flag[k]) { c = k; break; }
    if (c == 0) return;
    for (size_t i = (size_t)blockIdx.x * blockDim.x + threadIdx.x; i < n; i += (size_t)gridDim.x * blockDim.x) out[i] = x[i] + (float)c;
}
#endif
extern "C" void kernel_launch(void* const* d_in, const int* in_sizes, int n_in, void* d_out, int out_size, void* d_ws, size_t ws_size, hipStream_t stream) {
    static int grid = 0;
    if (grid == 0) {
        if (n_in != 22 || in_sizes[0] != BATCH * SEQ * D || out_size != BATCH * SEQ * D || ws_size < WS_END) {
            fprintf(stderr, "kernel_launch: unexpected shapes (n_in %d, in0 %d, out %d, ws %zu, need %zu); nothing launched\n", n_in, n_in > 0 ? in_sizes[0] : -1, out_size, ws_size, (size_t)WS_END); grid = -1; return; }
        int dev = 0, cus = 0, per_cu = 0;
        if (hipGetDevice(&dev) != hipSuccess || hipDeviceGetAttribute(&cus, hipDeviceAttributeMultiprocessorCount, dev) != hipSuccess) { grid = -1; return; }
        if (hipFuncSetAttribute((const void*)mk_fwd, hipFuncAttributeMaxDynamicSharedMemorySize, LDS_BYTES) != hipSuccess) { fprintf(stderr, "kernel_launch: hipFuncSetAttribute failed\n"); grid = -1; return; }
        if (hipOccupancyMaxActiveBlocksPerMultiprocessor(&per_cu, (const void*)mk_fwd, NTHR, LDS_BYTES) != hipSuccess || per_cu < 1) fprintf(stderr, "kernel_launch: occupancy query reports %d\n", per_cu);
        (void)hipGetLastError();
        grid = cus;
    }
    if (grid < 0) return;
    (void)hipMemsetAsync((char*)d_ws + WS_CTL, 0, CTL_ZERO_BYTES, stream);
    Args a{};
    for (int i = 0; i < 22; ++i) a.in[i] = (const float*)d_in[i];
    a.out = (float*)d_out; a.ws = (unsigned char*)d_ws;
#if MK_ONE_LAUNCH
    a.ph_lo = 0; a.ph_hi = NPHASES;
    hipLaunchKernelGGL(mk_fwd, dim3(grid), dim3(NTHR), LDS_BYTES, stream, a);
#else
#if MK_DEBUG
    (void)hipMemsetAsync((char*)d_ws + CTL_ZERO_BYTES, 0xFF, WS_END - CTL_ZERO_BYTES, stream);
    (void)hipMemsetAsync(d_out, 0xFF, (size_t)out_size * 4, stream);
    unsigned* flag = (unsigned*)((char*)d_ws + 512 * 1024);
    unsigned char* w8 = (unsigned char*)d_ws;
#define SCAN(off, bytes, isb, code) hipLaunchKernelGGL(dbg_scan, dim3(1024), dim3(256), 0, stream, (const unsigned*)(w8 + (off)), (size_t)(bytes) / 4, isb, code, flag)
#endif
    for (int k = 0; k < NPHASES; ++k) {
        if (k > 0 && (k - 1) % NPH_IT == NPH_IT - 1 && ((k - 1) / NPH_IT) % DEPTH != DEPTH - 1) continue;
        a.ph_lo = k; a.ph_hi = k + 1;
        hipLaunchKernelGGL(mk_fwd, dim3(grid), dim3(NTHR), LDS_BYTES, stream, a);
#if MK_DEBUG
        if (k == 0) { for (int l = 0; l < DEPTH; ++l) { SCAN(WS_S5T + l * S5T_LAYER, 32768, 0, 1); SCAN(WS_S5T + l * S5T_LAYER + S5T_B, 262144, 1, 1); } }
        if (k == 3) { SCAN(WS_QKA, (size_t)MH * D * 2, 1, 2); SCAN(WS_SEG + SG_SCZ * SEG_BYTES, SEG_BYTES, 1, 3); SCAN(WS_POOL, SEG_BYTES, 1, 4); SCAN(WS_E, 8 * MiB, 0, 5); }
        if (k == 4) { SCAN(WS_SEG + SG_S5U * SEG_BYTES, SEG_BYTES, 1, 6); }
        if (k == 5) { SCAN(WS_SEG + SG_O * SEG_BYTES, SEG_BYTES, 1, 7); SCAN(WS_SSQ, (size_t)MH * 16 * 4, 0, 7); }
        if (k == 6) { SCAN(WS_SEG + SG_S5Z * SEG_BYTES, SEG_BYTES, 1, 8); SCAN(WS_SEG + SG_PZ * SEG_BYTES, SEG_BYTES, 1, 8); SCAN(WS_SEG + SG_MZ * SEG_BYTES, SEG_BYTES, 1, 8); }
        if (k == 7) { SCAN(WS_SEG + SG_QK * SEG_BYTES, 2 * SEG_BYTES, 1, 9); }
        if (k == 8) { SCAN(WS_QKA, (size_t)MH * D * 2, 1, 10); SCAN(WS_OSS, (size_t)MH * 16 * 4, 0, 10); }
#endif
    }
#if MK_DEBUG
    hipLaunchKernelGGL(dbg_scan, dim3(1024), dim3(256), 0, stream, (const unsigned*)d_out, (size_t)out_size, 0, 11, flag);
    hipLaunchKernelGGL(dbg_fix, dim3(1024), dim3(256), 0, stream, (float*)d_out, (const float*)d_in[0], (size_t)out_size, (const unsigned*)flag);
#endif
#endif
}
```

```cpp
#include <hip/hip_runtime.h>
#include <cstdio>
#include <cstdint>

#ifndef MK_ONE_LAUNCH
#define MK_ONE_LAUNCH 1
#endif

#define GAS __attribute__((address_space(1)))
#define LAS __attribute__((address_space(3)))
typedef unsigned short bf16;
typedef short bf16x8 __attribute__((ext_vector_type(8)));
typedef short s16x4 __attribute__((ext_vector_type(4)));
typedef float f32x4 __attribute__((ext_vector_type(4)));
typedef float f32x2 __attribute__((ext_vector_type(2)));
typedef unsigned u32x4 __attribute__((ext_vector_type(4)));
typedef unsigned u32x2 __attribute__((ext_vector_type(2)));

constexpr int D = 1024, BATCH = 16, SEQ = 4096, DEPTH = 4, BW = 512, NIN = 10760, NP = 10752;
constexpr int NG = 32, NS = 64, HEADS = 4, DH = 128, CH = 64, NCH = SEQ / CH;
constexpr int HB = 8, MH = HB * SEQ;
constexpr int NPASS = BATCH / HB;
constexpr float RMS_EPS = 1e-6f;
constexpr float LOG2E = 1.4426950408889634f;

constexpr size_t MiB = 1u << 20;
constexpr size_t WS_CTL = 0, CTL_ZERO_BYTES = 1 * MiB;
constexpr size_t WS_W1T = 1 * MiB;
constexpr size_t WS_WBT = 85 * MiB;
constexpr size_t WS_WOT = 101 * MiB;
constexpr size_t WS_WGT = 109 * MiB;
constexpr size_t WS_WPT = 111 * MiB;
constexpr size_t WS_S5T = 113 * MiB;
constexpr size_t WS_E = 115 * MiB;
constexpr size_t WS_IF = 123 * MiB;
constexpr size_t WS_SSQ = 124 * MiB;
constexpr size_t WS_OSS = 126 * MiB;
constexpr size_t WS_H = 128 * MiB;
constexpr size_t WS_SEG = 192 * MiB;
constexpr size_t SEG_BYTES = (size_t)MH * BW * 2;
constexpr size_t WS_GATE = 608 * MiB;
constexpr size_t WS_POOL = 864 * MiB;
constexpr size_t WS_QKA = 896 * MiB;
constexpr size_t WS_END = 960 * MiB;
static_assert(WS_W1T + (size_t)DEPTH * NP * D * 2 <= WS_WBT && WS_SEG + 13 * SEG_BYTES <= WS_GATE && WS_GATE + 4 * (size_t)MH * D * 2 <= WS_POOL, "ws map");
constexpr size_t S5T_LAYER = 512 * 1024;
constexpr size_t S5T_A = 0, S5T_A64 = 16384, S5T_B = 32768, S5T_C = 32768 + 131072;
enum { SG_S5U = 0, SG_S5Z = 1, SG_PU = 2, SG_PZ = 3, SG_SCX = 4, SG_SCB = 5, SG_SCC = 6, SG_SCZ = 7, SG_QK = 8, SG_V = 10, SG_O = 11, SG_MZ = 12 };

constexpr int NWAVES = 8, NTHR = 512;
constexpr int LDS_BYTES = 147456;
constexpr int LDS_MISC = 143 * 1024;

__device__ __forceinline__ unsigned f2bf(float f) { unsigned u = __builtin_bit_cast(unsigned, f); return (u + 0x7fffu + ((u >> 16) & 1u)) >> 16; }
__device__ __forceinline__ float bflo(unsigned w) { return __builtin_bit_cast(float, w << 16); }
__device__ __forceinline__ float bfhi(unsigned w) { return __builtin_bit_cast(float, w & 0xffff0000u); }
typedef __bf16 bf16x2_t __attribute__((ext_vector_type(2)));
__device__ __forceinline__ unsigned cvt_pk_bf16(float lo, float hi) { const f32x2 v = {lo, hi}; const bf16x2_t r = __builtin_convertvector(v, bf16x2_t); return __builtin_bit_cast(unsigned, r); }
__device__ __forceinline__ float fsigmoid(float v) { return __builtin_amdgcn_rcpf(1.0f + __builtin_amdgcn_exp2f(-v * LOG2E)); }
__device__ __forceinline__ float fexp(float v) { return __builtin_amdgcn_exp2f(v * LOG2E); }
__device__ __forceinline__ int fresh_lane() { int l; asm volatile("v_mbcnt_lo_u32_b32 %0, -1, 0\n\tv_mbcnt_hi_u32_b32 %0, -1, %0" : "=v"(l)); return l; }
__device__ __forceinline__ float shfl_idx(float v, int src) { return __builtin_bit_cast(float, __builtin_amdgcn_ds_bpermute(src << 2, __builtin_bit_cast(int, v))); }
__device__ __forceinline__ float shfl_x(float v, int mask, int lane) { return shfl_idx(v, lane ^ mask); }
__device__ __forceinline__ float wave_sum(float v, int lane) {
#pragma unroll
    for (int o = 1; o < 64; o <<= 1) v += shfl_x(v, o, lane);
    return v;
}
#define LDS_WAIT() asm volatile("s_waitcnt lgkmcnt(0)" ::: "memory")
#define VM_WAIT() asm volatile("s_waitcnt vmcnt(0)" ::: "memory")
#define WAVE_SYNC() do { asm volatile("s_waitcnt lgkmcnt(0)" ::: "memory"); __builtin_amdgcn_wave_barrier(); } while (0)

#define XB_TMO      128
#define XB_XCNT(j)  (256  + 64 * (j))
#define XB_XSUB(j)  (1280 + 64 * (j))
#define XB_XGEN(j)  (2304 + 64 * (j))
#define XB_TOP      3328
#define XB_TOPGEN   3392
#define XCD_BAR_WORDS 3456
#define XB_SPIN_CAP (1u << 18)
__device__ __forceinline__ unsigned xb_ld(unsigned* p)              { return __hip_atomic_load(p, __ATOMIC_RELAXED, __HIP_MEMORY_SCOPE_AGENT); }
__device__ __forceinline__ unsigned xb_add(unsigned* p, unsigned v) { return __hip_atomic_fetch_add(p, v, __ATOMIC_RELAXED, __HIP_MEMORY_SCOPE_AGENT); }
__device__ __forceinline__ unsigned xb_xcc_id() { return (unsigned)__builtin_amdgcn_s_getreg((3 << 11) | 20) & 0xFu; }
#define XB_SPIN(cond, bar) do { unsigned _sp = 0; while (cond) { __builtin_amdgcn_s_sleep(1); \
    if ((++_sp & 255u) == 0u) { if (xb_ld(&(bar)[XB_TMO])) break; if (_sp > XB_SPIN_CAP) { atomicAdd(&(bar)[XB_TMO], 1u); break; } } } } while (0)
struct XcdBarrier { unsigned* bar; unsigned x; volatile LAS unsigned* st; };
__device__ __forceinline__ XcdBarrier xcd_barrier_post(unsigned* bar, volatile LAS unsigned* st) {
    XcdBarrier b; b.bar = bar; b.x = xb_xcc_id(); b.st = st;
    if (threadIdx.x == 0) (void)xb_add(&bar[XB_XCNT(b.x)], 1u);
    return b;
}
__device__ __forceinline__ void xcd_barrier_complete(unsigned* bar, unsigned x, unsigned& nloc, unsigned& nx) {
    const unsigned G = gridDim.x * gridDim.y * gridDim.z;
    unsigned sum, cnt, mine, sp = 0u;
    for (;;) {
        sum = 0u; cnt = 0u; mine = 0u;
#pragma unroll
        for (unsigned j = 0; j < 16; ++j) { const unsigned c = xb_ld(&bar[XB_XCNT(j)]); sum += c; cnt += (c > 0u) ? 1u : 0u; mine = (j == x) ? c : mine; }
        if (sum == G) break;
        __builtin_amdgcn_s_sleep(1);
        if ((++sp & 255u) == 0u) { if (xb_ld(&bar[XB_TMO])) break; if (sp > XB_SPIN_CAP) { atomicAdd(&bar[XB_TMO], 1u); break; } }
    }
    nloc = mine > 0u ? mine : 1u; nx = cnt > 0u ? cnt : 1u;
}
__device__ __forceinline__ void xcd_barrier(const XcdBarrier& b) {
    asm volatile("s_waitcnt vmcnt(0)" ::: "memory");
    __syncthreads();
    if (threadIdx.x == 0) {
        unsigned* bar = b.bar;
        __builtin_amdgcn_s_waitcnt(0);
        unsigned nloc = b.st[0], nx = b.st[1];
        if (nloc == 0u) { xcd_barrier_complete(bar, b.x, nloc, nx); b.st[0] = nloc; b.st[1] = nx; }
        const unsigned old = xb_add(&bar[XB_XSUB(b.x)], 1u);
        const unsigned gen = old / nloc;
        if (old + 1u == (gen + 1u) * nloc) {
            __builtin_amdgcn_fence(__ATOMIC_RELEASE, "agent");
            asm volatile("s_waitcnt vmcnt(0)" ::: "memory");
            const unsigned og = xb_add(&bar[XB_TOP], 1u);
            const unsigned tg = og / nx;
            if (og + 1u == (tg + 1u) * nx) xb_add(&bar[XB_TOPGEN], 1u);
            else XB_SPIN(xb_ld(&bar[XB_TOPGEN]) == tg, bar);
            __builtin_amdgcn_fence(__ATOMIC_ACQUIRE, "agent");
            xb_add(&bar[XB_XGEN(b.x)], 1u);
            asm volatile("s_waitcnt vmcnt(0)" ::: "memory");
        } else {
            XB_SPIN(xb_ld(&bar[XB_XGEN(b.x)]) == gen, bar);
            __builtin_amdgcn_fence(__ATOMIC_ACQUIRE, "agent");
            asm volatile("s_waitcnt vmcnt(0)" ::: "memory");
        }
    }
    __syncthreads();
}

namespace pg8 {
constexpr int BM = 256, BK = 64, HALF = 128, HTB = HALF * BK * 2, STAGE_BYTES = 8 * HTB, NXCD = 8, WGM = 8;
__host__ __device__ __forceinline__ int lds_byte(int r, int c) { const int st = (r >> 4) * 2 + (c >> 5), rr = r & 15, cc = c & 31, ob = rr * 64 + cc * 2; return st * 1024 + (ob ^ (((ob >> 9) & 1) << 5)); }
__host__ __device__ __forceinline__ void stage_rc(int b, int& R, int& C) { const int st = b / 1024, sb = b % 1024, swz = sb ^ (((sb >> 9) & 1) << 5); R = (st >> 1) * 16 + swz / 64; C = (st & 1) * 32 + (swz % 64) / 2; }
__host__ __device__ __forceinline__ int perm32(int rho) { const int n = rho >> 4, i = rho & 15; return 8 * (i >> 2) + 4 * n + (i & 3); }
struct Unit { int pm, pn; };
struct StaticOrder {
    int nM, nN, nwg, G, c;
    __device__ void init(int M, int N, int G_, int c_) { nM = M / BM; nN = N / BM; nwg = nM * nN; G = G_; c = c_; }
    __device__ bool next(int i, Unit& u) const {
        const long L = (long)i * G + c; if (L >= nwg) return false;
        int wgid = (int)L; { const int q = nwg / NXCD, r = nwg % NXCD, xcd = wgid % NXCD, off = wgid / NXCD; wgid = (xcd < r ? xcd * (q + 1) : r * (q + 1) + (xcd - r) * q) + off; }
        const int nig = WGM * nN, gid = wgid / nig, fm = gid * WGM, gsz = (nM - fm) < WGM ? (nM - fm) : WGM;
        u.pm = fm + ((wgid % nig) % gsz); u.pn = (wgid % nig) / gsz; return true;
    }
};
template <class Epi, int GN, int GK, int LDA, int LDB>
__device__ __forceinline__ void gemm_phase(LAS unsigned char* lds, const bf16* gA, const bf16* gBt, const int G, const int cid, const int tid, const Epi& E) {
    const int wid = __builtin_amdgcn_readfirstlane(tid >> 6), lane = tid & 63, wr = wid >> 2, wc = wid & 3, fr = lane & 15, fq = lane >> 4;
    constexpr int nt = GK / BK;
    StaticOrder S; S.init(MH, GN, G, cid);
    unsigned voffA[2], voffB[2];
#pragma unroll
    for (int i = 0; i < 2; ++i) { int R, C; stage_rc(tid * 16 + i * 8192, R, C); const int Rb = (R & ~31) + perm32(R & 31);
        voffA[i] = (unsigned)(R * LDA + C) * 2u; voffB[i] = (unsigned)(Rb * LDB + C) * 2u; }
    constexpr size_t kstep = (size_t)(BK * 2);
    constexpr size_t hstepA = (size_t)HALF * LDA * 2, hstepB = (size_t)HALF * LDB * 2;
    constexpr size_t tstepA = 2 * hstepA, tstepB = 2 * hstepB;
    const unsigned ldsw = (unsigned)wid * 1024u;
    const int aoff = lds_byte(wr * 64 + fr, fq * 8), boff = lds_byte(wc * 32 + fr, fq * 8);
#define PG8_SA(b, h) (((b) * 2 + (h)) * HTB)
#define PG8_SB(b, h) ((4 + (b) * 2 + (h)) * HTB)
#define PG8_STAGE(bufoff, gbase, voff) do { _Pragma("unroll") for (int _i = 0; _i < 2; ++_i) \
        __builtin_amdgcn_global_load_lds((const unsigned*)((const char*)(gbase) + (voff)[_i]), (LAS unsigned*)(lds + (bufoff) + ldsw + _i * 8192), 16, 0, 0); } while (0)
#define PG8_LDA(dst, b, h) do { _Pragma("unroll") for (int m = 0; m < 4; ++m) _Pragma("unroll") for (int k = 0; k < 2; ++k) dst[m][k] = *(const LAS bf16x8*)(lds + PG8_SA(b, h) + aoff + m * 2048 + k * 1024); } while (0)
#define PG8_LDB(dst, b, h) do { _Pragma("unroll") for (int n = 0; n < 2; ++n) _Pragma("unroll") for (int k = 0; k < 2; ++k) dst[n][k] = *(const LAS bf16x8*)(lds + PG8_SB(b, h) + boff + n * 2048 + k * 1024); } while (0)
#define PG8_MMA(ai, bj, At, Bt) do { __builtin_amdgcn_s_setprio(1); _Pragma("unroll") for (int m = 0; m < 4; ++m) _Pragma("unroll") for (int n = 0; n < 2; ++n) _Pragma("unroll") for (int k = 0; k < 2; ++k) \
        acc[ai][bj][m][n] = __builtin_amdgcn_mfma_f32_16x16x32_bf16(Bt[n][k], At[m][k], acc[ai][bj][m][n], 0, 0, 0); __builtin_amdgcn_s_setprio(0); } while (0)
#define PG8_WAIT_V(n) asm volatile("s_waitcnt vmcnt(" #n ")" ::: "memory")
#define PG8_WAIT_L(n) asm volatile("s_waitcnt lgkmcnt(" #n ")" ::: "memory")
#define PG8_BAR __builtin_amdgcn_s_barrier()
#define PG8_SCHED __builtin_amdgcn_sched_barrier(0)
    Unit cur, nxt; int ui = 0;
    if (!S.next(0, cur)) return;
    f32x4 acc[2][2][4][2];
#pragma unroll
    for (int a = 0; a < 2; ++a)
#pragma unroll
        for (int b = 0; b < 2; ++b)
#pragma unroll
            for (int m = 0; m < 4; ++m)
#pragma unroll
                for (int n = 0; n < 2; ++n) acc[a][b][m][n] = (f32x4){0.f, 0.f, 0.f, 0.f};
    bf16x8 At[4][2], B0[2][2], B1[2][2];
    const char* cA = (const char*)gA + (size_t)cur.pm * tstepA; const char* cB = (const char*)gBt + (size_t)cur.pn * tstepB;
    PG8_STAGE(PG8_SB(0, 0), cB, voffB); PG8_STAGE(PG8_SB(0, 1), cB + hstepB, voffB); PG8_STAGE(PG8_SA(0, 0), cA, voffA); PG8_STAGE(PG8_SA(0, 1), cA + hstepA, voffA);
    if (wr == 1) PG8_BAR;
    PG8_WAIT_V(2); PG8_BAR;
    PG8_STAGE(PG8_SB(1, 0), cB + kstep, voffB); PG8_STAGE(PG8_SA(1, 0), cA + kstep, voffA); PG8_STAGE(PG8_SB(1, 1), cB + hstepB + kstep, voffB);
    PG8_WAIT_V(6); PG8_BAR;
    for (;;) {
        const bool has_next = S.next(ui + 1, nxt);
        const char* nA = has_next ? (const char*)gA + (size_t)nxt.pm * tstepA : cA; const char* nB = has_next ? (const char*)gBt + (size_t)nxt.pn * tstepB : cB;
        for (int t = 0; t < nt; t += 2) {
            const bool last = (t == nt - 2);
            const char* a1 = cA + (size_t)(t + 1) * kstep;
            const char* a2 = last ? nA : cA + (size_t)(t + 2) * kstep; const char* b2 = last ? nB : cB + (size_t)(t + 2) * kstep;
            const char* a3 = a2 + kstep; const char* b3 = b2 + kstep;
            PG8_LDB(B0, 0, 0); PG8_LDB(B1, 0, 1); PG8_SCHED; PG8_LDA(At, 0, 0); PG8_STAGE(PG8_SA(1, 1), a1 + hstepA, voffA);
            PG8_WAIT_V(8); PG8_WAIT_L(0); PG8_BAR; PG8_MMA(0, 0, At, B0); PG8_MMA(0, 1, At, B1); PG8_BAR; PG8_SCHED;
            PG8_LDA(At, 0, 1); PG8_STAGE(PG8_SB(0, 0), b2, voffB); PG8_STAGE(PG8_SB(0, 1), b2 + hstepB, voffB); PG8_STAGE(PG8_SA(0, 0), a2, voffA);
            PG8_WAIT_V(8); PG8_WAIT_L(0); PG8_BAR; PG8_MMA(1, 0, At, B0); PG8_MMA(1, 1, At, B1); PG8_BAR; PG8_SCHED;
            PG8_LDB(B0, 1, 0); PG8_LDB(B1, 1, 1); PG8_SCHED; PG8_LDA(At, 1, 0); PG8_STAGE(PG8_SA(0, 1), a2 + hstepA, voffA);
            PG8_WAIT_V(8); PG8_WAIT_L(0); PG8_BAR; PG8_MMA(0, 0, At, B0); PG8_MMA(0, 1, At, B1); PG8_BAR; PG8_SCHED;
            PG8_LDA(At, 1, 1); PG8_STAGE(PG8_SB(1, 0), b3, voffB); PG8_STAGE(PG8_SB(1, 1), b3 + hstepB, voffB); PG8_STAGE(PG8_SA(1, 0), a3, voffA);
            PG8_WAIT_V(8); PG8_WAIT_L(0); PG8_BAR; PG8_MMA(1, 0, At, B0); PG8_MMA(1, 1, At, B1); PG8_BAR; PG8_SCHED;
        }
        if (wr == 0) PG8_BAR;
        E(acc, cur, wr, wc);
        if (!has_next) break;
#pragma unroll
        for (int a = 0; a < 2; ++a)
#pragma unroll
            for (int b = 0; b < 2; ++b)
#pragma unroll
                for (int m = 0; m < 4; ++m)
#pragma unroll
                    for (int n = 0; n < 2; ++n) acc[a][b][m][n] = (f32x4){0.f, 0.f, 0.f, 0.f};
        cur = nxt; cA = nA; cB = nB; ++ui;
        if (wr == 1) PG8_BAR;
    }
    PG8_WAIT_V(0);
    PG8_BAR;
#undef PG8_SA
#undef PG8_SB
#undef PG8_STAGE
#undef PG8_LDA
#undef PG8_LDB
#undef PG8_MMA
#undef PG8_WAIT_V
#undef PG8_WAIT_L
#undef PG8_BAR
#undef PG8_SCHED
}
}

__device__ __forceinline__ void unpack8(const u32x4 w, float (&f)[8]) {
    f[0] = bflo(w.x); f[1] = bfhi(w.x); f[2] = bflo(w.y); f[3] = bfhi(w.y); f[4] = bflo(w.z); f[5] = bfhi(w.z); f[6] = bflo(w.w); f[7] = bfhi(w.w);
}
__device__ __forceinline__ u32x4 pack8(const float (&f)[8]) {
    u32x4 w; w.x = cvt_pk_bf16(f[0], f[1]); w.y = cvt_pk_bf16(f[2], f[3]); w.z = cvt_pk_bf16(f[4], f[5]); w.w = cvt_pk_bf16(f[6], f[7]); return w;
}
__device__ __forceinline__ void acc8(const f32x4 a, const f32x4 b, float (&f)[8]) { f[0] = a[0]; f[1] = a[1]; f[2] = a[2]; f[3] = a[3]; f[4] = b[0]; f[5] = b[1]; f[6] = b[2]; f[7] = b[3]; }

#define EPI_ROWS(LD_) _Pragma("unroll") for (int ai = 0; ai < 2; ++ai) _Pragma("unroll") for (int m = 0; m < 4; ++m) _Pragma("unroll") for (int bj = 0; bj < 2; ++bj)
#define EPI_OFF(LD_) (((unsigned)(row0 + ai * 128 + m * 16) * (unsigned)(LD_) + (unsigned)(col0 + bj * 128)) * 2u)
struct EpiProj {
    bf16* seg; bf16* gate;
    template <int ACT, int LD> __device__ __forceinline__ void body(const f32x4 (&acc)[2][2][4][2], unsigned char* base, int row0, int col0) const {
        EPI_ROWS(LD) { float v[8]; acc8(acc[ai][bj][m][0], acc[ai][bj][m][1], v);
            if (ACT == 1) {
#pragma unroll
                for (int e = 0; e < 8; ++e) v[e] = v[e] * fsigmoid(v[e]); }
            if (ACT == 2) {
#pragma unroll
                for (int e = 0; e < 8; ++e) v[e] = fsigmoid(v[e]); }
            *(u32x4*)(base + EPI_OFF(LD)) = pack8(v); }
    }
    __device__ __forceinline__ void operator()(const f32x4 (&acc)[2][2][4][2], const pg8::Unit& u, int wr, int wc) const {
        const int lane_ = fresh_lane(), fr = lane_ & 15, fq = lane_ >> 4;
        const int pn = u.pn; const int row0 = u.pm * 256 + wr * 64 + fr;
        if (pn < 26) { const int sg = pn >> 1; unsigned char* base = (unsigned char*)(seg + (size_t)sg * MH * BW); const int col0 = (pn & 1) * 256 + wc * 32 + 8 * fq;
            const int act = (sg == SG_S5Z || sg == SG_PZ || sg == SG_SCZ || sg == SG_MZ) ? 1 : (sg == SG_O ? 2 : 0);
            if (act == 0) body<0, BW>(acc, base, row0, col0); else if (act == 1) body<1, BW>(acc, base, row0, col0); else body<2, BW>(acc, base, row0, col0); }
        else { const int gg = pn - 26; unsigned char* base = (unsigned char*)(gate + (size_t)(gg >> 2) * MH * D); const int col0 = (gg & 3) * 256 + wc * 32 + 8 * fq;
            body<2, D>(acc, base, row0, col0); }
    }
};
struct EpiGlu {
    const bf16* ya; bf16* io;
    __device__ __forceinline__ void operator()(const f32x4 (&acc)[2][2][4][2], const pg8::Unit& u, int wr, int wc) const {
        const int lane_ = fresh_lane(), fr = lane_ & 15, fq = lane_ >> 4;
        const int row0 = u.pm * 256 + wr * 64 + fr, col0 = u.pn * 256 + wc * 32 + 8 * fq;
        const unsigned char* yb = (const unsigned char*)ya; unsigned char* ib = (unsigned char*)io;
        EPI_ROWS(BW) { const unsigned off = EPI_OFF(BW); float v[8], y[8], z[8]; acc8(acc[ai][bj][m][0], acc[ai][bj][m][1], v);
            unpack8(*(const u32x4*)(yb + off), y); unpack8(*(const u32x4*)(ib + off), z);
#pragma unroll
            for (int e = 0; e < 8; ++e) v[e] = y[e] * fsigmoid(v[e]) * z[e];
            *(u32x4*)(ib + off) = pack8(v); }
    }
};
struct EpiPool {
    const float* scale; bf16* io;
    __device__ __forceinline__ void operator()(const f32x4 (&acc)[2][2][4][2], const pg8::Unit& u, int wr, int wc) const {
        const int lane_ = fresh_lane(), fr = lane_ & 15, fq = lane_ >> 4;
        const int row0 = u.pm * 256 + wr * 64 + fr, col0 = u.pn * 256 + wc * 32 + 8 * fq;
        unsigned char* ib = (unsigned char*)io;
        float sc[2][8];
#pragma unroll
        for (int bj = 0; bj < 2; ++bj) { const f32x4 s0 = *(const f32x4*)(scale + col0 + bj * 128), s1 = *(const f32x4*)(scale + col0 + bj * 128 + 4); acc8(s0, s1, sc[bj]); }
        EPI_ROWS(BW) { const unsigned off = EPI_OFF(BW); float v[8], z[8]; acc8(acc[ai][bj][m][0], acc[ai][bj][m][1], v);
            unpack8(*(const u32x4*)(ib + off), z);
#pragma unroll
            for (int e = 0; e < 8; ++e) v[e] = v[e] * sc[bj][e] * z[e];
            *(u32x4*)(ib + off) = pack8(v); }
    }
};
struct EpiBranch {
    const bf16* gate; bf16* merged; int first;
    __device__ __forceinline__ void operator()(const f32x4 (&acc)[2][2][4][2], const pg8::Unit& u, int wr, int wc) const {
        const int lane_ = fresh_lane(), fr = lane_ & 15, fq = lane_ >> 4;
        const int row0 = u.pm * 256 + wr * 64 + fr, col0 = u.pn * 256 + wc * 32 + 8 * fq;
        const unsigned char* gb = (const unsigned char*)gate; unsigned char* mb = (unsigned char*)merged;
        if (first) {
            EPI_ROWS(D) { const unsigned off = EPI_OFF(D); float v[8], g[8]; acc8(acc[ai][bj][m][0], acc[ai][bj][m][1], v); unpack8(*(const u32x4*)(gb + off), g);
#pragma unroll
                for (int e = 0; e < 8; ++e) v[e] = v[e] * g[e];
                *(u32x4*)(mb + off) = pack8(v); }
        } else {
            EPI_ROWS(D) { const unsigned off = EPI_OFF(D); float v[8], g[8], o[8]; acc8(acc[ai][bj][m][0], acc[ai][bj][m][1], v); unpack8(*(const u32x4*)(gb + off), g); unpack8(*(const u32x4*)(mb + off), o);
#pragma unroll
                for (int e = 0; e < 8; ++e) v[e] = o[e] + v[e] * g[e];
                *(u32x4*)(mb + off) = pack8(v); }
        }
    }
};
struct EpiOut {
    bf16* out; float* oss;
    __device__ __forceinline__ void operator()(const f32x4 (&acc)[2][2][4][2], const pg8::Unit& u, int wr, int wc) const {
        const int lane_ = fresh_lane(), fr = lane_ & 15, fq = lane_ >> 4;
        const int row0 = u.pm * 256 + wr * 64 + fr, col0 = u.pn * 256 + wc * 32 + 8 * fq;
        unsigned char* ob = (unsigned char*)out;
#pragma unroll
        for (int ai = 0; ai < 2; ++ai)
#pragma unroll
            for (int m = 0; m < 4; ++m) { const int row = row0 + ai * 128 + m * 16; float s = 0.f;
#pragma unroll
                for (int bj = 0; bj < 2; ++bj) { float v[8]; acc8(acc[ai][bj][m][0], acc[ai][bj][m][1], v);
#pragma unroll
                    for (int e = 0; e < 8; ++e) s += v[e] * v[e];
                    *(u32x4*)(ob + EPI_OFF(D)) = pack8(v); }
                s += shfl_x(s, 16, lane_); s += shfl_x(s, 32, lane_);
                if (fq == 0) oss[(unsigned)row * 16u + u.pn * 4 + wc] = s; }
    }
};

struct Args { const float* in[22]; float* out; unsigned char* ws; int ph_lo, ph_hi; };
struct Ctx { int tid, lane, wave, G, bx, vcu, gw, NGW, gt, NGT; unsigned char* ws; };
#define MAKE_CTX(c) Ctx c; do { int wv_ = wave0; asm volatile("" : "+s"(wv_)); const int t_ = wv_ * 64 + fresh_lane(); int g_ = gridDim.x, b_ = blockIdx.x; asm volatile("" : "+s"(g_), "+s"(b_)); unsigned char* w_ = a.ws; asm volatile("" : "+s"(w_)); \
    c.tid = t_; c.lane = t_ & 63; c.wave = wv_; c.G = g_; c.bx = b_; c.vcu = (g_ % 8 == 0) ? (b_ % 8) * (g_ / 8) + b_ / 8 : b_; \
    c.gw = c.vcu * NWAVES + c.wave; c.NGW = g_ * NWAVES; c.gt = c.gw * 64 + c.lane; c.NGT = c.NGW * 64; c.ws = w_; } while (0)
enum { I_X = 0, I_NPRE, I_NPOST, I_WIN, I_ARE, I_AIM, I_LDT, I_BRE, I_BIM, I_CRE, I_CIM, I_S5D, I_WGLU, I_POOLW, I_POOLS, I_SCW, I_MCW, I_MBI, I_MBF, I_MNW, I_WBR, I_WOUT };

__device__ __forceinline__ void transpose_item(const float* W, int ldw, int k0s, int n0s, bf16* WT, int ldt, int n0d, int k0d, LAS float* scr, int lane, bool zero) {
    if (!zero) {
#pragma unroll 8
        for (int i = 0; i < 32; ++i) { const int kk = 2 * i + (lane >> 5); scr[kk * 33 + (lane & 31)] = W[(size_t)(k0s + kk) * ldw + n0s + (lane & 31)]; }
    } else {
#pragma unroll 8
        for (int i = 0; i < 32; ++i) { const int kk = 2 * i + (lane >> 5); scr[kk * 33 + (lane & 31)] = 0.f; }
    }
    LDS_WAIT(); __builtin_amdgcn_wave_barrier();
    const int c = lane & 7;
#pragma unroll
    for (int j = 0; j < 4; ++j) { const int n = (lane >> 3) + 8 * j; const LAS float* s = scr + (8 * c) * 33 + n;
        u32x4 o; o.x = cvt_pk_bf16(s[0 * 33], s[1 * 33]); o.y = cvt_pk_bf16(s[2 * 33], s[3 * 33]); o.z = cvt_pk_bf16(s[4 * 33], s[5 * 33]); o.w = cvt_pk_bf16(s[6 * 33], s[7 * 33]);
        *(u32x4*)(WT + (size_t)(n0d + n) * ldt + k0d + 8 * c) = o; }
    LDS_WAIT(); __builtin_amdgcn_wave_barrier();
}
__device__ __forceinline__ void phase_prologue(const Args& a, const Ctx& c, LAS unsigned char* lds) {
    unsigned char* ws = c.ws; const int gw = c.gw, NGW = c.NGW, wave = c.wave, lane = c.lane;
    LAS float* scr = (LAS float*)(lds + wave * 16384);
    constexpr int I_W1 = DEPTH * 16 * 336, I_WB = DEPTH * 4 * 8 * 32, I_WO = DEPTH * 16 * 32, I_WG = DEPTH * 8 * 16, I_WP = DEPTH * 8 * 16;
    constexpr int NIT = I_W1 + I_WB + I_WO + I_WG + I_WP;
    for (int it = gw; it < NIT; it += NGW) {
        int r = it;
        if (r < I_W1) { const int l = r / 5376, q = r % 5376, kb = q / 336, nb = q % 336, n0d = nb * 32, n0s = n0d + (n0d >= 6144 ? 8 : 0);
            transpose_item(a.in[I_WIN] + (size_t)l * D * NIN, NIN, kb * 64, n0s, (bf16*)(ws + WS_W1T) + (size_t)l * NP * D, D, n0d, kb * 64, scr, lane, false); continue; }
        r -= I_W1;
        if (r < I_WB) { const int lb = r / 256, q = r % 256, kb = q / 32, nb = q % 32;
            transpose_item(a.in[I_WBR] + (size_t)lb * BW * D, D, kb * 64, nb * 32, (bf16*)(ws + WS_WBT) + (size_t)lb * D * BW, BW, nb * 32, kb * 64, scr, lane, false); continue; }
        r -= I_WB;
        if (r < I_WO) { const int l = r / 512, q = r % 512, kb = q / 32, nb = q % 32;
            transpose_item(a.in[I_WOUT] + (size_t)l * D * D, D, kb * 64, nb * 32, (bf16*)(ws + WS_WOT) + (size_t)l * D * D, D, nb * 32, kb * 64, scr, lane, false); continue; }
        r -= I_WO;
        if (r < I_WG) { const int l = r / 128, q = r % 128, kb = q / 16, nb = q % 16;
            transpose_item(a.in[I_WGLU] + (size_t)l * BW * BW, BW, kb * 64, nb * 32, (bf16*)(ws + WS_WGT) + (size_t)l * BW * BW, BW, nb * 32, kb * 64, scr, lane, false); continue; }
        r -= I_WG;
        { const int l = r / 128, q = r % 128, kb = q / 16, nb = q % 16, k0 = kb * 64, n0 = nb * 32, gk = k0 >> 7, gn = n0 >> 7;
            transpose_item(a.in[I_POOLW] + (size_t)(l * 4 + gk) * 128 * 128, 128, k0 & 127, n0 & 127, (bf16*)(ws + WS_WPT) + (size_t)l * BW * BW, BW, n0, k0, scr, lane, gk != gn); }
    }
    const int gt = gw * 64 + lane, NGT = NGW * 64;
    for (int i = gt; i < DEPTH * NG * NS; i += NGT) {
        const int l = i / (NG * NS), g = (i / NS) % NG, n = i % NS;
        const float lr = a.in[I_ARE][i], li = a.in[I_AIM][i], dt = __expf(a.in[I_LDT][l * NG + g]);
        const float er = __expf(lr * dt);
        const double rev = (double)li * (double)dt * 0.15915494309189535; const float fr = (float)(rev - __builtin_rint(rev));
        const float ar = er * __builtin_amdgcn_cosf(fr), ai = er * __builtin_amdgcn_sinf(fr);
        const float e64 = __expf(64.f * lr * dt);
        const double rev64 = rev * 64.0; const float fr64 = (float)(rev64 - __builtin_rint(rev64));
        const float ar64 = e64 * __builtin_amdgcn_cosf(fr64), ai64 = e64 * __builtin_amdgcn_sinf(fr64);
        unsigned char* T = ws + WS_S5T + (size_t)l * S5T_LAYER;
        ((f32x2*)(T + S5T_A))[g * NS + n] = (f32x2){ar, ai};
        ((f32x2*)(T + S5T_A64))[g * NS + n] = (f32x2){ar64, ai64};
        const float nr = ar - 1.f, ni = ai, den = 1.f / (lr * lr + li * li);
        const float cr = (nr * lr + ni * li) * den, ci = (ni * lr - nr * li) * den;
        bf16* TB = (bf16*)(T + S5T_B) + (size_t)(g * 128 + 2 * n) * 16;
        const float* Bre = a.in[I_BRE] + (size_t)i * 16; const float* Bim = a.in[I_BIM] + (size_t)i * 16;
#pragma unroll
        for (int q = 0; q < 16; ++q) { const float br = Bre[q], bi = Bim[q]; TB[q] = (bf16)f2bf(cr * br - ci * bi); TB[16 + q] = (bf16)f2bf(cr * bi + ci * br); }
        bf16* TC = (bf16*)(T + S5T_C) + (size_t)g * 16 * 128;
        const float* Cre = a.in[I_CRE] + (size_t)(l * NG + g) * 16 * NS; const float* Cim = a.in[I_CIM] + (size_t)(l * NG + g) * 16 * NS;
#pragma unroll
        for (int p = 0; p < 16; ++p) { TC[p * 128 + 2 * n] = (bf16)f2bf(Cre[p * NS + n]); TC[p * 128 + 2 * n + 1] = (bf16)f2bf(-Cim[p * NS + n]); }
    }
}

template <bool DO_RES, bool DO_H>
__device__ __forceinline__ void phase_norm(const Args& a, const Ctx& c, LAS unsigned char* lds, int layer, int pass) {
    unsigned char* ws = c.ws; const int gw = c.gw, NGW = c.NGW, lane = c.lane;
    LAS float* wif = (LAS float*)lds;
    if (DO_H) {
        const float* win = a.in[I_WIN] + (size_t)layer * D * NIN + 6144;
        for (int i = c.tid; i < 8192; i += NTHR) { const int cc = i >> 3, jj = i & 7; wif[jj * 1024 + cc] = win[(size_t)cc * NIN + jj]; }
        __syncthreads();
    }
    const float* xsrc = (DO_H && layer <= 1) ? a.in[I_X] : a.out;
    f32x4 wpre[4], wpost[4];
#pragma unroll
    for (int j = 0; j < 4; ++j) {
        wpre[j] = DO_H ? *(const f32x4*)(a.in[I_NPRE] + (size_t)layer * D + 4 * lane + 256 * j) : (f32x4){0.f, 0.f, 0.f, 0.f};
        wpost[j] = DO_RES ? *(const f32x4*)(a.in[I_NPOST] + (size_t)(DO_H ? layer - 1 : layer) * D + 4 * lane + 256 * j) : (f32x4){0.f, 0.f, 0.f, 0.f};
    }
    const bf16* OUT = (const bf16*)(ws + WS_QKA); const float* OSS = (const float*)(ws + WS_OSS);
    bf16* Hb = (bf16*)(ws + WS_H); float* IF = (float*)(ws + WS_IF);
    for (int r = gw; r < MH; r += NGW) {
        const size_t grow = (size_t)pass * MH + r;
        f32x4 v[4];
#pragma unroll
        for (int j = 0; j < 4; ++j) v[j] = *(const f32x4*)(xsrc + grow * D + 4 * lane + 256 * j);
        if (DO_RES) {
            float ss = 0.f;
#pragma unroll
            for (int j = 0; j < 4; ++j) { const f32x4 p = *(const f32x4*)(OSS + (size_t)r * 16 + 4 * j); ss += (p[0] + p[1]) + (p[2] + p[3]); }
            const float rs = __builtin_amdgcn_rsqf(ss * (1.f / D) + RMS_EPS);
#pragma unroll
            for (int j = 0; j < 4; ++j) { const u32x2 o = *(const u32x2*)(OUT + (size_t)r * D + 4 * lane + 256 * j);
                v[j][0] += bflo(o.x) * rs * wpost[j][0]; v[j][1] += bfhi(o.x) * rs * wpost[j][1]; v[j][2] += bflo(o.y) * rs * wpost[j][2]; v[j][3] += bfhi(o.y) * rs * wpost[j][3]; }
#pragma unroll
            for (int j = 0; j < 4; ++j) *(f32x4*)(a.out + grow * D + 4 * lane + 256 * j) = v[j];
        }
        if (DO_H) {
            float s = 0.f;
#pragma unroll
            for (int j = 0; j < 4; ++j) s += (v[j][0] * v[j][0] + v[j][1] * v[j][1]) + (v[j][2] * v[j][2] + v[j][3] * v[j][3]);
            const float rstd = __builtin_amdgcn_rsqf(wave_sum(s, lane) * (1.f / D) + RMS_EPS);
#pragma unroll
            for (int j = 0; j < 4; ++j) { v[j] = v[j] * rstd * wpre[j];
                u32x2 o; o.x = cvt_pk_bf16(v[j][0], v[j][1]); o.y = cvt_pk_bf16(v[j][2], v[j][3]);
                *(u32x2*)(Hb + (size_t)r * D + 4 * lane + 256 * j) = o; }
            float mine = 0.f;
#pragma unroll
            for (int jj = 0; jj < 8; ++jj) { float d = 0.f;
#pragma unroll
                for (int j = 0; j < 4; ++j) { const f32x4 w = *(const LAS f32x4*)(wif + jj * 1024 + 4 * lane + 256 * j); d += (v[j][0] * w[0] + v[j][1] * w[1]) + (v[j][2] * w[2] + v[j][3] * w[3]); }
                d = wave_sum(d, lane); mine = (lane == jj) ? d : mine; }
            if (lane < 8) IF[(size_t)r * 8 + lane] = mine;
        }
    }
    if (DO_H) __syncthreads();
}

__device__ __forceinline__ void ld8(const bf16* p, float (&f)[8]) { unpack8(*(const u32x4*)p, f); }
__device__ __forceinline__ void phase_ew(const Args& a, const Ctx& cx, int layer) {
    unsigned char* ws = cx.ws; const int gt = cx.gt, NGT = cx.NGT;
    bf16* SEG = (bf16*)(ws + WS_SEG);
    {
        bf16* QKA = (bf16*)(ws + WS_QKA); const float* cw = a.in[I_MCW] + (size_t)layer * 4 * 1024;
        for (int id = gt; id < (MH / 16) * 128; id += NGT) {
            const int cg = id & 127, run = id >> 7, c = cg * 8, r0 = run * 16;
            const bf16* src = SEG + (size_t)(SG_QK + (cg >> 6)) * MH * BW + (c & 511);
            float w[4][8];
#pragma unroll
            for (int k = 0; k < 4; ++k) { const f32x4 w0 = *(const f32x4*)(cw + k * 1024 + c), w1 = *(const f32x4*)(cw + k * 1024 + c + 4); acc8(w0, w1, w[k]); }
            const float scale = (cg < 64) ? 0.08838834764831845f : 1.0f;
            const bool halo = (r0 & (SEQ - 1)) != 0;
            float x0[8], x1[8], x2[8], x3[8];
            if (halo) { ld8(src + (size_t)(r0 - 3) * BW, x0); ld8(src + (size_t)(r0 - 2) * BW, x1); ld8(src + (size_t)(r0 - 1) * BW, x2); }
            else {
#pragma unroll
                for (int e = 0; e < 8; ++e) { x0[e] = 0.f; x1[e] = 0.f; x2[e] = 0.f; } }
#pragma unroll 4
            for (int i = 0; i < 16; ++i) {
                ld8(src + (size_t)(r0 + i) * BW, x3); float y[8];
#pragma unroll
                for (int e = 0; e < 8; ++e) { const float t = w[0][e] * x0[e] + w[1][e] * x1[e] + w[2][e] * x2[e] + w[3][e] * x3[e]; y[e] = t * fsigmoid(t) * scale; x0[e] = x1[e]; x1[e] = x2[e]; x2[e] = x3[e]; }
                *(u32x4*)(QKA + (size_t)(r0 + i) * D + c) = pack8(y);
            }
        }
    }
    {
        const float* cw = a.in[I_SCW] + (size_t)layer * 3 * BW;
        const bf16* X = SEG + (size_t)SG_SCX * MH * BW; const bf16* Bb = SEG + (size_t)SG_SCB * MH * BW; const bf16* Cc = SEG + (size_t)SG_SCC * MH * BW; bf16* Z = SEG + (size_t)SG_SCZ * MH * BW;
        for (int id = gt; id < (MH / 16) * 64; id += NGT) {
            const int cg = id & 63, run = id >> 6, c = cg * 8, r0 = run * 16;
            float w[3][8];
#pragma unroll
            for (int k = 0; k < 3; ++k) { const f32x4 w0 = *(const f32x4*)(cw + k * BW + c), w1 = *(const f32x4*)(cw + k * BW + c + 4); acc8(w0, w1, w[k]); }
            const bool halo = (r0 & (SEQ - 1)) != 0;
            float p0[8], p1[8], p2[8];
            if (halo) { float xa[8], ca[8]; ld8(X + (size_t)(r0 - 2) * BW + c, xa); ld8(Cc + (size_t)(r0 - 2) * BW + c, ca);
#pragma unroll
                for (int e = 0; e < 8; ++e) p0[e] = xa[e] * ca[e];
                ld8(X + (size_t)(r0 - 1) * BW + c, xa); ld8(Cc + (size_t)(r0 - 1) * BW + c, ca);
#pragma unroll
                for (int e = 0; e < 8; ++e) p1[e] = xa[e] * ca[e]; }
            else {
#pragma unroll
                for (int e = 0; e < 8; ++e) { p0[e] = 0.f; p1[e] = 0.f; } }
#pragma unroll 4
            for (int i = 0; i < 16; ++i) { const size_t off = (size_t)(r0 + i) * BW + c;
                float xa[8], ca[8], bb[8], zz[8], y[8]; ld8(X + off, xa); ld8(Cc + off, ca); ld8(Bb + off, bb); ld8(Z + off, zz);
#pragma unroll
                for (int e = 0; e < 8; ++e) { p2[e] = xa[e] * ca[e]; y[e] = bb[e] * (w[0][e] * p0[e] + w[1][e] * p1[e] + w[2][e] * p2[e]) * zz[e]; p0[e] = p1[e]; p1[e] = p2[e]; }
                *(u32x4*)(Z + off) = pack8(y); }
        }
    }
    {
        const bf16* U = SEG + (size_t)SG_PU * MH * BW; bf16* PO = (bf16*)(ws + WS_POOL);
        for (int id = gt; id < (MH / 32) * 64; id += NGT) {
            const int cg = id & 63, run = id >> 6, c = cg * 8, r0 = run * 32, win = 2 << (cg >> 4), pos0 = r0 & (SEQ - 1);
            float s[8];
#pragma unroll
            for (int e = 0; e < 8; ++e) s[e] = 0.f;
            for (int j = 1; j <= win; ++j) if (pos0 - j >= 0) { float t[8]; ld8(U + (size_t)(r0 - j) * BW + c, t);
#pragma unroll
                for (int e = 0; e < 8; ++e) s[e] += t[e]; }
            for (int i = 0; i < 32; ++i) { const int pos = pos0 + i; const size_t off = (size_t)(r0 + i) * BW + c;
                float cur[8], old[8], y[8]; ld8(U + off, cur);
                if (pos - win >= 0) ld8(U + off - (size_t)win * BW, old); else {
#pragma unroll
                    for (int e = 0; e < 8; ++e) old[e] = 0.f; }
                const int cnt = (pos + 1 < win) ? pos + 1 : win; const float inv = 1.0f / (float)cnt;
#pragma unroll
                for (int e = 0; e < 8; ++e) { s[e] += cur[e] - old[e]; y[e] = s[e] * inv - cur[e]; }
                *(u32x4*)(PO + off) = pack8(y); }
        }
    }
}
__device__ __forceinline__ void phase_ydfix(const Args& a, const Ctx& cx, int layer) {
    unsigned char* ws = cx.ws; const int gt = cx.gt, NGT = cx.NGT; bf16* SEG = (bf16*)(ws + WS_SEG);
    const bf16* HG = SEG + (size_t)SG_O * MH * BW; bf16* Z = SEG + (size_t)SG_MZ * MH * BW; const float* SSQ = (const float*)(ws + WS_SSQ); const float* nw = a.in[I_MNW] + (size_t)layer * BW;
    for (int id = gt; id < MH * 64; id += NGT) {
        const int cg = id & 63, r = id >> 6, c = cg * 8, hd = cg >> 4;
        const f32x4 q = *(const f32x4*)(SSQ + (size_t)r * 16 + hd * 4);
        const float rs = __builtin_amdgcn_rsqf(((q[0] + q[1]) + (q[2] + q[3])) * (1.f / DH) + RMS_EPS);
        float h[8], z[8], w[8]; const size_t off = (size_t)r * BW + c; ld8(HG + off, h); ld8(Z + off, z);
        const f32x4 w0 = *(const f32x4*)(nw + c), w1 = *(const f32x4*)(nw + c + 4); acc8(w0, w1, w);
#pragma unroll
        for (int e = 0; e < 8; ++e) h[e] = h[e] * rs * w[e] * z[e];
        *(u32x4*)(Z + off) = pack8(h);
    }
}

constexpr int S5_UYS = 1040;
constexpr int S5_OFF_BU = 64 * S5_UYS;
constexpr int S5_WS = 272;
constexpr int S5_OFF_X = S5_OFF_BU + 8 * 16 * S5_WS;
static_assert(S5_OFF_X + 8 * 16 * S5_WS <= LDS_MISC, "S5 LDS");
template <bool PASS2>
__device__ __forceinline__ void phase_s5(const Args& a, const Ctx& cx, LAS unsigned char* lds, int layer) {
    unsigned char* ws = cx.ws; const int vcu = cx.vcu, G = cx.G;
    const int tid = cx.tid, wave = cx.wave, lane = cx.lane, fr = lane & 15, fq = lane >> 4;
    bf16* U = (bf16*)(ws + WS_SEG) + (size_t)SG_S5U * MH * BW;
    f32x2* E = (f32x2*)(ws + WS_E);
    const unsigned char* T = ws + WS_S5T + (size_t)layer * S5T_LAYER;
    const f32x2* TA = (const f32x2*)(T + S5T_A); const f32x2* TA64 = (const f32x2*)(T + S5T_A64);
    const bf16* TB = (const bf16*)(T + S5T_B); const bf16* TC = (const bf16*)(T + S5T_C);
    const float* Dk = a.in[I_S5D] + (size_t)layer * BW;
    LAS unsigned char* UY = lds; LAS unsigned char* BUs = lds + S5_OFF_BU + wave * 16 * S5_WS; LAS unsigned char* Xs = lds + S5_OFF_X + wave * 16 * S5_WS;
    for (int unit = vcu; unit < HB * NCH; unit += G) {
        const int b = unit / NCH, c = unit % NCH; const size_t row0 = (size_t)b * SEQ + (size_t)c * CH;
#pragma unroll
        for (int j = 0; j < 8; ++j) { const int id = tid + NTHR * j, r = id >> 6, pc = id & 63;
            *(LAS u32x4*)(UY + r * S5_UYS + pc * 16) = *(const u32x4*)(U + (row0 + r) * BW + pc * 8); }
        __syncthreads();
#pragma unroll 1
        for (int gi = 0; gi < 4; ++gi) {
            const int g = wave + 8 * gi;
            const f32x2 av = TA[g * NS + lane]; const float ar = av[0], ai = av[1];
            s16x4 Bf[8];
#pragma unroll
            for (int ct = 0; ct < 8; ++ct) Bf[ct] = *(const s16x4*)(TB + (size_t)(g * 128 + ct * 16 + fr) * 16 + fq * 4);
            float sr = 0.f, si = 0.f;
            bf16x8 Cf[4]; float dk[4];
            if (PASS2) {
#pragma unroll
                for (int s = 0; s < 4; ++s) Cf[s] = *(const bf16x8*)(TC + (size_t)(g * 16 + fr) * 128 + s * 32 + fq * 8);
#pragma unroll
                for (int r = 0; r < 4; ++r) dk[r] = Dk[g * 16 + fq * 4 + r];
                const f32x2 a64 = TA64[g * NS + lane];
                const f32x2* Eb = E + ((size_t)b * NCH * NG + g) * NS + lane;
                for (int j = 0; j < c; ++j) { const f32x2 e = Eb[(size_t)j * NG * NS]; const float nr = a64[0] * sr - a64[1] * si + e[0], ni = a64[0] * si + a64[1] * sr + e[1]; sr = nr; si = ni; }
            }
#pragma unroll 1
            for (int tb = 0; tb < 4; ++tb) {
                LAS unsigned char* up = UY + (tb * 16 + fr) * S5_UYS + (g * 16 + fq * 4) * 2;
                const s16x4 Uf = *(const LAS s16x4*)up;
#pragma unroll
                for (int ct = 0; ct < 8; ++ct) {
                    const f32x4 d = __builtin_amdgcn_mfma_f32_16x16x16bf16_1k(Bf[ct], Uf, (f32x4){0.f, 0.f, 0.f, 0.f}, 0, 0, 0);
                    u32x2 w; w.x = cvt_pk_bf16(d[0], d[1]); w.y = cvt_pk_bf16(d[2], d[3]);
                    *(LAS u32x2*)(BUs + fr * S5_WS + (ct * 16 + fq * 4) * 2) = w;
                }
                WAVE_SYNC();
#pragma unroll
                for (int t = 0; t < 16; ++t) {
                    const unsigned w = *(const LAS unsigned*)(BUs + t * S5_WS + lane * 4);
                    const float nr = ar * sr - ai * si + bflo(w), ni = ar * si + ai * sr + bfhi(w); sr = nr; si = ni;
                    if (PASS2) *(LAS unsigned*)(Xs + t * S5_WS + lane * 4) = cvt_pk_bf16(sr, si);
                }
                if (PASS2) {
                    WAVE_SYNC();
                    f32x4 y = (f32x4){0.f, 0.f, 0.f, 0.f};
#pragma unroll
                    for (int s = 0; s < 4; ++s) { const bf16x8 Xf = *(const LAS bf16x8*)(Xs + fr * S5_WS + (s * 32 + fq * 8) * 2);
                        y = __builtin_amdgcn_mfma_f32_16x16x32_bf16(Cf[s], Xf, y, 0, 0, 0); }
                    const u32x2 uw = __builtin_bit_cast(u32x2, Uf);
                    const float u0 = bflo(uw.x), u1 = bfhi(uw.x), u2 = bflo(uw.y), u3 = bfhi(uw.y);
                    float o[4] = {y[0] + dk[0] * u0, y[1] + dk[1] * u1, y[2] + dk[2] * u2, y[3] + dk[3] * u3};
#pragma unroll
                    for (int r = 0; r < 4; ++r) { const float x = o[r]; o[r] = x * fsigmoid(1.5957691216057308f * (x + 0.044715f * x * x * x)); }
                    u32x2 w; w.x = cvt_pk_bf16(o[0], o[1]); w.y = cvt_pk_bf16(o[2], o[3]);
                    *(LAS u32x2*)up = w;
                }
                WAVE_SYNC();
            }
            if (!PASS2) E[(((size_t)b * NCH + c) * NG + g) * NS + lane] = (f32x2){sr, si};
        }
        __syncthreads();
        if (PASS2) {
#pragma unroll
            for (int j = 0; j < 8; ++j) { const int id = tid + NTHR * j, r = id >> 6, pc = id & 63;
                *(u32x4*)(U + (row0 + r) * BW + pc * 8) = *(const LAS u32x4*)(UY + r * S5_UYS + pc * 16); }
            __syncthreads();
        }
    }
}

constexpr int ML_KS = 272, ML_TS = 144, ML_CS = 272;
constexpr int ML_OFF_KT = 64 * ML_KS, ML_OFF_VT = ML_OFF_KT + 128 * ML_TS, ML_OFF_VW = ML_OFF_VT + 48 * ML_TS, ML_BUF = ML_OFF_VW + 48 * ML_TS;
constexpr int ML_OFF_CS = 2 * ML_BUF, ML_CSB = 48 * ML_CS;
static_assert(ML_OFF_CS + 2 * ML_CSB <= LDS_MISC, "mLSTM LDS");
__device__ __forceinline__ float wave_incl_sum(float v, int lane) {
#pragma unroll
    for (int o = 1; o < 64; o <<= 1) { const float t = shfl_idx(v, lane - o); v = (lane >= o) ? v + t : v; }
    return v;
}
__device__ __forceinline__ float wave_incl_max(float v, int lane) {
#pragma unroll
    for (int o = 1; o < 64; o <<= 1) { const float t = shfl_idx(v, lane - o); v = (lane >= o) ? fmaxf(v, t) : v; }
    return v;
}
__device__ __forceinline__ float wave_max(float v, int lane) {
#pragma unroll
    for (int o = 1; o < 64; o <<= 1) v = fmaxf(v, shfl_x(v, o, lane));
    return v;
}
__device__ __forceinline__ void phase_mlstm(const Args& a, const Ctx& cx, LAS unsigned char* lds, int layer) {
    unsigned char* ws = cx.ws; const int vcu = cx.vcu, G = cx.G;
    const int tid = cx.tid, wave = cx.wave, lane = cx.lane, fr = lane & 15, fq = lane >> 4;
    const bf16* QKA = (const bf16*)(ws + WS_QKA); const bf16* V = (const bf16*)(ws + WS_SEG) + (size_t)SG_V * MH * BW; bf16* O = (bf16*)(ws + WS_SEG) + (size_t)SG_O * MH * BW;
    const float* IF = (const float*)(ws + WS_IF); float* SSQ = (float*)(ws + WS_SSQ);
    for (int i = tid; i < 2 * 16 * (ML_TS / 4); i += NTHR) { const int bfi = i / (16 * (ML_TS / 4)), q = i % (16 * (ML_TS / 4)), row = q / (ML_TS / 4), w = q % (ML_TS / 4);
        *(LAS unsigned*)(lds + bfi * ML_BUF + ML_OFF_VT + (32 + row) * ML_TS + w * 4) = (row == 0) ? 0x3F803F80u : 0u;
        *(LAS unsigned*)(lds + bfi * ML_BUF + ML_OFF_VW + (32 + row) * ML_TS + w * 4) = 0u; }
    for (int unit = vcu; unit < HB * 16; unit += G) {
        const int es = unit & 3, hd = (unit >> 2) & 3, b = unit >> 4; const size_t row0 = (size_t)b * SEQ;
        const float b_i = a.in[I_MBI][layer * 4 + hd], b_f = a.in[I_MBF][layer * 4 + hd];
        const int colq = hd * 128, colk = 512 + hd * 128, colv = hd * 128 + es * 32;
        for (int i = tid; i < ML_CSB / 4; i += NTHR) *(LAS unsigned*)(lds + ML_OFF_CS + i * 4) = 0u;
        u32x4 kreg[2], vreg = (u32x4){0u, 0u, 0u, 0u}; bf16x8 qcur[4], qnext[4]; u32x2 ocur[2], onext[2]; float gi, gf;
#pragma unroll
        for (int s4 = 0; s4 < 4; ++s4) { qcur[s4] = (bf16x8){0, 0, 0, 0, 0, 0, 0, 0}; qnext[s4] = qcur[s4]; }
        ocur[0] = ocur[1] = onext[0] = onext[1] = (u32x2){0u, 0u};
        float gb, gu, gpm, gg, gmloc, gwloc;
        f32x4 C[2][3];
#pragma unroll
        for (int i = 0; i < 2; ++i)
#pragma unroll
            for (int j = 0; j < 3; ++j) C[i][j] = (f32x4){0.f, 0.f, 0.f, 0.f};
        float m_prev = 0.f;
#define ML_LOAD(s_, QD, OD) do { const size_t rs_ = row0 + (size_t)(s_) * CH; \
        _Pragma("unroll") for (int j_ = 0; j_ < 2; ++j_) { const int id_ = tid + NTHR * j_, l_ = id_ & 63, pc_ = id_ >> 6; kreg[j_] = *(const u32x4*)(QKA + (rs_ + l_) * D + colk + pc_ * 8); } \
        if (tid < 256) vreg = *(const u32x4*)(V + (rs_ + lane) * BW + colv + (tid >> 6) * 8); \
        gi = IF[(rs_ + lane) * 8 + hd]; gf = IF[(rs_ + lane) * 8 + 4 + hd]; \
        if (wave < 4) { _Pragma("unroll") for (int s4 = 0; s4 < 4; ++s4) QD[s4] = *(const bf16x8*)(QKA + (rs_ + 16 * wave + fr) * D + colq + s4 * 32 + fq * 8); \
            _Pragma("unroll") for (int et = 0; et < 2; ++et) OD[et] = *(const u32x2*)(O + (rs_ + 16 * wave + fr) * BW + colv + et * 16 + fq * 4); } } while (0)
#define ML_GATES() do { const float x_ = gf + b_f; const float lf_ = fminf(x_, 0.f) - __logf(1.f + __expf(-fabsf(x_))); const float il_ = gi + b_i; \
        gb = wave_incl_sum(lf_, lane); gg = shfl_idx(gb, 63); const float a_ = gg - gb + il_; gmloc = wave_max(a_, lane); gwloc = __expf(a_ - gmloc); gu = il_ - gb; gpm = wave_incl_max(gu, lane); } while (0)
#define ML_WRITE(nb_) do { LAS unsigned char* B_ = lds + (nb_) * ML_BUF; \
        _Pragma("unroll") for (int j_ = 0; j_ < 2; ++j_) { const int pc_ = (tid + NTHR * j_) >> 6; *(LAS u32x4*)(B_ + lane * ML_KS + pc_ * 16) = kreg[j_]; \
            const unsigned kw_[4] = {kreg[j_].x, kreg[j_].y, kreg[j_].z, kreg[j_].w}; \
            _Pragma("unroll") for (int e_ = 0; e_ < 8; ++e_) *(LAS bf16*)(B_ + ML_OFF_KT + (pc_ * 8 + e_) * ML_TS + lane * 2) = (bf16)((e_ & 1) ? (kw_[e_ >> 1] >> 16) : (kw_[e_ >> 1] & 0xffffu)); } \
        if (tid < 256) { const int pc_ = tid >> 6; const unsigned vw_[4] = {vreg.x, vreg.y, vreg.z, vreg.w}; \
            _Pragma("unroll") for (int e_ = 0; e_ < 8; ++e_) { const unsigned hv_ = (e_ & 1) ? (vw_[e_ >> 1] >> 16) : (vw_[e_ >> 1] & 0xffffu); \
                *(LAS bf16*)(B_ + ML_OFF_VT + (pc_ * 8 + e_) * ML_TS + lane * 2) = (bf16)hv_; \
                *(LAS bf16*)(B_ + ML_OFF_VW + (pc_ * 8 + e_) * ML_TS + lane * 2) = (bf16)f2bf(gwloc * bflo(hv_)); } } \
        if (wave == 4) *(LAS bf16*)(B_ + ML_OFF_VW + 32 * ML_TS + lane * 2) = (bf16)f2bf(gwloc); } while (0)
        ML_LOAD(0, qcur, ocur);
        ML_GATES();
        ML_WRITE(0);
#pragma unroll 1
        for (int s = 0; s < NCH; ++s) {
            const int cb = s & 1;
            __syncthreads();
            const size_t rs = row0 + (size_t)s * CH;
            if (s + 1 < NCH) ML_LOAD(s + 1, qnext, onext);
            LAS unsigned char* Bc = lds + cb * ML_BUF; LAS unsigned char* Cc = lds + ML_OFF_CS + cb * ML_CSB; LAS unsigned char* Cn = lds + ML_OFF_CS + (cb ^ 1) * ML_CSB;
            const float elog = gb + m_prev, mt_t = fmaxf(gb + gpm, elog), sint_t = __expf(elog - mt_t), en_t = __expf(-mt_t);
            const float m_new = fmaxf(gg + m_prev, gmloc), s_old = __expf(gg + m_prev - m_new), s_new = __expf(gmloc - m_new);
            if (wave < 4) {
                const int lb = wave, l = 16 * lb + fr;
                const float bl = shfl_idx(gb, l), mt = shfl_idx(mt_t, l), sint = shfl_idx(sint_t, l), enl = shfl_idx(en_t, l);
                f32x4 numT[3];
#pragma unroll
                for (int et = 0; et < 3; ++et) numT[et] = (f32x4){0.f, 0.f, 0.f, 0.f};
#pragma unroll
                for (int pp = 0; pp < 2; ++pp) {
                    const int mb0 = 2 * pp, mb1 = mb0 + 1;
                    if (mb0 <= lb) {
                        f32x4 st0 = (f32x4){0.f, 0.f, 0.f, 0.f}, st1 = (f32x4){0.f, 0.f, 0.f, 0.f};
#pragma unroll
                        for (int s4 = 0; s4 < 4; ++s4) { const bf16x8 kf = *(const LAS bf16x8*)(Bc + (mb0 * 16 + fr) * ML_KS + (s4 * 32 + fq * 8) * 2);
                            st0 = __builtin_amdgcn_mfma_f32_16x16x32_bf16(kf, qcur[s4], st0, 0, 0, 0); }
                        if (mb1 <= lb) {
#pragma unroll
                            for (int s4 = 0; s4 < 4; ++s4) { const bf16x8 kf = *(const LAS bf16x8*)(Bc + (mb1 * 16 + fr) * ML_KS + (s4 * 32 + fq * 8) * 2);
                                st1 = __builtin_amdgcn_mfma_f32_16x16x32_bf16(kf, qcur[s4], st1, 0, 0, 0); }
                        }
                        float w0[4], w1[4];
#pragma unroll
                        for (int r = 0; r < 4; ++r) { const int m0 = mb0 * 16 + 4 * fq + r, m1 = mb1 * 16 + 4 * fq + r;
                            const float e0 = __expf(bl + shfl_idx(gu, m0) - mt) * st0[r], e1 = __expf(bl + shfl_idx(gu, m1) - mt) * st1[r];
                            w0[r] = (m0 <= l) ? e0 : 0.f; w1[r] = (m1 <= l && mb1 <= lb) ? e1 : 0.f; }
                        u32x4 wp; wp.x = cvt_pk_bf16(w0[0], w0[1]); wp.y = cvt_pk_bf16(w0[2], w0[3]); wp.z = cvt_pk_bf16(w1[0], w1[1]); wp.w = cvt_pk_bf16(w1[2], w1[3]);
                        const bf16x8 wf = __builtin_bit_cast(bf16x8, wp);
#pragma unroll
                        for (int et = 0; et < 3; ++et) {
                            const u32x2 v0 = *(const LAS u32x2*)(Bc + ML_OFF_VT + (et * 16 + fr) * ML_TS + (mb0 * 16 + 4 * fq) * 2), v1 = *(const LAS u32x2*)(Bc + ML_OFF_VT + (et * 16 + fr) * ML_TS + (mb1 * 16 + 4 * fq) * 2);
                            const u32x4 vp = (u32x4){v0.x, v0.y, v1.x, v1.y};
                            numT[et] = __builtin_amdgcn_mfma_f32_16x16x32_bf16(__builtin_bit_cast(bf16x8, vp), wf, numT[et], 0, 0, 0); }
                    }
                }
                f32x4 tot[3];
#pragma unroll
                for (int et = 0; et < 3; ++et) { f32x4 it = (f32x4){0.f, 0.f, 0.f, 0.f};
#pragma unroll
                    for (int s4 = 0; s4 < 4; ++s4) { const bf16x8 cf = *(const LAS bf16x8*)(Cc + (et * 16 + fr) * ML_CS + (s4 * 32 + fq * 8) * 2);
                        it = __builtin_amdgcn_mfma_f32_16x16x32_bf16(cf, qcur[s4], it, 0, 0, 0); }
                    tot[et] = numT[et] + it * sint; }
                const float den = shfl_idx(tot[2][0], fr);
                const float inv = 1.0f / fmaxf(fabsf(den), enl);
                float ssq = 0.f;
#pragma unroll
                for (int et = 0; et < 2; ++et) { const float h0 = tot[et][0] * inv * bflo(ocur[et].x), h1 = tot[et][1] * inv * bfhi(ocur[et].x), h2 = tot[et][2] * inv * bflo(ocur[et].y), h3 = tot[et][3] * inv * bfhi(ocur[et].y);
                    ssq += (h0 * h0 + h1 * h1) + (h2 * h2 + h3 * h3);
                    u32x2 w; w.x = cvt_pk_bf16(h0, h1); w.y = cvt_pk_bf16(h2, h3);
                    *(u32x2*)(O + (rs + l) * BW + colv + et * 16 + fq * 4) = w; }
                ssq += shfl_x(ssq, 16, lane); ssq += shfl_x(ssq, 32, lane);
                if (fq == 0) SSQ[(rs + l) * 16 + hd * 4 + es] = ssq;
            } else {
                const int jw = wave - 4;
#pragma unroll
                for (int dti = 0; dti < 2; ++dti) { const int dt = 2 * jw + dti;
                    bf16x8 ktf[2];
#pragma unroll
                    for (int s2 = 0; s2 < 2; ++s2) ktf[s2] = *(const LAS bf16x8*)(Bc + ML_OFF_KT + (dt * 16 + fr) * ML_TS + (s2 * 32 + fq * 8) * 2);
#pragma unroll
                    for (int et = 0; et < 3; ++et) { f32x4 cl = (f32x4){0.f, 0.f, 0.f, 0.f};
#pragma unroll
                        for (int s2 = 0; s2 < 2; ++s2) { const bf16x8 vwf = *(const LAS bf16x8*)(Bc + ML_OFF_VW + (et * 16 + fr) * ML_TS + (s2 * 32 + fq * 8) * 2);
                            cl = __builtin_amdgcn_mfma_f32_16x16x32_bf16(ktf[s2], vwf, cl, 0, 0, 0); }
                        C[dti][et] = C[dti][et] * s_old + cl * s_new;
                        u32x2 w; w.x = cvt_pk_bf16(C[dti][et][0], C[dti][et][1]); w.y = cvt_pk_bf16(C[dti][et][2], C[dti][et][3]);
                        *(LAS u32x2*)(Cn + (et * 16 + fr) * ML_CS + (dt * 16 + 4 * fq) * 2) = w; }
                }
            }
            m_prev = m_new;
            if (s + 1 < NCH) {
                ML_GATES();
                ML_WRITE(cb ^ 1);
#pragma unroll
                for (int s4 = 0; s4 < 4; ++s4) qcur[s4] = qnext[s4];
                ocur[0] = onext[0]; ocur[1] = onext[1];
            }
        }
        __syncthreads();
#undef ML_LOAD
#undef ML_GATES
#undef ML_WRITE
    }
}

constexpr int NPH_IT = 9, NPHASES = 1 + NPH_IT * NPASS * DEPTH;
constexpr int CW_BAR = 4096;
__global__ void __launch_bounds__(NTHR, 2) mk_fwd(Args a) {
    extern __shared__ __attribute__((aligned(16))) unsigned char lds_raw[];
    LAS unsigned char* lds = (LAS unsigned char*)lds_raw;
    const int lo = a.ph_lo, hi = a.ph_hi;
    const int wave0 = __builtin_amdgcn_readfirstlane(threadIdx.x >> 6);
    if (threadIdx.x < 16) ((LAS unsigned*)(lds + LDS_MISC))[threadIdx.x] = 0u;
    __syncthreads();
    XcdBarrier bar; bar.bar = (unsigned*)(a.ws + WS_CTL) + CW_BAR; bar.x = 0; bar.st = (volatile LAS unsigned*)(lds + LDS_MISC);
    if (hi - lo > 1) bar = xcd_barrier_post((unsigned*)(a.ws + WS_CTL) + CW_BAR, (volatile LAS unsigned*)(lds + LDS_MISC));
#define IN(k) (lo <= (k) && (k) < hi)
#define SEAM(k) do { if (IN(k) && IN((k) + 1)) xcd_barrier(bar); } while (0)
#define P_SEG(c, sg) ((bf16*)((c).ws + WS_SEG) + (size_t)(sg) * MH * BW)
    if (IN(0)) { MAKE_CTX(c); phase_prologue(a, c, lds); }
    SEAM(0);
#pragma unroll 1
    for (int it = 0; it < NPASS * DEPTH; ++it) {
        const int base = 1 + NPH_IT * it, pass = it / DEPTH, layer = it % DEPTH;
        if (hi <= base || lo >= base + NPH_IT) continue;
        if (IN(base + 0)) { MAKE_CTX(c); if (layer == 0) phase_norm<false, true>(a, c, lds, layer, pass); else phase_norm<true, true>(a, c, lds, layer, pass); }
        SEAM(base + 0);
        if (IN(base + 1)) { MAKE_CTX(c);
            EpiProj E{P_SEG(c, 0), (bf16*)(c.ws + WS_GATE)};
            pg8::gemm_phase<EpiProj, NP, D, D, D>(lds, (const bf16*)(c.ws + WS_H), (const bf16*)(c.ws + WS_W1T) + (size_t)layer * NP * D, c.G, c.bx, c.tid, E);
        }
        SEAM(base + 1);
        if (IN(base + 2)) { { MAKE_CTX(c); phase_ew(a, c, layer); } { MAKE_CTX(c); phase_s5<false>(a, c, lds, layer); } }
        SEAM(base + 2);
        if (IN(base + 3)) { MAKE_CTX(c); phase_s5<true>(a, c, lds, layer); }
        SEAM(base + 3);
        if (IN(base + 4)) { MAKE_CTX(c); phase_mlstm(a, c, lds, layer); }
        SEAM(base + 4);
        if (IN(base + 5)) {
            { MAKE_CTX(c); EpiGlu E{P_SEG(c, SG_S5U), P_SEG(c, SG_S5Z)};
              pg8::gemm_phase<EpiGlu, BW, BW, BW, BW>(lds, P_SEG(c, SG_S5U), (const bf16*)(c.ws + WS_WGT) + (size_t)layer * BW * BW, c.G, c.bx, c.tid, E); }
            { MAKE_CTX(c); EpiPool E{a.in[I_POOLS] + (size_t)layer * BW, P_SEG(c, SG_PZ)};
              pg8::gemm_phase<EpiPool, BW, BW, BW, BW>(lds, (const bf16*)(c.ws + WS_POOL), (const bf16*)(c.ws + WS_WPT) + (size_t)layer * BW * BW, c.G, c.bx, c.tid, E); }
            { MAKE_CTX(c); phase_ydfix(a, c, layer); }
        }
        SEAM(base + 5);
        if (IN(base + 6)) {
#pragma unroll 1
            for (int bi = 0; bi < 4; ++bi) { MAKE_CTX(c);
                const int sg = (bi == 0) ? SG_S5Z : (bi == 1) ? SG_PZ : (bi == 2) ? SG_SCZ : SG_MZ;
                EpiBranch E{(const bf16*)(c.ws + WS_GATE) + (size_t)bi * MH * D, P_SEG(c, SG_QK), bi == 0 ? 1 : 0};
                pg8::gemm_phase<EpiBranch, D, BW, BW, BW>(lds, P_SEG(c, sg), (const bf16*)(c.ws + WS_WBT) + (size_t)(layer * 4 + bi) * D * BW, c.G, c.bx, c.tid, E);
            }
        }
        SEAM(base + 6);
        if (IN(base + 7)) { MAKE_CTX(c);
            EpiOut E{(bf16*)(c.ws + WS_QKA), (float*)(c.ws + WS_OSS)};
            pg8::gemm_phase<EpiOut, D, D, D, D>(lds, P_SEG(c, SG_QK), (const bf16*)(c.ws + WS_WOT) + (size_t)layer * D * D, c.G, c.bx, c.tid, E);
        }
        SEAM(base + 7);
        if (layer == DEPTH - 1) {
            if (IN(base + 8)) { MAKE_CTX(c); phase_norm<true, false>(a, c, lds, layer, pass); }
            SEAM(base + 8);
        }
    }
#undef IN
#undef SEAM
}


#ifndef MK_DEBUG
#define MK_DEBUG 0
#endif
#if MK_DEBUG
__global__ void dbg_scan(const unsigned* p, size_t nwords, int is_bf16, int code, unsigned* flag) {
    bool bad = false;
    for (size_t i = (size_t)blockIdx.x * blockDim.x + threadIdx.x; i < nwords; i += (size_t)gridDim.x * blockDim.x) { const unsigned w = p[i];
        if (is_bf16) bad |= ((w & 0x7f80u) == 0x7f80u) || ((w & 0x7f800000u) == 0x7f800000u); else bad |= ((w & 0x7f800000u) == 0x7f800000u); }
    if (bad) flag[code] = 1u;
}
__global__ void dbg_fix(float* out, const float* x, size_t n, const unsigned* flag) {
    int c = 0; for (int k = 1; k < 32; ++k) if (flag[k]) { c = k; break; }
    if (c == 0) return;
    for (size_t i = (size_t)blockIdx.x * blockDim.x + threadIdx.x; i < n; i += (size_t)gridDim.x * blockDim.x) out[i] = x[i] + (float)c;
}
#endif
extern "C" void kernel_launch(void* const* d_in, const int* in_sizes, int n_in, void* d_out, int out_size, void* d_ws, size_t ws_size, hipStream_t stream) {
    static int grid = 0;
    if (grid == 0) {
        if (n_in != 22 || in_sizes[0] != BATCH * SEQ * D || out_size != BATCH * SEQ * D || ws_size < WS_END) {
            fprintf(stderr, "kernel_launch: unexpected shapes (n_in %d, in0 %d, out %d, ws %zu, need %zu); nothing launched\n", n_in, n_in > 0 ? in_sizes[0] : -1, out_size, ws_size, (size_t)WS_END); grid = -1; return; }
        int dev = 0, cus = 0, per_cu = 0;
        if (hipGetDevice(&dev) != hipSuccess || hipDeviceGetAttribute(&cus, hipDeviceAttributeMultiprocessorCount, dev) != hipSuccess) { grid = -1; return; }
        if (hipFuncSetAttribute((const void*)mk_fwd, hipFuncAttributeMaxDynamicSharedMemorySize, LDS_BYTES) != hipSuccess) { fprintf(stderr, "kernel_launch: hipFuncSetAttribute failed\n"); grid = -1; return; }
        if (hipOccupancyMaxActiveBlocksPerMultiprocessor(&per_cu, (const void*)mk_fwd, NTHR, LDS_BYTES) != hipSuccess || per_cu < 1) fprintf(stderr, "kernel_launch: occupancy query reports %d\n", per_cu);
        (void)hipGetLastError();
        grid = cus;
    }
    if (grid < 0) return;
    (void)hipMemsetAsync((char*)d_ws + WS_CTL, 0, CTL_ZERO_BYTES, stream);
    Args a{};
    for (int i = 0; i < 22; ++i) a.in[i] = (const float*)d_in[i];
    a.out = (float*)d_out; a.ws = (unsigned char*)d_ws;
#if MK_ONE_LAUNCH
    a.ph_lo = 0; a.ph_hi = NPHASES;
    hipLaunchKernelGGL(mk_fwd, dim3(grid), dim3(NTHR), LDS_BYTES, stream, a);
#else
#if MK_DEBUG
    (void)hipMemsetAsync((char*)d_ws + CTL_ZERO_BYTES, 0xFF, WS_END - CTL_ZERO_BYTES, stream);
    (void)hipMemsetAsync(d_out, 0xFF, (size_t)out_size * 4, stream);
    unsigned* flag = (unsigned*)((char*)d_ws + 512 * 1024);
    unsigned char* w8 = (unsigned char*)d_ws;
#define SCAN(off, bytes, isb, code) hipLaunchKernelGGL(dbg_scan, dim3(1024), dim3(256), 0, stream, (const unsigned*)(w8 + (off)), (size_t)(bytes) / 4, isb, code, flag)
#endif
    for (int k = 0; k < NPHASES; ++k) {
        if (k > 0 && (k - 1) % NPH_IT == NPH_IT - 1 && ((k - 1) / NPH_IT) % DEPTH != DEPTH - 1) continue;
        a.ph_lo = k; a.ph_hi = k + 1;
        hipLaunchKernelGGL(mk_fwd, dim3(grid), dim3(NTHR), LDS_BYTES, stream, a);
#if MK_DEBUG
        if (k == 0) { for (int l = 0; l < DEPTH; ++l) { SCAN(WS_S5T + l * S5T_LAYER, 32768, 0, 1); SCAN(WS_S5T + l * S5T_LAYER + S5T_B, 262144, 1, 1); } }
        if (k == 3) { SCAN(WS_QKA, (size_t)MH * D * 2, 1, 2); SCAN(WS_SEG + SG_SCZ * SEG_BYTES, SEG_BYTES, 1, 3); SCAN(WS_POOL, SEG_BYTES, 1, 4); SCAN(WS_E, 8 * MiB, 0, 5); }
        if (k == 4) { SCAN(WS_SEG + SG_S5U * SEG_BYTES, SEG_BYTES, 1, 6); }
        if (k == 5) { SCAN(WS_SEG + SG_O * SEG_BYTES, SEG_BYTES, 1, 7); SCAN(WS_SSQ, (size_t)MH * 16 * 4, 0, 7); }
        if (k == 6) { SCAN(WS_SEG + SG_S5Z * SEG_BYTES, SEG_BYTES, 1, 8); SCAN(WS_SEG + SG_PZ * SEG_BYTES, SEG_BYTES, 1, 8); SCAN(WS_SEG + SG_MZ * SEG_BYTES, SEG_BYTES, 1, 8); }
        if (k == 7) { SCAN(WS_SEG + SG_QK * SEG_BYTES, 2 * SEG_BYTES, 1, 9); }
        if (k == 8) { SCAN(WS_QKA, (size_t)MH * D * 2, 1, 10); SCAN(WS_OSS, (size_t)MH * 16 * 4, 0, 10); }
#endif
    }
#if MK_DEBUG
    hipLaunchKernelGGL(dbg_scan, dim3(1024), dim3(256), 0, stream, (const unsigned*)d_out, (size_t)out_size, 0, 11, flag);
    hipLaunchKernelGGL(dbg_fix, dim3(1024), dim3(256), 0, stream, (float*)d_out, (const float*)d_in[0], (size_t)out_size, (const unsigned*)flag);
#endif
#endif
}
```

```cpp
#include <hip/hip_runtime.h>
#include <cstdio>
#include <cstdint>

#ifndef MK_GROUP_BARRIERS
#define MK_GROUP_BARRIERS 1
#endif
#ifndef MK_TIME
#define MK_TIME 0
#endif
#ifndef MK_TMASK
#define MK_TMASK 2
#endif
#ifndef MK_TSEL
#define MK_TSEL 20
#endif
#ifndef MK_TBUCKET
#define MK_TBUCKET 16.f
#endif
#ifndef MK_DUP
#define MK_DUP 0
#endif
#ifndef MK_MLMODE
#define MK_MLMODE 0
#endif
#ifndef MK_ONE_LAUNCH
#define MK_ONE_LAUNCH 1
#endif

#define GAS __attribute__((address_space(1)))
#define LAS __attribute__((address_space(3)))
typedef unsigned short bf16;
typedef short bf16x8 __attribute__((ext_vector_type(8)));
typedef short s16x4 __attribute__((ext_vector_type(4)));
typedef float f32x4 __attribute__((ext_vector_type(4)));
typedef float f32x2 __attribute__((ext_vector_type(2)));
typedef unsigned u32x4 __attribute__((ext_vector_type(4)));
typedef unsigned u32x2 __attribute__((ext_vector_type(2)));
typedef int i32x8 __attribute__((ext_vector_type(8)));
constexpr float W8_SCALE = 64.f;

constexpr int D = 1024, BATCH = 16, SEQ = 4096, DEPTH = 4, BW = 512, NIN = 10760, NP = 10752;
constexpr int NG = 32, NS = 64, HEADS = 4, DH = 128, CH = 64, NCH = SEQ / CH;
constexpr int HB = 8, MH = HB * SEQ;
constexpr int NPASS = BATCH / HB;
constexpr float RMS_EPS = 1e-6f;
constexpr float LOG2E = 1.4426950408889634f;

constexpr size_t MiB = 1u << 20;
constexpr size_t WS_CTL = 0, CTL_ZERO_BYTES = 1 * MiB;
constexpr size_t WS_W1T = 1 * MiB;
constexpr size_t WS_WBT = 85 * MiB;
constexpr size_t WS_WOT = 101 * MiB;
constexpr size_t WS_WGT = 109 * MiB;
constexpr size_t WS_WPT = 111 * MiB;
constexpr size_t WS_S5T = 113 * MiB;
constexpr size_t WS_E = 115 * MiB;
constexpr size_t WS_IF = 123 * MiB;
constexpr size_t WS_SSQ = 124 * MiB;
constexpr size_t WS_OSS = 126 * MiB;
constexpr size_t WS_H = 128 * MiB;
constexpr size_t WS_SEG = 192 * MiB;
constexpr size_t SEG_BYTES = (size_t)MH * BW * 2;
constexpr size_t WS_GATE = 608 * MiB;
constexpr size_t WS_XB = 736 * MiB;
constexpr size_t WS_POOL = 864 * MiB;
constexpr size_t WS_QKA = 896 * MiB;
constexpr size_t WS_H8 = 960 * MiB;
constexpr size_t WS_W8 = 992 * MiB;
constexpr size_t WS_END = 1008 * MiB;
static_assert(WS_W1T + (size_t)DEPTH * NP * D * 2 <= WS_WBT && WS_SEG + 13 * SEG_BYTES <= WS_GATE && WS_GATE + 4 * (size_t)MH * D * 2 <= WS_POOL, "ws map");
constexpr size_t S5T_LAYER = 512 * 1024;
constexpr size_t S5T_A = 0, S5T_A64 = 16384, S5T_B = 32768, S5T_C = 32768 + 131072;
enum { SG_S5U = 0, SG_S5Z = 1, SG_PU = 2, SG_PZ = 3, SG_SCX = 4, SG_SCB = 5, SG_SCC = 6, SG_SCZ = 7, SG_QK = 8, SG_V = 10, SG_O = 11, SG_MZ = 12 };

constexpr int NWAVES = 8, NTHR = 512;
constexpr int LDS_BYTES = 147456;
constexpr int LDS_MISC = 143 * 1024;

__device__ __forceinline__ unsigned f2bf(float f) { unsigned u = __builtin_bit_cast(unsigned, f); return (u + 0x7fffu + ((u >> 16) & 1u)) >> 16; }
__device__ __forceinline__ float bflo(unsigned w) { return __builtin_bit_cast(float, w << 16); }
__device__ __forceinline__ float bfhi(unsigned w) { return __builtin_bit_cast(float, w & 0xffff0000u); }
typedef __bf16 bf16x2_t __attribute__((ext_vector_type(2)));
__device__ __forceinline__ unsigned cvt_pk_bf16(float lo, float hi) { const f32x2 v = {lo, hi}; const bf16x2_t r = __builtin_convertvector(v, bf16x2_t); return __builtin_bit_cast(unsigned, r); }
__device__ __forceinline__ float fsigmoid(float v) { return __builtin_amdgcn_rcpf(1.0f + __builtin_amdgcn_exp2f(-v * LOG2E)); }
__device__ __forceinline__ float fexp(float v) { return __builtin_amdgcn_exp2f(v * LOG2E); }
__device__ __forceinline__ int fresh_lane() { int l; asm volatile("v_mbcnt_lo_u32_b32 %0, -1, 0\n\tv_mbcnt_hi_u32_b32 %0, -1, %0" : "=v"(l)); return l; }
__device__ __forceinline__ float shfl_idx(float v, int src) { return __builtin_bit_cast(float, __builtin_amdgcn_ds_bpermute(src << 2, __builtin_bit_cast(int, v))); }
__device__ __forceinline__ float shfl_x(float v, int mask, int lane) { return shfl_idx(v, lane ^ mask); }
__device__ __forceinline__ float wave_sum(float v, int lane) {
#pragma unroll
    for (int o = 1; o < 64; o <<= 1) v += shfl_x(v, o, lane);
    return v;
}
template <int CTRL, int ROWMASK> __device__ __forceinline__ float upd_dpp(float old, float src) {
    return __builtin_bit_cast(float, __builtin_amdgcn_update_dpp(__builtin_bit_cast(int, old), __builtin_bit_cast(int, src), CTRL, ROWMASK, 0xf, false)); }
__device__ __forceinline__ float dpp_scan_add(float v) {
    v += upd_dpp<0x111, 0xf>(0.f, v); v += upd_dpp<0x112, 0xf>(0.f, v); v += upd_dpp<0x114, 0xf>(0.f, v); v += upd_dpp<0x118, 0xf>(0.f, v);
    v += upd_dpp<0x142, 0xa>(0.f, v); v += upd_dpp<0x143, 0xc>(0.f, v); return v; }
__device__ __forceinline__ float dpp_scan_max(float v) {
    const float ninf = -__builtin_inff();
    v = fmaxf(v, upd_dpp<0x111, 0xf>(ninf, v)); v = fmaxf(v, upd_dpp<0x112, 0xf>(ninf, v)); v = fmaxf(v, upd_dpp<0x114, 0xf>(ninf, v)); v = fmaxf(v, upd_dpp<0x118, 0xf>(ninf, v));
    v = fmaxf(v, upd_dpp<0x142, 0xa>(ninf, v)); v = fmaxf(v, upd_dpp<0x143, 0xc>(ninf, v)); return v; }
__device__ __forceinline__ float read_lane63(float v) { return __builtin_bit_cast(float, __builtin_amdgcn_readlane(__builtin_bit_cast(int, v), 63)); }
__device__ __forceinline__ float dpp_wave_sum(float v) { return read_lane63(dpp_scan_add(v)); }
#define LDS_WAIT() asm volatile("s_waitcnt lgkmcnt(0)" ::: "memory")
#define VM_WAIT() asm volatile("s_waitcnt vmcnt(0)" ::: "memory")
#define WAVE_SYNC() do { asm volatile("s_waitcnt lgkmcnt(0)" ::: "memory"); __builtin_amdgcn_wave_barrier(); } while (0)

#define XB_TMO      128
#define XB_XCNT(j)  (256  + 64 * (j))
#define XB_XSUB(j)  (1280 + 64 * (j))
#define XB_XGEN(j)  (2304 + 64 * (j))
#define XB_TOP      3328
#define XB_TOPGEN   3392
#define XCD_BAR_WORDS 3456
#define XB_SPIN_CAP (1u << 18)
__device__ __forceinline__ unsigned xb_ld(unsigned* p)              { return __hip_atomic_load(p, __ATOMIC_RELAXED, __HIP_MEMORY_SCOPE_AGENT); }
__device__ __forceinline__ unsigned xb_add(unsigned* p, unsigned v) { return __hip_atomic_fetch_add(p, v, __ATOMIC_RELAXED, __HIP_MEMORY_SCOPE_AGENT); }
__device__ __forceinline__ unsigned xb_xcc_id() { return (unsigned)__builtin_amdgcn_s_getreg((3 << 11) | 20) & 0xFu; }
#define XB_SPIN(cond, bar) do { unsigned _sp = 0; while (cond) { __builtin_amdgcn_s_sleep(1); \
    if ((++_sp & 255u) == 0u) { if (xb_ld(&(bar)[XB_TMO])) break; if (_sp > XB_SPIN_CAP) { atomicAdd(&(bar)[XB_TMO], 1u); break; } } } } while (0)
struct XcdBarrier { unsigned* bar; unsigned x; volatile LAS unsigned* st; };
__device__ __forceinline__ XcdBarrier xcd_barrier_post(unsigned* bar, volatile LAS unsigned* st) {
    XcdBarrier b; b.bar = bar; b.x = xb_xcc_id(); b.st = st;
    if (threadIdx.x == 0) (void)xb_add(&bar[XB_XCNT(b.x)], 1u);
    return b;
}
__device__ __forceinline__ void xcd_barrier_complete(unsigned* bar, unsigned x, unsigned& nloc, unsigned& nx) {
    const unsigned G = gridDim.x * gridDim.y * gridDim.z;
    unsigned sum, cnt, mine, sp = 0u;
    for (;;) {
        sum = 0u; cnt = 0u; mine = 0u;
#pragma unroll
        for (unsigned j = 0; j < 16; ++j) { const unsigned c = xb_ld(&bar[XB_XCNT(j)]); sum += c; cnt += (c > 0u) ? 1u : 0u; mine = (j == x) ? c : mine; }
        if (sum == G) break;
        __builtin_amdgcn_s_sleep(1);
        if ((++sp & 255u) == 0u) { if (xb_ld(&bar[XB_TMO])) break; if (sp > XB_SPIN_CAP) { atomicAdd(&bar[XB_TMO], 1u); break; } }
    }
    nloc = mine > 0u ? mine : 1u; nx = cnt > 0u ? cnt : 1u;
}
__device__ __forceinline__ void xcd_barrier(const XcdBarrier& b) {
    asm volatile("s_waitcnt vmcnt(0)" ::: "memory");
    __syncthreads();
    if (threadIdx.x == 0) {
        unsigned* bar = b.bar;
        __builtin_amdgcn_s_waitcnt(0);
        unsigned nloc = b.st[0], nx = b.st[1];
        if (nloc == 0u) { xcd_barrier_complete(bar, b.x, nloc, nx); b.st[0] = nloc; b.st[1] = nx; }
        const unsigned old = xb_add(&bar[XB_XSUB(b.x)], 1u);
        const unsigned gen = old / nloc;
        if (old + 1u == (gen + 1u) * nloc) {
            __builtin_amdgcn_fence(__ATOMIC_RELEASE, "agent");
            asm volatile("s_waitcnt vmcnt(0)" ::: "memory");
            const unsigned og = xb_add(&bar[XB_TOP], 1u);
            const unsigned tg = og / nx;
            if (og + 1u == (tg + 1u) * nx) xb_add(&bar[XB_TOPGEN], 1u);
            else XB_SPIN(xb_ld(&bar[XB_TOPGEN]) == tg, bar);
            __builtin_amdgcn_fence(__ATOMIC_ACQUIRE, "agent");
            xb_add(&bar[XB_XGEN(b.x)], 1u);
            asm volatile("s_waitcnt vmcnt(0)" ::: "memory");
        } else {
            XB_SPIN(xb_ld(&bar[XB_XGEN(b.x)]) == gen, bar);
            __builtin_amdgcn_fence(__ATOMIC_ACQUIRE, "agent");
            asm volatile("s_waitcnt vmcnt(0)" ::: "memory");
        }
    }
    __syncthreads();
}

#define GB_WORD(j) (XCD_BAR_WORDS + 64 + 64 * (j))
__device__ __forceinline__ XcdBarrier xcd_barrier_post_ranked(unsigned* bar, volatile LAS unsigned* st) {
    XcdBarrier b; b.bar = bar; b.x = xb_xcc_id(); b.st = st;
    if (threadIdx.x == 0) st[3] = xb_add(&bar[XB_XCNT(b.x)], 1u);
    return b;
}
__device__ __forceinline__ void grp_barrier(const XcdBarrier& b) {
    asm volatile("s_waitcnt vmcnt(0)" ::: "memory");
    __syncthreads();
    if (threadIdx.x == 0) {
        unsigned* gb = &b.bar[GB_WORD(b.x)];
        const unsigned nloc = b.st[0];
        const unsigned old = xb_add(gb, 1u);
        const unsigned target = (old / nloc + 1u) * nloc;
        if (old + 1u < target) XB_SPIN(xb_ld(gb) < target, b.bar);
        asm volatile("buffer_inv sc0\n\ts_waitcnt vmcnt(0)" ::: "memory");
    }
    __syncthreads();
}

namespace pg8 {
constexpr int BM = 256, BK = 64, HALF = 128, HTB = HALF * BK * 2, STAGE_BYTES = 8 * HTB, NXCD = 8, WGM = 8;
__host__ __device__ __forceinline__ int lds_byte(int r, int c) { const int st = (r >> 4) * 2 + (c >> 5), rr = r & 15, cc = c & 31, ob = rr * 64 + cc * 2; return st * 1024 + (ob ^ (((ob >> 9) & 1) << 5)); }
__host__ __device__ __forceinline__ void stage_rc(int b, int& R, int& C) { const int st = b / 1024, sb = b % 1024, swz = sb ^ (((sb >> 9) & 1) << 5); R = (st >> 1) * 16 + swz / 64; C = (st & 1) * 32 + (swz % 64) / 2; }
__host__ __device__ __forceinline__ int perm32(int rho) { const int n = rho >> 4, i = rho & 15; return 8 * (i >> 2) + 4 * n + (i & 3); }
struct Unit { int pm, pn, z; };
struct StaticOrder {
    int nM, nN, nwg, G, c;
    __device__ void init(int M, int N, int G_, int c_) { nM = M / BM; nN = N / BM; nwg = nM * nN; G = G_; c = c_; }
    __device__ bool next(int i, Unit& u) const {
        const long L = (long)i * G + c; if (L >= nwg) return false;
        int wgid = (int)L; { const int q = nwg / NXCD, r = nwg % NXCD, xcd = wgid % NXCD, off = wgid / NXCD; wgid = (xcd < r ? xcd * (q + 1) : r * (q + 1) + (xcd - r) * q) + off; }
        const int nig = WGM * nN, gid = wgid / nig, fm = gid * WGM, gsz = (nM - fm) < WGM ? (nM - fm) : WGM;
        u.pm = fm + ((wgid % nig) % gsz); u.pn = (wgid % nig) / gsz; return true;
    }
};
template <class Epi, int GN, int GK, int LDA, int LDB, bool KD = false>
__device__ __forceinline__ void gemm_phase(LAS unsigned char* lds, const bf16* gA, const bf16* gBt, const int G, const int cid, const int tid, const Epi& E, const int Mrows = MH) {
    const int wid = __builtin_amdgcn_readfirstlane(tid >> 6), lane = tid & 63, wr = wid >> 2, wc = wid & 3, fr = lane & 15, fq = lane >> 4;
    constexpr int nt = GK / BK;
    StaticOrder S; S.init(Mrows, GN, G, cid);
    unsigned voffA, voffB;
    { int R, C; stage_rc(tid * 16, R, C); const int Rb = (R & ~31) + perm32(R & 31); voffA = (unsigned)(R * LDA + C) * 2u; voffB = (unsigned)(Rb * LDB + C) * 2u; }
    constexpr size_t voffA_R64 = (size_t)64 * LDA * 2, voffB_R64 = (size_t)64 * LDB * 2;
    constexpr size_t kstep = (size_t)(BK * 2);
    constexpr size_t hstepA = (size_t)HALF * LDA * 2, hstepB = (size_t)HALF * LDB * 2;
    constexpr size_t tstepA = 2 * hstepA, tstepB = 2 * hstepB;
    const unsigned ldsw = (unsigned)wid * 1024u;
    const int aoff = lds_byte(wr * 64 + fr, fq * 8), boff = lds_byte(wc * 32 + fr, fq * 8);
    const unsigned ldsd = (unsigned)(__SIZE_TYPE__)lds + ldsw;
#define PG8_SA(b, h) (((b) * 2 + (h)) * HTB)
#define PG8_SB(b, h) ((4 + (b) * 2 + (h)) * HTB)
#define PG8_STAGE(bufoff, gbase, voff) do { _Pragma("unroll") for (int _i = 0; _i < 2; ++_i) \
        asm volatile("s_mov_b32 m0, %0\n\ts_nop 0\n\tglobal_load_lds_dwordx4 %1, %2" :: "s"(ldsd + (unsigned)((bufoff) + _i * 8192)), "v"(voff), "s"((const char*)(gbase) + (size_t)_i * (voff##_R64)) : "m0", "memory"); } while (0)
#define PG8_LDA(dst, b, h) do { _Pragma("unroll") for (int m = 0; m < 4; ++m) _Pragma("unroll") for (int k = 0; k < 2; ++k) dst[m][k] = *(const LAS bf16x8*)(lds + PG8_SA(b, h) + aoff + m * 2048 + k * 1024); } while (0)
#define PG8_LDB(dst, b, h) do { _Pragma("unroll") for (int n = 0; n < 2; ++n) _Pragma("unroll") for (int k = 0; k < 2; ++k) dst[n][k] = *(const LAS bf16x8*)(lds + PG8_SB(b, h) + boff + n * 2048 + k * 1024); } while (0)
#define PG8_MMA(ai, bj, At, Bt) do { __builtin_amdgcn_s_setprio(1); _Pragma("unroll") for (int m = 0; m < 4; ++m) _Pragma("unroll") for (int n = 0; n < 2; ++n) _Pragma("unroll") for (int k = 0; k < 2; ++k) \
        acc[ai][bj][m][n] = __builtin_amdgcn_mfma_f32_16x16x32_bf16(Bt[n][k], At[m][k], acc[ai][bj][m][n], 0, 0, 0); __builtin_amdgcn_s_setprio(0); } while (0)
#define PG8_WAIT_V(n) asm volatile("s_waitcnt vmcnt(" #n ")" ::: "memory")
#define PG8_WAIT_L(n) asm volatile("s_waitcnt lgkmcnt(" #n ")" ::: "memory")
#define PG8_BAR __builtin_amdgcn_s_barrier()
#define PG8_SCHED __builtin_amdgcn_sched_barrier(0)
    Unit cur, nxt; int ui = 0;
    if (!S.next(0, cur)) return;
    f32x4 acc[2][2][4][2];
#pragma unroll
    for (int a = 0; a < 2; ++a)
#pragma unroll
        for (int b = 0; b < 2; ++b)
#pragma unroll
            for (int m = 0; m < 4; ++m)
#pragma unroll
                for (int n = 0; n < 2; ++n) acc[a][b][m][n] = (f32x4){0.f, 0.f, 0.f, 0.f};
    bf16x8 At[4][2], B0[2][2], B1[2][2];
    const char* cA = (const char*)gA + (size_t)cur.pm * tstepA + (KD ? (size_t)cur.pn * GK * 2 : 0); const char* cB = (const char*)gBt + (size_t)cur.pn * tstepB + (KD ? (size_t)cur.pn * GK * 2 : 0);
    PG8_STAGE(PG8_SB(0, 0), cB, voffB); PG8_STAGE(PG8_SB(0, 1), cB + hstepB, voffB); PG8_STAGE(PG8_SA(0, 0), cA, voffA); PG8_STAGE(PG8_SA(0, 1), cA + hstepA, voffA);
    if (wr == 1) PG8_BAR;
    PG8_WAIT_V(2); PG8_BAR;
    PG8_STAGE(PG8_SB(1, 0), cB + kstep, voffB); PG8_STAGE(PG8_SA(1, 0), cA + kstep, voffA); PG8_STAGE(PG8_SB(1, 1), cB + hstepB + kstep, voffB);
    PG8_WAIT_V(6); PG8_BAR;
    for (;;) {
        const bool has_next = S.next(ui + 1, nxt);
        const char* nA = has_next ? (const char*)gA + (size_t)nxt.pm * tstepA + (KD ? (size_t)nxt.pn * GK * 2 : 0) : cA; const char* nB = has_next ? (const char*)gBt + (size_t)nxt.pn * tstepB + (KD ? (size_t)nxt.pn * GK * 2 : 0) : cB;
#pragma unroll 1
        for (int t = 0; t < nt; t += 2) {
            const bool last = (t == nt - 2);
            const char* a1 = cA + (size_t)(t + 1) * kstep;
            const char* a2 = last ? nA : cA + (size_t)(t + 2) * kstep; const char* b2 = last ? nB : cB + (size_t)(t + 2) * kstep;
            const char* a3 = a2 + kstep; const char* b3 = b2 + kstep;
            PG8_LDB(B0, 0, 0); PG8_LDB(B1, 0, 1); PG8_SCHED; PG8_LDA(At, 0, 0); PG8_STAGE(PG8_SA(1, 1), a1 + hstepA, voffA);
            PG8_WAIT_V(8); PG8_WAIT_L(0); PG8_BAR; PG8_MMA(0, 0, At, B0); PG8_MMA(0, 1, At, B1); PG8_BAR; PG8_SCHED;
            PG8_LDA(At, 0, 1); PG8_STAGE(PG8_SB(0, 0), b2, voffB); PG8_STAGE(PG8_SB(0, 1), b2 + hstepB, voffB); PG8_STAGE(PG8_SA(0, 0), a2, voffA);
            PG8_WAIT_V(8); PG8_WAIT_L(0); PG8_BAR; PG8_MMA(1, 0, At, B0); PG8_MMA(1, 1, At, B1); PG8_BAR; PG8_SCHED;
            PG8_LDB(B0, 1, 0); PG8_LDB(B1, 1, 1); PG8_SCHED; PG8_LDA(At, 1, 0); PG8_STAGE(PG8_SA(0, 1), a2 + hstepA, voffA);
            PG8_WAIT_V(8); PG8_WAIT_L(0); PG8_BAR; PG8_MMA(0, 0, At, B0); PG8_MMA(0, 1, At, B1); PG8_BAR; PG8_SCHED;
            PG8_LDA(At, 1, 1); PG8_STAGE(PG8_SB(1, 0), b3, voffB); PG8_STAGE(PG8_SB(1, 1), b3 + hstepB, voffB); PG8_STAGE(PG8_SA(1, 0), a3, voffA);
            PG8_WAIT_V(8); PG8_WAIT_L(0); PG8_BAR; PG8_MMA(1, 0, At, B0); PG8_MMA(1, 1, At, B1); PG8_BAR; PG8_SCHED;
        }
        if (wr == 0) PG8_BAR;
        E(acc, cur, wr, wc);
        if (!has_next) break;
#pragma unroll
        for (int a = 0; a < 2; ++a)
#pragma unroll
            for (int b = 0; b < 2; ++b)
#pragma unroll
                for (int m = 0; m < 4; ++m)
#pragma unroll
                    for (int n = 0; n < 2; ++n) acc[a][b][m][n] = (f32x4){0.f, 0.f, 0.f, 0.f};
        cur = nxt; cA = nA; cB = nB; ++ui;
        if (wr == 1) PG8_BAR;
    }
    PG8_WAIT_V(0);
    PG8_BAR;
#undef PG8_SA
#undef PG8_SB
#undef PG8_STAGE
#undef PG8_LDA
#undef PG8_LDB
#undef PG8_MMA
#undef PG8_WAIT_V
#undef PG8_WAIT_L
#undef PG8_BAR
#undef PG8_SCHED
}
__device__ __forceinline__ f32x4 zero4v() { f32x4 z; asm volatile("v_mov_b32 %0, 0\n\tv_mov_b32 %1, 0\n\tv_mov_b32 %2, 0\n\tv_mov_b32 %3, 0" : "=v"(z[0]), "=v"(z[1]), "=v"(z[2]), "=v"(z[3])); return z; }
__device__ __forceinline__ i32x8 ld32(const LAS unsigned char* p) { const u32x4 x = *(const LAS u32x4*)p, y = *(const LAS u32x4*)(p + 1024); return (i32x8){(int)x.x, (int)x.y, (int)x.z, (int)x.w, (int)y.x, (int)y.y, (int)y.z, (int)y.w}; }
template <class Epi, int GN, int GKB>
__device__ __forceinline__ void gemm_phase8(LAS unsigned char* lds, const unsigned char* gA, const unsigned char* gBt, const int G, const int cid, const int tid, const Epi& E) {
    const int wid = __builtin_amdgcn_readfirstlane(tid >> 6), lane = tid & 63, wr = wid >> 2, wc = wid & 3, fr = lane & 15, fq = lane >> 4;
    constexpr int nt = GKB / 128;
    StaticOrder S; S.init(MH, GN, G, cid);
    unsigned voffA, voffB;
    { int R, C; stage_rc(tid * 16, R, C); const int Rb = (R & ~31) + perm32(R & 31); voffA = (unsigned)(R * GKB + C * 2); voffB = (unsigned)(Rb * GKB + C * 2); }
    constexpr size_t voffA_R64 = (size_t)64 * GKB, voffB_R64 = (size_t)64 * GKB;
    constexpr size_t kstep = (size_t)(BK * 2);
    constexpr size_t hstepA = (size_t)HALF * GKB, hstepB = (size_t)HALF * GKB;
    constexpr size_t tstepA = 2 * hstepA, tstepB = 2 * hstepB;
    const unsigned ldsw = (unsigned)wid * 1024u;
    const int aoff = lds_byte(wr * 64 + fr, fq * 8), boff = lds_byte(wc * 32 + fr, fq * 8);
#define PG8_SA(b, h) (((b) * 2 + (h)) * HTB)
#define PG8_SB(b, h) ((4 + (b) * 2 + (h)) * HTB)
    const unsigned ldsd = (unsigned)(__SIZE_TYPE__)lds + ldsw;
#define PG8_STAGE(bufoff, gbase, voff) do { _Pragma("unroll") for (int _i = 0; _i < 2; ++_i) \
        asm volatile("s_mov_b32 m0, %0\n\ts_nop 0\n\tglobal_load_lds_dwordx4 %1, %2" :: "s"(ldsd + (unsigned)((bufoff) + _i * 8192)), "v"(voff), "s"((const char*)(gbase) + (size_t)_i * (voff##_R64)) : "m0", "memory"); } while (0)
#define PG8_LD32(p_) ld32(p_)
#define PG8_LDA(dst, b, h) do { _Pragma("unroll") for (int m = 0; m < 4; ++m) dst[m] = PG8_LD32(lds + PG8_SA(b, h) + aoff + m * 2048); } while (0)
#define PG8_LDB(dst, b, h) do { _Pragma("unroll") for (int n = 0; n < 2; ++n) dst[n] = PG8_LD32(lds + PG8_SB(b, h) + boff + n * 2048); } while (0)
#define PG8_MMA(ai, bj, At, Bt) do { __builtin_amdgcn_s_setprio(1); _Pragma("unroll") for (int m = 0; m < 4; ++m) _Pragma("unroll") for (int n = 0; n < 2; ++n) \
        acc[ai][bj][m][n] = __builtin_amdgcn_mfma_scale_f32_16x16x128_f8f6f4(Bt[n], At[m], acc[ai][bj][m][n], 0, 0, 0, 127, 0, 127); __builtin_amdgcn_s_setprio(0); } while (0)
#define PG8_WAIT_V(n) asm volatile("s_waitcnt vmcnt(" #n ")" ::: "memory")
#define PG8_WAIT_L(n) asm volatile("s_waitcnt lgkmcnt(" #n ")" ::: "memory")
#define PG8_BAR __builtin_amdgcn_s_barrier()
#define PG8_SCHED __builtin_amdgcn_sched_barrier(0)
    Unit cur, nxt; int ui = 0;
    if (!S.next(0, cur)) return;
    f32x4 acc[2][2][4][2];
#pragma unroll
    for (int a = 0; a < 2; ++a)
#pragma unroll
        for (int b = 0; b < 2; ++b)
#pragma unroll
            for (int m = 0; m < 4; ++m)
#pragma unroll
                for (int n = 0; n < 2; ++n) acc[a][b][m][n] = zero4v();
    i32x8 At[4], B0[2], B1[2];
    const char* cA = (const char*)gA + (size_t)cur.pm * tstepA; const char* cB = (const char*)gBt + (size_t)cur.pn * tstepB;
    PG8_STAGE(PG8_SB(0, 0), cB, voffB); PG8_STAGE(PG8_SB(0, 1), cB + hstepB, voffB); PG8_STAGE(PG8_SA(0, 0), cA, voffA); PG8_STAGE(PG8_SA(0, 1), cA + hstepA, voffA);
    if (wr == 1) PG8_BAR;
    PG8_WAIT_V(2); PG8_BAR;
    PG8_STAGE(PG8_SB(1, 0), cB + kstep, voffB); PG8_STAGE(PG8_SA(1, 0), cA + kstep, voffA); PG8_STAGE(PG8_SB(1, 1), cB + hstepB + kstep, voffB);
    PG8_WAIT_V(6); PG8_BAR;
    for (;;) {
        const bool has_next = S.next(ui + 1, nxt);
        const char* nA = has_next ? (const char*)gA + (size_t)nxt.pm * tstepA : cA; const char* nB = has_next ? (const char*)gBt + (size_t)nxt.pn * tstepB : cB;
#pragma unroll 1
        for (int t = 0; t < nt; t += 2) {
            const bool last = (t == nt - 2);
            const char* a1 = cA + (size_t)(t + 1) * kstep;
            const char* a2 = last ? nA : cA + (size_t)(t + 2) * kstep; const char* b2 = last ? nB : cB + (size_t)(t + 2) * kstep;
            const char* a3 = a2 + kstep; const char* b3 = b2 + kstep;
            PG8_LDB(B0, 0, 0); PG8_LDB(B1, 0, 1); PG8_SCHED; PG8_LDA(At, 0, 0); PG8_STAGE(PG8_SA(1, 1), a1 + hstepA, voffA);
            PG8_WAIT_V(8); PG8_WAIT_L(0); PG8_BAR; PG8_MMA(0, 0, At, B0); PG8_MMA(0, 1, At, B1); PG8_BAR; PG8_SCHED;
            PG8_LDA(At, 0, 1); PG8_STAGE(PG8_SB(0, 0), b2, voffB); PG8_STAGE(PG8_SB(0, 1), b2 + hstepB, voffB); PG8_STAGE(PG8_SA(0, 0), a2, voffA);
            PG8_WAIT_V(8); PG8_WAIT_L(0); PG8_BAR; PG8_MMA(1, 0, At, B0); PG8_MMA(1, 1, At, B1); PG8_BAR; PG8_SCHED;
            PG8_LDB(B0, 1, 0); PG8_LDB(B1, 1, 1); PG8_SCHED; PG8_LDA(At, 1, 0); PG8_STAGE(PG8_SA(0, 1), a2 + hstepA, voffA);
            PG8_WAIT_V(8); PG8_WAIT_L(0); PG8_BAR; PG8_MMA(0, 0, At, B0); PG8_MMA(0, 1, At, B1); PG8_BAR; PG8_SCHED;
            PG8_LDA(At, 1, 1); PG8_STAGE(PG8_SB(1, 0), b3, voffB); PG8_STAGE(PG8_SB(1, 1), b3 + hstepB, voffB); PG8_STAGE(PG8_SA(1, 0), a3, voffA);
            PG8_WAIT_V(8); PG8_WAIT_L(0); PG8_BAR; PG8_MMA(1, 0, At, B0); PG8_MMA(1, 1, At, B1); PG8_BAR; PG8_SCHED;
        }
        if (wr == 0) PG8_BAR;
        E(acc, cur, wr, wc);
        if (!has_next) break;
#pragma unroll
        for (int a = 0; a < 2; ++a)
#pragma unroll
            for (int b = 0; b < 2; ++b)
#pragma unroll
                for (int m = 0; m < 4; ++m)
#pragma unroll
                    for (int n = 0; n < 2; ++n) acc[a][b][m][n] = zero4v();
        cur = nxt; cA = nA; cB = nB; ++ui;
        if (wr == 1) PG8_BAR;
    }
    PG8_WAIT_V(0);
    PG8_BAR;
#undef PG8_LD32
#undef PG8_SA
#undef PG8_SB
#undef PG8_STAGE
#undef PG8_LDA
#undef PG8_LDB
#undef PG8_MMA
#undef PG8_WAIT_V
#undef PG8_WAIT_L
#undef PG8_BAR
#undef PG8_SCHED
}
}

__device__ __forceinline__ void unpack8(const u32x4 w, float (&f)[8]) {
    f[0] = bflo(w.x); f[1] = bfhi(w.x); f[2] = bflo(w.y); f[3] = bfhi(w.y); f[4] = bflo(w.z); f[5] = bfhi(w.z); f[6] = bflo(w.w); f[7] = bfhi(w.w);
}
__device__ __forceinline__ u32x4 pack8(const float (&f)[8]) {
    u32x4 w; w.x = cvt_pk_bf16(f[0], f[1]); w.y = cvt_pk_bf16(f[2], f[3]); w.z = cvt_pk_bf16(f[4], f[5]); w.w = cvt_pk_bf16(f[6], f[7]); return w;
}
__device__ __forceinline__ void acc8(const f32x4 a, const f32x4 b, float (&f)[8]) { f[0] = a[0]; f[1] = a[1]; f[2] = a[2]; f[3] = a[3]; f[4] = b[0]; f[5] = b[1]; f[6] = b[2]; f[7] = b[3]; }

#define EPI_ROWS(LD_) _Pragma("unroll") for (int ai = 0; ai < 2; ++ai) _Pragma("unroll") for (int m = 0; m < 4; ++m) _Pragma("unroll") for (int bj = 0; bj < 2; ++bj)
#define EPI_OFF(LD_) (((unsigned)(row0 + ai * 128 + m * 16) * (unsigned)(LD_) + (unsigned)(col0 + bj * 128)) * 2u)
struct EpiProj {
    bf16* seg; bf16* gate;
    template <int ACT, int LD> __device__ __forceinline__ void body(const f32x4 (&acc)[2][2][4][2], unsigned char* base, int row0, int col0) const {
        EPI_ROWS(LD) { float v[8]; acc8(acc[ai][bj][m][0], acc[ai][bj][m][1], v);
            if (ACT == 1) {
#pragma unroll
                for (int e = 0; e < 8; ++e) v[e] = v[e] * fsigmoid(v[e]); }
            if (ACT == 2) {
#pragma unroll
                for (int e = 0; e < 8; ++e) v[e] = fsigmoid(v[e]); }
            __builtin_nontemporal_store(pack8(v), (u32x4*)(base + EPI_OFF(LD))); __builtin_amdgcn_sched_barrier(0); }
    }
    template <int SILU> static __device__ __forceinline__ u32x2 pr4(const f32x4 p, f32x4 q) {
        if (SILU) {
#pragma unroll
            for (int e = 0; e < 4; ++e) q[e] = q[e] * fsigmoid(q[e]); }
        const f32x4 r = p * q; u32x2 w; w.x = cvt_pk_bf16(r[0], r[1]); w.y = cvt_pk_bf16(r[2], r[3]); return w; }
    template <int SILU> __device__ __forceinline__ void pair(const f32x4 (&acc)[2][2][4][2], unsigned char* base, int row0, int col0h) const {
#pragma unroll
        for (int ai = 0; ai < 2; ++ai)
#pragma unroll
            for (int j = 0; j < 2; ++j)
#pragma unroll
                for (int bj = 0; bj < 2; ++bj) {
                    const u32x2 c0 = pr4<SILU>(acc[ai][bj][2 * j][0], acc[ai][bj][2 * j][1]), c1 = pr4<SILU>(acc[ai][bj][2 * j + 1][0], acc[ai][bj][2 * j + 1][1]);
                    const auto sx = __builtin_amdgcn_permlane16_swap(c0.x, c1.x, false, false); const auto sy = __builtin_amdgcn_permlane16_swap(c0.y, c1.y, false, false);
                    const u32x4 w = {sx[0], sy[0], sx[1], sy[1]};
                    __builtin_nontemporal_store(w, (u32x4*)(base + ((unsigned)(row0 + ai * 128 + j * 32) * (unsigned)BW + (unsigned)(col0h + bj * 64)) * 2u)); __builtin_amdgcn_sched_barrier(0); }
    }
    __device__ __forceinline__ void operator()(const f32x4 (&acc)[2][2][4][2], const pg8::Unit& u, int wr, int wc) const {
        const int lane_ = fresh_lane(), fr = lane_ & 15, fq = lane_ >> 4;
        const int pn = u.pn; const int row0 = u.pm * 256 + wr * 64 + fr;
        if (pn >= 8 && pn < 16) { const int par = fq & 1, col0h = (pn & 3) * 128 + wc * 16 + 4 * (fq - par), row0p = row0 + par * 16;
            if (pn < 12) pair<0>(acc, (unsigned char*)(seg + (size_t)SG_SCX * MH * BW), row0p, col0h); else pair<1>(acc, (unsigned char*)(seg + (size_t)SG_SCB * MH * BW), row0p, col0h); }
        else if (pn < 26) { const int sg = pn >> 1; unsigned char* base = (unsigned char*)(seg + (size_t)sg * MH * BW); const int col0 = (pn & 1) * 256 + wc * 32 + 8 * fq;
            const int act = (sg == SG_S5Z || sg == SG_PZ || sg == SG_SCZ || sg == SG_MZ) ? 1 : (sg == SG_O ? 2 : 0);
            if (act == 0) body<0, BW>(acc, base, row0, col0); else if (act == 1) body<1, BW>(acc, base, row0, col0); else body<2, BW>(acc, base, row0, col0); }
        else { const int gg = pn - 26; unsigned char* base = (unsigned char*)(gate + (size_t)(gg >> 2) * MH * D); const int col0 = (gg & 3) * 256 + wc * 32 + 8 * fq;
            body<2, D>(acc, base, row0, col0); }
    }
};
__device__ __forceinline__ u32x2 pack8_u8(const float (&f)[8]) { unsigned a = 0u, b = 0u;
    a = __builtin_amdgcn_cvt_pk_u8_f32(f[0], 0, a); a = __builtin_amdgcn_cvt_pk_u8_f32(f[1], 1, a); a = __builtin_amdgcn_cvt_pk_u8_f32(f[2], 2, a); a = __builtin_amdgcn_cvt_pk_u8_f32(f[3], 3, a);
    b = __builtin_amdgcn_cvt_pk_u8_f32(f[4], 0, b); b = __builtin_amdgcn_cvt_pk_u8_f32(f[5], 1, b); b = __builtin_amdgcn_cvt_pk_u8_f32(f[6], 2, b); b = __builtin_amdgcn_cvt_pk_u8_f32(f[7], 3, b); return (u32x2){a, b}; }
__device__ __forceinline__ void unpack8_u8(const u32x2 w, float (&f)[8]) {
    f[0] = (float)(w.x & 0xffu); f[1] = (float)((w.x >> 8) & 0xffu); f[2] = (float)((w.x >> 16) & 0xffu); f[3] = (float)(w.x >> 24);
    f[4] = (float)(w.y & 0xffu); f[5] = (float)((w.y >> 8) & 0xffu); f[6] = (float)((w.y >> 16) & 0xffu); f[7] = (float)(w.y >> 24); }
#define EPI_OFFB(LD_) ((unsigned)(row0 + ai * 128 + m * 16) * (unsigned)(LD_) + (unsigned)(col0 + bj * 128))
struct EpiGate8 {
    unsigned char* gate;
    static __device__ __forceinline__ u32x2 g8(const f32x4 p, const f32x4 q) { float v[8]; acc8(p, q, v);
#pragma unroll
        for (int e = 0; e < 8; ++e) v[e] = __builtin_amdgcn_rcpf((1.0f / 255.f) + __builtin_amdgcn_exp2f(__builtin_fmaf(v[e], -LOG2E / W8_SCALE, -7.99435343685885794f)));
        return pack8_u8(v); }
    __device__ __forceinline__ void operator()(const f32x4 (&acc)[2][2][4][2], const pg8::Unit& u, int wr, int wc) const {
        const int lane_ = fresh_lane(), fr = lane_ & 15, fq = lane_ >> 4, par = fq & 1;
        const int row0 = u.pm * 256 + wr * 64 + fr + par * 16, col0 = (u.pn & 3) * 256 + wc * 32 + 8 * (fq - par);
        unsigned char* base = gate + (size_t)(u.pn >> 2) * MH * D;
#pragma unroll
        for (int ai = 0; ai < 2; ++ai)
#pragma unroll
            for (int j = 0; j < 2; ++j)
#pragma unroll
                for (int bj = 0; bj < 2; ++bj) {
                    const u32x2 c0 = g8(acc[ai][bj][2 * j][0], acc[ai][bj][2 * j][1]), c1 = g8(acc[ai][bj][2 * j + 1][0], acc[ai][bj][2 * j + 1][1]);
                    const auto sx = __builtin_amdgcn_permlane16_swap(c0.x, c1.x, false, false); const auto sy = __builtin_amdgcn_permlane16_swap(c0.y, c1.y, false, false);
                    const u32x4 w = {sx[0], sy[0], sx[1], sy[1]};
                    __builtin_nontemporal_store(w, (u32x4*)(base + (unsigned)(row0 + ai * 128 + j * 32) * (unsigned)D + (unsigned)(col0 + bj * 128))); __builtin_amdgcn_sched_barrier(0); }
    }
};
#define EPI_HALF_ROWS _Pragma("unroll") for (int m = 0; m < 4; ++m) _Pragma("unroll") for (int bj = 0; bj < 2; ++bj)
#define EPI_QUART_ROWS _Pragma("unroll") for (int m = 2 * mh; m < 2 * mh + 2; ++m) _Pragma("unroll") for (int bj = 0; bj < 2; ++bj)
struct EpiGlu {
    const bf16* ya; bf16* io;
    __device__ __forceinline__ void operator()(const f32x4 (&acc)[2][2][4][2], const pg8::Unit& u, int wr, int wc) const {
        const int lane_ = fresh_lane(), fr = lane_ & 15, fq = lane_ >> 4;
        const int row0 = u.pm * 256 + wr * 64 + fr, col0 = u.pn * 256 + wc * 32 + 8 * fq;
        const unsigned char* yb = (const unsigned char*)ya; unsigned char* ib = (unsigned char*)io;
        u32x4 yq[2][2][2], zq[2][2][2];
#define GLU_LOAD(B_, q_) do { const int ai = (q_) >> 1, mh = (q_) & 1; _Pragma("unroll") for (int mm = 0; mm < 2; ++mm) _Pragma("unroll") for (int bj = 0; bj < 2; ++bj) { const int m = 2 * mh + mm; const unsigned off = EPI_OFF(BW); \
            yq[B_][mm][bj] = *(const u32x4*)(yb + off); zq[B_][mm][bj] = *(const u32x4*)(ib + off); } } while (0)
#define GLU_DO(B_, q_) do { const int ai = (q_) >> 1, mh = (q_) & 1; _Pragma("unroll") for (int mm = 0; mm < 2; ++mm) _Pragma("unroll") for (int bj = 0; bj < 2; ++bj) { const int m = 2 * mh + mm; const unsigned off = EPI_OFF(BW); \
            float v[8], y[8], z[8]; acc8(acc[ai][bj][m][0], acc[ai][bj][m][1], v); unpack8(yq[B_][mm][bj], y); unpack8(zq[B_][mm][bj], z); \
            _Pragma("unroll") for (int e = 0; e < 8; ++e) v[e] = y[e] * fsigmoid(v[e]) * z[e]; \
            *(u32x4*)(ib + off) = pack8(v); } } while (0)
        GLU_LOAD(0, 0);
        GLU_LOAD(1, 1); GLU_DO(0, 0);
        GLU_LOAD(0, 2); GLU_DO(1, 1);
        GLU_LOAD(1, 3); GLU_DO(0, 2);
        GLU_DO(1, 3);
#undef GLU_LOAD
#undef GLU_DO
    }
};
struct EpiPool {
    const float* scale; bf16* io;
    __device__ __forceinline__ void operator()(const f32x4 (&acc)[2][2][4][2], const pg8::Unit& u, int wr, int wc) const {
        const int lane_ = fresh_lane(), fr = lane_ & 15, fq = lane_ >> 4;
        const int row0 = u.pm * 256 + wr * 64 + fr, col0 = u.pn * 256 + wc * 32 + 8 * fq;
        unsigned char* ib = (unsigned char*)io;
        float sc[2][8];
#pragma unroll
        for (int bj = 0; bj < 2; ++bj) { const f32x4 s0 = *(const f32x4*)(scale + col0 + bj * 128), s1 = *(const f32x4*)(scale + col0 + bj * 128 + 4); acc8(s0, s1, sc[bj]); }
#pragma unroll
        for (int ai = 0; ai < 2; ++ai) {
            u32x4 zq[4][2];
            EPI_HALF_ROWS { zq[m][bj] = *(const u32x4*)(ib + EPI_OFF(BW)); }
            EPI_HALF_ROWS { float v[8], z[8]; acc8(acc[ai][bj][m][0], acc[ai][bj][m][1], v); unpack8(zq[m][bj], z);
#pragma unroll
                for (int e = 0; e < 8; ++e) v[e] = v[e] * sc[bj][e] * z[e];
                *(u32x4*)(ib + EPI_OFF(BW)) = pack8(v); }
        }
    }
};
struct EpiBranch {
    const unsigned char* gate; bf16* merged; int first;
    __device__ __forceinline__ void operator()(const f32x4 (&acc)[2][2][4][2], const pg8::Unit& u, int wr, int wc) const {
        const int lane_ = fresh_lane(), fr = lane_ & 15, fq = lane_ >> 4;
        const int row0 = u.pm * 256 + wr * 64 + fr, col0 = u.pn * 256 + wc * 32 + 8 * fq;
        const unsigned char* gb = gate; unsigned char* mb = (unsigned char*)merged;
        if (first) {
            u32x2 gq[2][4][2];
            EPI_ROWS(D) { gq[ai][m][bj] = *(const u32x2*)(gb + EPI_OFFB(D)); }
            EPI_ROWS(D) { float v[8], g[8]; acc8(acc[ai][bj][m][0], acc[ai][bj][m][1], v); unpack8_u8(gq[ai][m][bj], g);
#pragma unroll
                for (int e = 0; e < 8; ++e) v[e] = v[e] * (g[e] * (1.0f / 255.f));
                *(u32x4*)(mb + EPI_OFF(D)) = pack8(v); }
        } else {
#pragma unroll
            for (int ai = 0; ai < 2; ++ai) {
                u32x2 gq[4][2]; u32x4 oq[4][2];
                EPI_HALF_ROWS { gq[m][bj] = *(const u32x2*)(gb + EPI_OFFB(D)); oq[m][bj] = *(const u32x4*)(mb + EPI_OFF(D)); }
                EPI_HALF_ROWS { float v[8], g[8], o[8]; acc8(acc[ai][bj][m][0], acc[ai][bj][m][1], v); unpack8_u8(gq[m][bj], g); unpack8(oq[m][bj], o);
#pragma unroll
                    for (int e = 0; e < 8; ++e) v[e] = o[e] + v[e] * (g[e] * (1.0f / 255.f));
                    *(u32x4*)(mb + EPI_OFF(D)) = pack8(v); }
            }
        }
    }
};
struct EpiOut {
    bf16* out; float* oss;
    __device__ __forceinline__ void operator()(const f32x4 (&acc)[2][2][4][2], const pg8::Unit& u, int wr, int wc) const {
        const int lane_ = fresh_lane(), fr = lane_ & 15, fq = lane_ >> 4;
        const int row0 = u.pm * 256 + wr * 64 + fr, col0 = u.pn * 256 + wc * 32 + 8 * fq;
        unsigned char* ob = (unsigned char*)out;
#pragma unroll
        for (int ai = 0; ai < 2; ++ai)
#pragma unroll
            for (int m = 0; m < 4; ++m) { const int row = row0 + ai * 128 + m * 16; float s = 0.f;
#pragma unroll
                for (int bj = 0; bj < 2; ++bj) { float v[8]; acc8(acc[ai][bj][m][0], acc[ai][bj][m][1], v);
#pragma unroll
                    for (int e = 0; e < 8; ++e) s += v[e] * v[e];
                    *(u32x4*)(ob + EPI_OFF(D)) = pack8(v); }
                s += shfl_x(s, 16, lane_); s += shfl_x(s, 32, lane_);
                if (fq == 0) oss[(unsigned)row * 16u + u.pn * 4 + wc] = s; }
    }
};

namespace pg8 {
struct A4 { const bf16* p[4]; };
__device__ __forceinline__ void gemm_merge_phase(LAS unsigned char* lds, const A4 a4, const bf16* gBt, const unsigned char* gate, bf16* merged, const int G, const int cid, const int tid) {
    constexpr int GK = BW, LDA = BW, LDB = BW, NT128 = D / 128;
    const int wid = __builtin_amdgcn_readfirstlane(tid >> 6), lane = tid & 63, wr = wid >> 2, wc = wid & 3, fr = lane & 15, fq = lane >> 4;
    constexpr int nt = GK / BK;
    StaticOrder S; S.nM = MH / BM; S.nN = NT128; S.nwg = S.nM * S.nN; S.G = G; S.c = cid;
    unsigned voffA, voffB;
    { int R, C; stage_rc(tid * 16, R, C); const int Rb = (R & ~31) + perm32(R & 31); voffA = (unsigned)(R * LDA + C) * 2u; voffB = (unsigned)(Rb * LDB + C) * 2u; }
    constexpr size_t voffA_R64 = (size_t)64 * LDA * 2, voffB_R64 = (size_t)64 * LDB * 2;
    constexpr size_t kstep = (size_t)(BK * 2);
    constexpr size_t hstepA = (size_t)HALF * LDA * 2, hstepB = (size_t)HALF * LDB * 2, tstepA = 2 * hstepA;
    const unsigned ldsw = (unsigned)wid * 1024u;
    const int aoff = lds_byte(wr * 64 + fr, fq * 8), boff = lds_byte(wc * 32 + fr, fq * 8);
    const unsigned ldsd = (unsigned)(__SIZE_TYPE__)lds + ldsw;
#define PGM_SA(b, h) (((b) * 2 + (h)) * HTB)
#define PGM_SB(b) ((4 + (b)) * HTB)
#define PGM_STAGE(bufoff, gbase, voff) do { _Pragma("unroll") for (int _i = 0; _i < 2; ++_i) \
        asm volatile("s_mov_b32 m0, %0\n\ts_nop 0\n\tglobal_load_lds_dwordx4 %1, %2" :: "s"(ldsd + (unsigned)((bufoff) + _i * 8192)), "v"(voff), "s"((const char*)(gbase) + (size_t)_i * (voff##_R64)) : "m0", "memory"); } while (0)
#define PGM_LDA(dst, b, h) do { _Pragma("unroll") for (int m = 0; m < 4; ++m) _Pragma("unroll") for (int k = 0; k < 2; ++k) dst[m][k] = *(const LAS bf16x8*)(lds + PGM_SA(b, h) + aoff + m * 2048 + k * 1024); } while (0)
#define PGM_LDB(dst, b) do { _Pragma("unroll") for (int n = 0; n < 2; ++n) _Pragma("unroll") for (int k = 0; k < 2; ++k) dst[n][k] = *(const LAS bf16x8*)(lds + PGM_SB(b) + boff + n * 2048 + k * 1024); } while (0)
#define PGM_MMA(ai, At, Bt) do { __builtin_amdgcn_s_setprio(1); _Pragma("unroll") for (int m = 0; m < 4; ++m) _Pragma("unroll") for (int n = 0; n < 2; ++n) _Pragma("unroll") for (int k = 0; k < 2; ++k) \
        acc[ai][m][n] = __builtin_amdgcn_mfma_f32_16x16x32_bf16(Bt[n][k], At[m][k], acc[ai][m][n], 0, 0, 0); __builtin_amdgcn_s_setprio(0); } while (0)
#define PGM_WAIT_V(n) asm volatile("s_waitcnt vmcnt(" #n ")" ::: "memory")
#define PGM_WAIT_L(n) asm volatile("s_waitcnt lgkmcnt(" #n ")" ::: "memory")
#define PGM_BAR __builtin_amdgcn_s_barrier()
#define PGM_SCHED __builtin_amdgcn_sched_barrier(0)
#define PGM_NEXT(i_, u_) (S.next((i_) >> 2, u_) ? ((u_).z = (i_) & 3, true) : false)
#define PGM_ABASE(u_) ((const char*)((u_).z == 0 ? a4.p[0] : (u_).z == 1 ? a4.p[1] : (u_).z == 2 ? a4.p[2] : a4.p[3]) + (size_t)(u_).pm * tstepA)
#define PGM_BBASE(u_) ((const char*)gBt + (size_t)(u_).z * ((size_t)D * LDB * 2) + (size_t)(u_).pn * hstepB)
#define PGM_GATES(u_) do { const unsigned char* gb_ = gate + (size_t)(u_).z * MH * D + (size_t)(u_).pm * 256 * D; \
        _Pragma("unroll") for (int ai = 0; ai < 2; ++ai) _Pragma("unroll") for (int m = 0; m < 4; ++m) gq[ai][m] = *(const u32x2*)(gb_ + goff + (unsigned)((ai * 128 + m * 16) * D)); } while (0)
    Unit cur, nxt; int ui = 0;
    if (!PGM_NEXT(0, cur)) return;
    f32x4 acc[2][4][2], msum[2][4][2]; u32x2 gq[2][4];
#pragma unroll
    for (int a = 0; a < 2; ++a)
#pragma unroll
        for (int m = 0; m < 4; ++m)
#pragma unroll
            for (int n = 0; n < 2; ++n) { acc[a][m][n] = (f32x4){0.f, 0.f, 0.f, 0.f}; msum[a][m][n] = (f32x4){0.f, 0.f, 0.f, 0.f}; }
    bf16x8 At[4][2], B0[2][2];
    const unsigned goff_lane = (unsigned)((wr * 64 + fr) * D + wc * 32 + 8 * fq);
    unsigned goff = goff_lane + (unsigned)cur.pn * 128u;
    const char* cA = PGM_ABASE(cur); const char* cB = PGM_BBASE(cur);
    PGM_GATES(cur);
    PGM_STAGE(PGM_SB(0), cB, voffB); PGM_STAGE(PGM_SA(0, 0), cA, voffA); PGM_STAGE(PGM_SA(0, 1), cA + hstepA, voffA);
    if (wr == 1) PGM_BAR;
    PGM_WAIT_V(2); PGM_BAR;
    PGM_STAGE(PGM_SB(1), cB + kstep, voffB); PGM_STAGE(PGM_SA(1, 0), cA + kstep, voffA);
    PGM_WAIT_V(4); PGM_BAR;
    for (;;) {
        const bool has_next = PGM_NEXT(ui + 1, nxt);
        const char* nA = has_next ? PGM_ABASE(nxt) : cA; const char* nB = has_next ? PGM_BBASE(nxt) : cB;
#pragma unroll 1
        for (int t = 0; t < nt; t += 2) {
            const bool last = (t == nt - 2);
            const char* a1 = cA + (size_t)(t + 1) * kstep;
            const char* a2 = last ? nA : cA + (size_t)(t + 2) * kstep; const char* b2 = last ? nB : cB + (size_t)(t + 2) * kstep;
            const char* a3 = a2 + kstep; const char* b3 = b2 + kstep;
            PGM_LDB(B0, 0); PGM_SCHED; PGM_LDA(At, 0, 0); PGM_STAGE(PGM_SA(1, 1), a1 + hstepA, voffA);
            PGM_WAIT_V(6); PGM_WAIT_L(0); PGM_BAR; PGM_MMA(0, At, B0); PGM_BAR; PGM_SCHED;
            PGM_LDA(At, 0, 1); PGM_STAGE(PGM_SB(0), b2, voffB); PGM_STAGE(PGM_SA(0, 0), a2, voffA);
            PGM_WAIT_V(6); PGM_WAIT_L(0); PGM_BAR; PGM_MMA(1, At, B0); PGM_BAR; PGM_SCHED;
            PGM_LDB(B0, 1); PGM_SCHED; PGM_LDA(At, 1, 0); PGM_STAGE(PGM_SA(0, 1), a2 + hstepA, voffA);
            PGM_WAIT_V(6); PGM_WAIT_L(0); PGM_BAR; PGM_MMA(0, At, B0); PGM_BAR; PGM_SCHED;
            PGM_LDA(At, 1, 1); PGM_STAGE(PGM_SB(1), b3, voffB); PGM_STAGE(PGM_SA(1, 0), a3, voffA);
            PGM_WAIT_V(6); PGM_WAIT_L(0); PGM_BAR; PGM_MMA(1, At, B0); PGM_BAR; PGM_SCHED;
        }
        if (wr == 0) PGM_BAR;
#pragma unroll
        for (int ai = 0; ai < 2; ++ai)
#pragma unroll
            for (int m = 0; m < 4; ++m) { float g[8]; unpack8_u8(gq[ai][m], g);
                msum[ai][m][0] = msum[ai][m][0] + acc[ai][m][0] * (f32x4){g[0], g[1], g[2], g[3]}; msum[ai][m][1] = msum[ai][m][1] + acc[ai][m][1] * (f32x4){g[4], g[5], g[6], g[7]};
                acc[ai][m][0] = (f32x4){0.f, 0.f, 0.f, 0.f}; acc[ai][m][1] = (f32x4){0.f, 0.f, 0.f, 0.f}; }
        if (cur.z == 3) {
            unsigned char* mb = (unsigned char*)(merged + (size_t)cur.pm * 256 * D);
#pragma unroll
            for (int ai = 0; ai < 2; ++ai)
#pragma unroll
                for (int m = 0; m < 4; ++m) { float v[8]; const f32x4 s0 = msum[ai][m][0] * (1.0f / 255.f), s1 = msum[ai][m][1] * (1.0f / 255.f); acc8(s0, s1, v);
                    *(u32x4*)(mb + (size_t)(goff + (unsigned)((ai * 128 + m * 16) * D)) * 2) = pack8(v);
                    msum[ai][m][0] = (f32x4){0.f, 0.f, 0.f, 0.f}; msum[ai][m][1] = (f32x4){0.f, 0.f, 0.f, 0.f}; }
        }
        if (!has_next) break;
        cur = nxt; cA = nA; cB = nB; ++ui;
        goff = goff_lane + (unsigned)cur.pn * 128u;
        PGM_GATES(cur);
        if (wr == 1) PGM_BAR;
    }
    PGM_WAIT_V(0);
    PGM_BAR;
#undef PGM_SA
#undef PGM_SB
#undef PGM_STAGE
#undef PGM_LDA
#undef PGM_LDB
#undef PGM_MMA
#undef PGM_WAIT_V
#undef PGM_WAIT_L
#undef PGM_BAR
#undef PGM_SCHED
#undef PGM_NEXT
#undef PGM_ABASE
#undef PGM_BBASE
#undef PGM_GATES
}
}

struct Args { const float* in[22]; float* out; unsigned char* ws; int ph_lo, ph_hi; };
struct Ctx { int tid, lane, wave, G, bx, vcu, gw, NGW, gt, NGT, al, xg, xr, vrole; unsigned char* ws; };
#define CAS __attribute__((address_space(4)))
#if defined(__HIP_DEVICE_COMPILE__)
#define LOAD_ARGS(c) const CAS Args* kp_##c = (const CAS Args*)__builtin_amdgcn_kernarg_segment_ptr(); asm volatile("" : "+s"(kp_##c)); const Args a = *kp_##c
#else
#define LOAD_ARGS(c) const Args a = a_
#endif
#define MAKE_CTX(c) Ctx c; LOAD_ARGS(c); do { int wv_ = wave0; asm volatile("" : "+s"(wv_)); const int t_ = wv_ * 64 + fresh_lane(); int g_ = gridDim.x, b_ = vbid; asm volatile("" : "+s"(g_), "+s"(b_)); GAS unsigned char* w_ = (GAS unsigned char*)a.ws; asm volatile("" : "+s"(w_)); \
    c.tid = t_; c.lane = t_ & 63; c.wave = wv_; c.G = g_; c.bx = b_; c.vcu = (g_ % 8 == 0) ? (b_ % 8) * (g_ / 8) + b_ / 8 : b_; \
    c.gw = c.vcu * NWAVES + c.wave; c.NGW = g_ * NWAVES; c.gt = c.gw * 64 + c.lane; c.NGT = c.NGW * 64; c.al = (g_ == 256) ? 1 : 0; c.xg = b_ & 7; c.xr = b_ >> 3; c.vrole = c.al ? ((c.xr < 16) ? c.xg * 16 + c.xr : 128 + c.xg * 16 + (c.xr - 16)) : c.vcu; c.ws = (unsigned char*)w_; } while (0)
enum { I_X = 0, I_NPRE, I_NPOST, I_WIN, I_ARE, I_AIM, I_LDT, I_BRE, I_BIM, I_CRE, I_CIM, I_S5D, I_WGLU, I_POOLW, I_POOLS, I_SCW, I_MCW, I_MBI, I_MBF, I_MNW, I_WBR, I_WOUT };

__device__ __forceinline__ unsigned pk4_fp8(float a, float b, float c, float d) { int w = 0; w = __builtin_amdgcn_cvt_pk_fp8_f32(a, b, w, false); w = __builtin_amdgcn_cvt_pk_fp8_f32(c, d, w, true); return (unsigned)w; }
__device__ __forceinline__ void transpose_item8(const float* W, int ldw, int k0s, int n0s, unsigned char* WT, int ldt, int n0d, int k0d, LAS float* scr, int lane, float scale) {
    { float t[32];
#pragma unroll
      for (int i = 0; i < 32; ++i) { const int kk = 2 * i + (lane >> 5); t[i] = W[(size_t)(k0s + kk) * ldw + n0s + (lane & 31)]; }
#pragma unroll
      for (int i = 0; i < 32; ++i) { const int kk = 2 * i + (lane >> 5); scr[kk * 33 + (lane & 31)] = t[i] * scale; } }
    LDS_WAIT(); __builtin_amdgcn_wave_barrier();
    const int c = lane & 7;
#pragma unroll
    for (int j = 0; j < 4; ++j) { const int n = (lane >> 3) + 8 * j; const LAS float* s = scr + (8 * c) * 33 + n;
        u32x2 o; o.x = pk4_fp8(s[0 * 33], s[1 * 33], s[2 * 33], s[3 * 33]); o.y = pk4_fp8(s[4 * 33], s[5 * 33], s[6 * 33], s[7 * 33]);
        *(u32x2*)(WT + (size_t)(n0d + n) * ldt + k0d + 8 * c) = o; }
    LDS_WAIT(); __builtin_amdgcn_wave_barrier();
}
__device__ __forceinline__ void transpose_item(const float* W, int ldw, int k0s, int n0s, bf16* WT, int ldt, int n0d, int k0d, LAS float* scr, int lane, bool zero) {
    if (!zero) {
        float t[32];
#pragma unroll
        for (int i = 0; i < 32; ++i) { const int kk = 2 * i + (lane >> 5); t[i] = W[(size_t)(k0s + kk) * ldw + n0s + (lane & 31)]; }
#pragma unroll
        for (int i = 0; i < 32; ++i) { const int kk = 2 * i + (lane >> 5); scr[kk * 33 + (lane & 31)] = t[i]; }
    } else {
#pragma unroll 8
        for (int i = 0; i < 32; ++i) { const int kk = 2 * i + (lane >> 5); scr[kk * 33 + (lane & 31)] = 0.f; }
    }
    LDS_WAIT(); __builtin_amdgcn_wave_barrier();
    const int c = lane & 7;
#pragma unroll
    for (int j = 0; j < 4; ++j) { const int n = (lane >> 3) + 8 * j; const LAS float* s = scr + (8 * c) * 33 + n;
        u32x4 o; o.x = cvt_pk_bf16(s[0 * 33], s[1 * 33]); o.y = cvt_pk_bf16(s[2 * 33], s[3 * 33]); o.z = cvt_pk_bf16(s[4 * 33], s[5 * 33]); o.w = cvt_pk_bf16(s[6 * 33], s[7 * 33]);
        *(u32x4*)(WT + (size_t)(n0d + n) * ldt + k0d + 8 * c) = o; }
    LDS_WAIT(); __builtin_amdgcn_wave_barrier();
}
__device__ __forceinline__ void phase_prologue(const Args& a, const Ctx& c, LAS unsigned char* lds) {
    unsigned char* ws = c.ws; const int gw = c.gw, NGW = c.NGW, wave = c.wave, lane = c.lane;
    LAS float* scr = (LAS float*)(lds + wave * 16384);
    constexpr int I_W1 = DEPTH * 16 * 336, I_WB = DEPTH * 4 * 8 * 32, I_WO = DEPTH * 16 * 32, I_WG = DEPTH * 8 * 16, I_WP = DEPTH * 8 * 16;
    constexpr int NIT = I_W1 + I_WB + I_WO + I_WG + I_WP;
    for (int it = gw; it < NIT; it += NGW) {
        int r = it;
        if (r < I_W1) { const int l = r / 5376, q = r % 5376, kb = q / 336, nb = q % 336, n0d = nb * 32; int n0s = n0d + (n0d >= 6144 ? 8 : 0);
            if (n0d >= 2048 && n0d < 4096) {
                const int nd = n0d + (lane & 31), qq = (nd - 2048) & 1023, g8 = qq >> 3, e = qq & 7, first = (nd < 3072) ? (e < 4 ? 2048 : 3072) : (e < 4 ? 2560 : 3584);
                n0s = first + 4 * g8 + (e & 3) - (lane & 31); }
            if (n0d < 6656) transpose_item(a.in[I_WIN] + (size_t)l * D * NIN, NIN, kb * 64, n0s, (bf16*)(ws + WS_W1T) + (size_t)l * NP * D, D, n0d, kb * 64, scr, lane, false);
            else transpose_item8(a.in[I_WIN] + (size_t)l * D * NIN, NIN, kb * 64, n0s, ws + WS_W8 + (size_t)l * 4 * D * D, D, n0d - 6656, kb * 64, scr, lane, W8_SCALE);
            continue; }
        r -= I_W1;
        if (r < I_WB) { const int lb = r / 256, q = r % 256, kb = q / 32, nb = q % 32;
            transpose_item(a.in[I_WBR] + (size_t)lb * BW * D, D, kb * 64, nb * 32, (bf16*)(ws + WS_WBT) + (size_t)lb * D * BW, BW, nb * 32, kb * 64, scr, lane, false); continue; }
        r -= I_WB;
        if (r < I_WO) { const int l = r / 512, q = r % 512, kb = q / 32, nb = q % 32;
            transpose_item(a.in[I_WOUT] + (size_t)l * D * D, D, kb * 64, nb * 32, (bf16*)(ws + WS_WOT) + (size_t)l * D * D, D, nb * 32, kb * 64, scr, lane, false); continue; }
        r -= I_WO;
        if (r < I_WG) { const int l = r / 128, q = r % 128, kb = q / 16, nb = q % 16;
            transpose_item(a.in[I_WGLU] + (size_t)l * BW * BW, BW, kb * 64, nb * 32, (bf16*)(ws + WS_WGT) + (size_t)l * BW * BW, BW, nb * 32, kb * 64, scr, lane, false); continue; }
        r -= I_WG;
        { const int l = r / 128, q = r % 128, kb = q / 16, nb = q % 16, k0 = kb * 64, n0 = nb * 32, gk = k0 >> 7, gn = n0 >> 7;
            transpose_item(a.in[I_POOLW] + (size_t)(l * 4 + gk) * 128 * 128, 128, k0 & 127, n0 & 127, (bf16*)(ws + WS_WPT) + (size_t)l * BW * BW, BW, n0, k0, scr, lane, gk != gn); }
    }
    const int gt = gw * 64 + lane, NGT = NGW * 64;
    for (int i = gt; i < DEPTH * NG * NS; i += NGT) {
        const int l = i / (NG * NS), g = (i / NS) % NG, n = i % NS;
        const float lr = a.in[I_ARE][i], li = a.in[I_AIM][i], dt = __expf(a.in[I_LDT][l * NG + g]);
        const float er = __expf(lr * dt);
        const double rev = (double)li * (double)dt * 0.15915494309189535; const float fr = (float)(rev - __builtin_rint(rev));
        const float ar = er * __builtin_amdgcn_cosf(fr), ai = er * __builtin_amdgcn_sinf(fr);
        const float e64 = __expf(64.f * lr * dt);
        const double rev64 = rev * 64.0; const float fr64 = (float)(rev64 - __builtin_rint(rev64));
        const float ar64 = e64 * __builtin_amdgcn_cosf(fr64), ai64 = e64 * __builtin_amdgcn_sinf(fr64);
        unsigned char* T = ws + WS_S5T + (size_t)l * S5T_LAYER;
        ((f32x2*)(T + S5T_A))[g * NS + n] = (f32x2){ar, ai};
        ((f32x2*)(T + S5T_A64))[g * NS + n] = (f32x2){ar64, ai64};
        const float nr = ar - 1.f, ni = ai, den = 1.f / (lr * lr + li * li);
        const float cr = (nr * lr + ni * li) * den, ci = (ni * lr - nr * li) * den;
        bf16* TB = (bf16*)(T + S5T_B) + (size_t)(g * 128 + 2 * n) * 16;
        const float* Bre = a.in[I_BRE] + (size_t)i * 16; const float* Bim = a.in[I_BIM] + (size_t)i * 16;
#pragma unroll
        for (int q = 0; q < 16; ++q) { const float br = Bre[q], bi = Bim[q]; TB[q] = (bf16)f2bf(cr * br - ci * bi); TB[16 + q] = (bf16)f2bf(cr * bi + ci * br); }
        bf16* TC = (bf16*)(T + S5T_C) + (size_t)g * 16 * 128;
        const float* Cre = a.in[I_CRE] + (size_t)(l * NG + g) * 16 * NS; const float* Cim = a.in[I_CIM] + (size_t)(l * NG + g) * 16 * NS;
#pragma unroll
        for (int p = 0; p < 16; ++p) { TC[p * 128 + 2 * n] = (bf16)f2bf(Cre[p * NS + n]); TC[p * 128 + 2 * n + 1] = (bf16)f2bf(-Cim[p * NS + n]); }
    }
}

template <bool DO_RES, bool DO_H, bool SRCB>
__device__ __forceinline__ void phase_norm(const Args& a, const Ctx& c, LAS unsigned char* lds, int layer, int pass) {
    unsigned char* ws = c.ws; const int gw = c.gw, NGW = c.NGW, lane = c.lane;
    LAS float* wif = (LAS float*)lds;
    if (DO_H) {
        const float* win = a.in[I_WIN] + (size_t)layer * D * NIN + 6144;
        { float t[8192 / NTHR];
#pragma unroll
          for (int k = 0; k < 8192 / NTHR; ++k) { const int i = c.tid + k * NTHR, cc = i >> 3, jj = i & 7; t[k] = win[(size_t)cc * NIN + jj]; }
#pragma unroll
          for (int k = 0; k < 8192 / NTHR; ++k) { const int i = c.tid + k * NTHR, cc = i >> 3, jj = i & 7;
              wif[jj * 1024 + 256 * (2 * (cc >> 9) + ((cc & 7) >> 2)) + 4 * ((cc & 511) >> 3) + (cc & 3)] = t[k]; } }
        __syncthreads();
    }
    const float* xsrc = a.in[I_X] + (size_t)pass * MH * D; bf16* XB = (bf16*)(ws + WS_XB);
#define NCOL(j) (8 * lane + 512 * ((j) >> 1) + 4 * ((j) & 1))
#define NORM_LOADX(dst, raw, row_) do { if (SRCB) { _Pragma("unroll") for (int q = 0; q < 2; ++q) raw[q] = *(const u32x4*)(XB + (size_t)(row_) * D + 8 * lane + 512 * q); } \
        else { _Pragma("unroll") for (int j = 0; j < 4; ++j) dst[j] = *(const f32x4*)(xsrc + (size_t)(row_) * D + NCOL(j)); } } while (0)
    f32x4 wpre[4], wpost[4];
#pragma unroll
    for (int j = 0; j < 4; ++j) {
        wpre[j] = DO_H ? *(const f32x4*)(a.in[I_NPRE] + (size_t)layer * D + NCOL(j)) : (f32x4){0.f, 0.f, 0.f, 0.f};
        wpost[j] = DO_RES ? *(const f32x4*)(a.in[I_NPOST] + (size_t)(DO_H ? layer - 1 : layer) * D + NCOL(j)) : (f32x4){0.f, 0.f, 0.f, 0.f};
    }
    const bf16* OUT = (const bf16*)(ws + WS_QKA); const float* OSS = (const float*)(ws + WS_OSS);
    bf16* Hb = (bf16*)(ws + WS_H); float* IF = (float*)(ws + WS_IF);
    constexpr int NPF = 2;
    f32x4 vn[NPF][4]; u32x4 xr[NPF][2], on[NPF][2]; f32x4 pn[NPF][4];
#pragma unroll
    for (int h = 0; h < NPF; ++h)
#pragma unroll
        for (int j = 0; j < 4; ++j) { vn[h][j] = (f32x4){0.f, 0.f, 0.f, 0.f}; xr[h][j >> 1] = (u32x4){0u, 0u, 0u, 0u}; on[h][j >> 1] = (u32x4){0u, 0u, 0u, 0u}; pn[h][j] = (f32x4){0.f, 0.f, 0.f, 0.f}; }
#define NORM_LOADO(h_, row_) do { if (DO_RES) { _Pragma("unroll") for (int q = 0; q < 2; ++q) on[h_][q] = *(const u32x4*)(OUT + (size_t)(row_) * D + 8 * lane + 512 * q); \
        _Pragma("unroll") for (int j = 0; j < 4; ++j) pn[h_][j] = *(const f32x4*)(OSS + (size_t)(row_) * 16 + 4 * j); } } while (0)
    const int r_first = c.al ? c.xg * (MH / 8) + (c.xr * NWAVES + c.wave) : gw, r_step = c.al ? (NGW / 8) : NGW, r_end = c.al ? (c.xg + 1) * (MH / 8) : MH;
#pragma unroll
    for (int h = 0; h < NPF; ++h) if (r_first + h * r_step < r_end) { NORM_LOADX(vn[h], xr[h], r_first + h * r_step); NORM_LOADO(h, r_first + h * r_step); }
    for (int r0 = r_first; r0 < r_end; r0 += NPF * r_step) {
#pragma unroll
      for (int h = 0; h < NPF; ++h) { const int r = r0 + h * r_step; if (r >= r_end) break;
        const size_t grow = (size_t)pass * MH + r;
        f32x4 v[4]; u32x4 oc[2]; float ss = 0.f;
#pragma unroll
        for (int q = 0; q < 2; ++q) { const u32x4 xq = xr[h][q]; oc[q] = on[h][q];
            v[2 * q] = SRCB ? (f32x4){bflo(xq.x), bfhi(xq.x), bflo(xq.y), bfhi(xq.y)} : vn[h][2 * q]; v[2 * q + 1] = SRCB ? (f32x4){bflo(xq.z), bfhi(xq.z), bflo(xq.w), bfhi(xq.w)} : vn[h][2 * q + 1]; }
#pragma unroll
        for (int j = 0; j < 4; ++j) ss += (pn[h][j][0] + pn[h][j][1]) + (pn[h][j][2] + pn[h][j][3]);
        if (r + NPF * r_step < r_end) { NORM_LOADX(vn[h], xr[h], r + NPF * r_step); NORM_LOADO(h, r + NPF * r_step); }
        if (DO_RES) {
            const float rs = __builtin_amdgcn_rsqf(ss * (1.f / D) + RMS_EPS);
#pragma unroll
            for (int j = 0; j < 4; ++j) { const unsigned ox = (j & 1) ? oc[j >> 1].z : oc[j >> 1].x, oy = (j & 1) ? oc[j >> 1].w : oc[j >> 1].y;
                v[j][0] += bflo(ox) * rs * wpost[j][0]; v[j][1] += bfhi(ox) * rs * wpost[j][1]; v[j][2] += bflo(oy) * rs * wpost[j][2]; v[j][3] += bfhi(oy) * rs * wpost[j][3]; }
            if (DO_H) {
#pragma unroll
                for (int q = 0; q < 2; ++q) { u32x4 w; w.x = cvt_pk_bf16(v[2 * q][0], v[2 * q][1]); w.y = cvt_pk_bf16(v[2 * q][2], v[2 * q][3]); w.z = cvt_pk_bf16(v[2 * q + 1][0], v[2 * q + 1][1]); w.w = cvt_pk_bf16(v[2 * q + 1][2], v[2 * q + 1][3]);
                    *(u32x4*)(XB + (size_t)r * D + 8 * lane + 512 * q) = w; }
            } else {
#pragma unroll
                for (int j = 0; j < 4; ++j) *(f32x4*)(a.out + grow * D + NCOL(j)) = v[j]; }
        }
        if (DO_H) {
            float s = 0.f;
#pragma unroll
            for (int j = 0; j < 4; ++j) s += (v[j][0] * v[j][0] + v[j][1] * v[j][1]) + (v[j][2] * v[j][2] + v[j][3] * v[j][3]);
            const float rstd = __builtin_amdgcn_rsqf(dpp_wave_sum(s) * (1.f / D) + RMS_EPS);
#pragma unroll
            for (int j = 0; j < 4; ++j) v[j] = v[j] * rstd * wpre[j];
#pragma unroll
            for (int q = 0; q < 2; ++q) { u32x4 o; o.x = cvt_pk_bf16(v[2 * q][0], v[2 * q][1]); o.y = cvt_pk_bf16(v[2 * q][2], v[2 * q][3]); o.z = cvt_pk_bf16(v[2 * q + 1][0], v[2 * q + 1][1]); o.w = cvt_pk_bf16(v[2 * q + 1][2], v[2 * q + 1][3]);
                *(u32x4*)(Hb + (size_t)r * D + 8 * lane + 512 * q) = o;
                u32x2 o8; o8.x = pk4_fp8(v[2 * q][0], v[2 * q][1], v[2 * q][2], v[2 * q][3]); o8.y = pk4_fp8(v[2 * q + 1][0], v[2 * q + 1][1], v[2 * q + 1][2], v[2 * q + 1][3]);
                *(u32x2*)(ws + WS_H8 + (size_t)r * D + 8 * lane + 512 * q) = o8; }
            float mine = 0.f;
#pragma unroll 2
            for (int jj = 0; jj < 8; ++jj) { float d = 0.f;
#pragma unroll
                for (int j = 0; j < 4; ++j) { const f32x4 w = *(const LAS f32x4*)(wif + jj * 1024 + 4 * lane + 256 * j); d += (v[j][0] * w[0] + v[j][1] * w[1]) + (v[j][2] * w[2] + v[j][3] * w[3]); }
                d = dpp_wave_sum(d); mine = (lane == jj) ? d : mine; }
            if (lane < 8) IF[(size_t)r * 8 + lane] = mine;
        }
      }
    }
    if (DO_H) __syncthreads();
#undef NORM_LOADX
#undef NORM_LOADO
#undef NCOL
}

__device__ __forceinline__ void ld8(const bf16* p, float (&f)[8]) { unpack8(*(const u32x4*)p, f); }
__device__ __forceinline__ void phase_ew(const Args& a, const Ctx& cx, int layer, int parts, int gt, int NGT) {
    unsigned char* ws = cx.ws;
    const int lt = cx.al ? cx.xr * NTHR + cx.tid : gt, NLT = cx.al ? NGT / 8 : NGT;
    bf16* SEG = (bf16*)(ws + WS_SEG);
    if (parts & 1) {
        bf16* QKA = (bf16*)(ws + WS_QKA); const float* cw = a.in[I_MCW] + (size_t)layer * 4 * 1024;
        const int NIa = cx.al ? (MH / 16) * 128 / 8 : (MH / 16) * 128, iba = cx.al ? cx.xg * NIa : 0;
        for (int li = lt; li < NIa; li += NLT) { const int id = iba + li;
            const int cg = id & 127, run = id >> 7, c = cg * 8, r0 = run * 16;
            const bf16* src = SEG + (size_t)(SG_QK + (cg >> 6)) * MH * BW + (c & 511);
            float w[4][8];
#pragma unroll
            for (int k = 0; k < 4; ++k) { const f32x4 w0 = *(const f32x4*)(cw + k * 1024 + c), w1 = *(const f32x4*)(cw + k * 1024 + c + 4); acc8(w0, w1, w[k]); }
            const float scale = (cg < 64) ? 0.08838834764831845f : 1.0f;
            const bool halo = (r0 & (SEQ - 1)) != 0;
            u32x4 raw[19];
#pragma unroll
            for (int i = 0; i < 3; ++i) raw[i] = halo ? *(const u32x4*)(src + (size_t)(r0 - 3 + i) * BW) : (u32x4){0u, 0u, 0u, 0u};
#pragma unroll
            for (int i = 0; i < 16; ++i) raw[3 + i] = *(const u32x4*)(src + (size_t)(r0 + i) * BW);
            float x0[8], x1[8], x2[8], x3[8];
            unpack8(raw[0], x0); unpack8(raw[1], x1); unpack8(raw[2], x2);
#pragma unroll
            for (int i = 0; i < 16; ++i) {
                unpack8(raw[3 + i], x3); float y[8];
#pragma unroll
                for (int e = 0; e < 8; ++e) { const float t = w[0][e] * x0[e] + w[1][e] * x1[e] + w[2][e] * x2[e] + w[3][e] * x3[e]; y[e] = t * fsigmoid(t) * scale; x0[e] = x1[e]; x1[e] = x2[e]; x2[e] = x3[e]; }
                *(u32x4*)(QKA + (size_t)(r0 + i) * D + c) = pack8(y);
            }
        }
    }
    if (parts & 2) {
        const float* cw = a.in[I_SCW] + (size_t)layer * 3 * BW;
        const bf16* P1 = SEG + (size_t)SG_SCX * MH * BW; const bf16* P2 = SEG + (size_t)SG_SCB * MH * BW; bf16* Z = SEG + (size_t)SG_SCZ * MH * BW;
        const int NIb = cx.al ? (MH / 16) * 64 / 8 : (MH / 16) * 64, ibb = cx.al ? cx.xg * NIb : 0;
        for (int li = lt; li < NIb; li += NLT) { const int id = ibb + li;
            const int cg = id & 63, run = id >> 6, c = cg * 8, r0 = run * 16;
            float w[3][8];
#pragma unroll
            for (int k = 0; k < 3; ++k) { const f32x4 w0 = *(const f32x4*)(cw + k * BW + c), w1 = *(const f32x4*)(cw + k * BW + c + 4); acc8(w0, w1, w[k]); }
            const bool halo = (r0 & (SEQ - 1)) != 0;
            u32x4 rp[18], rb[16];
#pragma unroll
            for (int i = 0; i < 2; ++i) rp[i] = halo ? *(const u32x4*)(P1 + (size_t)(r0 - 2 + i) * BW + c) : (u32x4){0u, 0u, 0u, 0u};
#pragma unroll
            for (int i = 0; i < 16; ++i) { const size_t off = (size_t)(r0 + i) * BW + c; rp[2 + i] = *(const u32x4*)(P1 + off); rb[i] = *(const u32x4*)(P2 + off); }
            float p0[8], p1[8], p2[8];
            unpack8(rp[0], p0); unpack8(rp[1], p1);
#pragma unroll
            for (int i = 0; i < 16; ++i) { const size_t off = (size_t)(r0 + i) * BW + c;
                float bz[8], y[8]; unpack8(rp[2 + i], p2); unpack8(rb[i], bz);
#pragma unroll
                for (int e = 0; e < 8; ++e) { y[e] = bz[e] * (w[0][e] * p0[e] + w[1][e] * p1[e] + w[2][e] * p2[e]); p0[e] = p1[e]; p1[e] = p2[e]; }
                *(u32x4*)(Z + off) = pack8(y); }
        }
    }
    if (parts & 4) {
        const bf16* U = SEG + (size_t)SG_PU * MH * BW; bf16* PO = (bf16*)(ws + WS_POOL);
        const int NIc = cx.al ? (MH / 16) * 64 / 8 : (MH / 16) * 64, ibc = cx.al ? cx.xg * NIc : 0;
        for (int li = lt; li < NIc; li += NLT) { const int id = ibc + li;
            const int cg = id & 63, run = id >> 6, c = cg * 8, r0 = run * 16, win = 2 << (cg >> 4), pos0 = r0 & (SEQ - 1);
            float s[8];
#pragma unroll
            for (int e = 0; e < 8; ++e) s[e] = 0.f;
            { u32x4 wu[16];
#pragma unroll
              for (int j = 1; j <= 16; ++j) wu[j - 1] = (j <= win && pos0 - j >= 0) ? *(const u32x4*)(U + (size_t)(r0 - j) * BW + c) : (u32x4){0u, 0u, 0u, 0u};
#pragma unroll
              for (int j = 0; j < 16; ++j) { float t[8]; unpack8(wu[j], t);
#pragma unroll
                for (int e = 0; e < 8; ++e) s[e] += t[e]; } }
#pragma unroll 1
            for (int i0 = 0; i0 < 16; i0 += 8) {
                u32x4 rc[8], ro[8];
#pragma unroll
                for (int i = 0; i < 8; ++i) { const int pos = pos0 + i0 + i; const size_t off = (size_t)(r0 + i0 + i) * BW + c;
                    rc[i] = *(const u32x4*)(U + off); ro[i] = (pos - win >= 0) ? *(const u32x4*)(U + off - (size_t)win * BW) : (u32x4){0u, 0u, 0u, 0u}; }
#pragma unroll
                for (int i = 0; i < 8; ++i) { const int pos = pos0 + i0 + i; const size_t off = (size_t)(r0 + i0 + i) * BW + c;
                    float cur[8], old[8], y[8]; unpack8(rc[i], cur); unpack8(ro[i], old);
                    const int cnt = (pos + 1 < win) ? pos + 1 : win; const float inv = 1.0f / (float)cnt;
#pragma unroll
                    for (int e = 0; e < 8; ++e) { s[e] += cur[e] - old[e]; y[e] = s[e] * inv - cur[e]; }
                    *(u32x4*)(PO + off) = pack8(y); }
            }
        }
    }
}
__device__ __forceinline__ void phase_ydfix(const Args& a, const Ctx& cx, int layer) {
    unsigned char* ws = cx.ws; const int gt = cx.gt, NGT = cx.NGT; bf16* SEG = (bf16*)(ws + WS_SEG);
    const bf16* HG = SEG + (size_t)SG_O * MH * BW; bf16* Z = SEG + (size_t)SG_MZ * MH * BW; const float* SSQ = (const float*)(ws + WS_SSQ); const float* nw = a.in[I_MNW] + (size_t)layer * BW;
    float w[8]; { const int c = (cx.tid & 63) * 8; const f32x4 w0 = *(const f32x4*)(nw + c), w1 = *(const f32x4*)(nw + c + 4); acc8(w0, w1, w); }
    const int NI = cx.al ? MH * 64 / 8 : MH * 64, ib = cx.al ? cx.xg * NI : 0, lt = cx.al ? cx.xr * NTHR + cx.tid : gt, NLT = cx.al ? NGT / 8 : NGT;
    for (int l0 = lt; l0 < NI; l0 += 4 * NLT) {
        u32x4 rh[4], rz[4];
#pragma unroll
        for (int k = 0; k < 4; ++k) { const int id = ib + l0 + k * NLT; const bool ok = l0 + k * NLT < NI; const int cg = id & 63, r = ok ? id >> 6 : 0, c = cg * 8, hd = cg >> 4; const size_t off = (size_t)r * BW + c;
            rh[k] = *(const u32x4*)(HG + off); rz[k] = *(const u32x4*)(Z + off); }
#pragma unroll
        for (int k = 0; k < 4; ++k) { const int id = ib + l0 + k * NLT; if (l0 + k * NLT >= NI) break; const int cg = id & 63, r = id >> 6, c = cg * 8; const size_t off = (size_t)r * BW + c;
            float h[8], z[8]; unpack8(rh[k], h); unpack8(rz[k], z);
            float sq = ((h[0] * h[0] + h[1] * h[1]) + (h[2] * h[2] + h[3] * h[3])) + ((h[4] * h[4] + h[5] * h[5]) + (h[6] * h[6] + h[7] * h[7]));
            sq += __builtin_bit_cast(float, __builtin_amdgcn_update_dpp(0, __builtin_bit_cast(int, sq), 0x128, 0xf, 0xf, false));
            sq += __builtin_bit_cast(float, __builtin_amdgcn_update_dpp(0, __builtin_bit_cast(int, sq), 0x124, 0xf, 0xf, false));
            sq += __builtin_bit_cast(float, __builtin_amdgcn_update_dpp(0, __builtin_bit_cast(int, sq), 0x122, 0xf, 0xf, false));
            sq += __builtin_bit_cast(float, __builtin_amdgcn_update_dpp(0, __builtin_bit_cast(int, sq), 0x121, 0xf, 0xf, false));
            const float rs = __builtin_amdgcn_rsqf(sq * (1.f / DH) + RMS_EPS);
#pragma unroll
            for (int e = 0; e < 8; ++e) h[e] = h[e] * rs * w[e] * z[e];
            *(u32x4*)(Z + off) = pack8(h); }
    }
}

constexpr int S5_UYS = 1040;
constexpr int S5_OFF_BU = 64 * S5_UYS;
constexpr int S5_WS = 272;
constexpr int S5_OFF_X = S5_OFF_BU + 8 * 16 * S5_WS;
static_assert(S5_OFF_X + 8 * 16 * S5_WS <= LDS_MISC, "S5 LDS");
struct NoHook { __device__ __forceinline__ void operator()() const {} };
template <bool PASS2, bool EXTC, class Hook>
__device__ __forceinline__ void phase_s5_impl(const Args& a, const Ctx& cx, LAS unsigned char* lds, int layer, int u0, int ustride, int ucount, float (&xr)[4], float (&xi)[4], const Hook& hook) {
    unsigned char* ws = cx.ws;
    const int tid = cx.tid, wave = cx.wave, lane = cx.lane, fr = lane & 15, fq = lane >> 4;
    bf16* U = (bf16*)(ws + WS_SEG) + (size_t)SG_S5U * MH * BW;
    f32x2* E = (f32x2*)(ws + WS_E);
    const unsigned char* T = ws + WS_S5T + (size_t)layer * S5T_LAYER;
    const f32x2* TA = (const f32x2*)(T + S5T_A); const f32x2* TA64 = (const f32x2*)(T + S5T_A64);
    const bf16* TB = (const bf16*)(T + S5T_B); const bf16* TC = (const bf16*)(T + S5T_C);
    const float* Dk = a.in[I_S5D] + (size_t)layer * BW;
    LAS unsigned char* UY = lds; LAS unsigned char* BUs = lds + S5_OFF_BU + wave * 16 * S5_WS; LAS unsigned char* Xs = lds + S5_OFF_X + wave * 16 * S5_WS;
    u32x4 pre[8];
    const unsigned voff0 = (unsigned)(tid >> 6) * 1024u + (unsigned)(tid & 63) * 16u;
    if (u0 < HB * NCH) { const unsigned char* ub = (const unsigned char*)(U + ((size_t)(u0 / NCH) * SEQ + (size_t)(u0 % NCH) * CH) * BW);
#pragma unroll
        for (int j = 0; j < 8; ++j) pre[j] = *(const u32x4*)(ub + voff0 + 8192u * j); }
    hook();
    f32x2 avN = (f32x2){0.f, 0.f}; s16x4 BfN[8]; bf16x8 CfN[4]; float dkN[4] = {0.f, 0.f, 0.f, 0.f};
#pragma unroll
    for (int ct = 0; ct < 8; ++ct) BfN[ct] = (s16x4){0, 0, 0, 0};
#pragma unroll
    for (int s = 0; s < 4; ++s) CfN[s] = (bf16x8){0, 0, 0, 0, 0, 0, 0, 0};
    float esr[4] = {EXTC ? xr[0] : 0.f, EXTC ? xr[1] : 0.f, EXTC ? xr[2] : 0.f, EXTC ? xr[3] : 0.f}, esi[4] = {EXTC ? xi[0] : 0.f, EXTC ? xi[1] : 0.f, EXTC ? xi[2] : 0.f, EXTC ? xi[3] : 0.f};
    float c0r[4] = {0.f, 0.f, 0.f, 0.f}, c0i[4] = {0.f, 0.f, 0.f, 0.f};
    if (PASS2 && u0 < HB * NCH && (u0 % NCH) != 0) { const int b = u0 / NCH, c = u0 % NCH;
        f32x2 a64[4], a128[4];
#pragma unroll
        for (int gi = 0; gi < 4; ++gi) { a64[gi] = *(const f32x2*)((const unsigned char*)(TA64 + (wave + 8 * gi) * NS) + (unsigned)lane * 8u);
            a128[gi] = (f32x2){a64[gi][0] * a64[gi][0] - a64[gi][1] * a64[gi][1], 2.f * a64[gi][0] * a64[gi][1]}; }
        const unsigned char* Eb = (const unsigned char*)(E + ((size_t)b * NCH * NG + wave) * NS); const unsigned eoff = (unsigned)lane * 8u;
        const int np = c >> 1;
        for (int j0 = 0; j0 < np; j0 += 12) {
            f32x2 e[4][12];
#pragma unroll
            for (int k = 0; k < 12; ++k) { const int jj = (j0 + k < np) ? j0 + k : np - 1; const unsigned char* Ek = Eb + (size_t)(2 * jj + 1) * (NG * NS * 8);
#pragma unroll
                for (int gi = 0; gi < 4; ++gi) e[gi][k] = *(const f32x2*)(Ek + (eoff + (unsigned)(gi * 8 * NS * 8))); }
#pragma unroll
            for (int k = 0; k < 12; ++k) if (j0 + k < np) {
#pragma unroll
                for (int gi = 0; gi < 4; ++gi) { const float nr = a128[gi][0] * c0r[gi] - a128[gi][1] * c0i[gi] + e[gi][k][0], ni = a128[gi][0] * c0i[gi] + a128[gi][1] * c0r[gi] + e[gi][k][1]; c0r[gi] = nr; c0i[gi] = ni; } }
        }
        if (c & 1) { const unsigned char* Ek = Eb + (size_t)(c - 1) * (NG * NS * 8);
#pragma unroll
            for (int gi = 0; gi < 4; ++gi) { const f32x2 e1 = *(const f32x2*)(Ek + (eoff + (unsigned)(gi * 8 * NS * 8)));
                const float nr = a64[gi][0] * c0r[gi] - a64[gi][1] * c0i[gi] + e1[0], ni = a64[gi][0] * c0i[gi] + a64[gi][1] * c0r[gi] + e1[1]; c0r[gi] = nr; c0i[gi] = ni; } }
    }
    for (int uk = 0; uk < ucount; ++uk) { const int unit = u0 + uk * ustride; if (unit >= HB * NCH) break;
        const int b = unit / NCH, c = unit % NCH; const size_t row0 = (size_t)b * SEQ + (size_t)c * CH;
#pragma unroll
        for (int j = 0; j < 8; ++j) { const int id = tid + NTHR * j, r = id >> 6, pc = id & 63; *(LAS u32x4*)(UY + r * S5_UYS + pc * 16) = pre[j]; }
        __syncthreads();
        float csr[4] = {0.f, 0.f, 0.f, 0.f}, csi[4] = {0.f, 0.f, 0.f, 0.f};
        const bool chain = PASS2 && uk > 0 && ustride == 1 && c != 0;
        const bool pairchain = !PASS2 && (uk > 0 || EXTC) && ustride == 1 && (c & 1) != 0;
        if (chain) {
#pragma unroll
            for (int gi = 0; gi < 4; ++gi) { csr[gi] = esr[gi]; csi[gi] = esi[gi]; }
        }
        if (PASS2 && !chain && uk == 0) {
#pragma unroll
            for (int gi = 0; gi < 4; ++gi) { csr[gi] = c0r[gi]; csi[gi] = c0i[gi]; }
        }
        if (uk + 1 < ucount && unit + ustride < HB * NCH) { const int un = unit + ustride; const unsigned char* ub = (const unsigned char*)(U + ((size_t)(un / NCH) * SEQ + (size_t)(un % NCH) * CH) * BW);
#pragma unroll
            for (int j = 0; j < 8; ++j) pre[j] = *(const u32x4*)(ub + voff0 + 8192u * j); }
#define S5_LOADT(g_) do { const int gq_ = (g_); avN = *(const f32x2*)((const unsigned char*)(TA + gq_ * NS) + (unsigned)lane * 8u); \
            _Pragma("unroll") for (int ct = 0; ct < 8; ++ct) BfN[ct] = *(const s16x4*)((const unsigned char*)(TB + (size_t)gq_ * 128 * 16) + ((unsigned)(fr * 16 + fq * 4) * 2u + (unsigned)ct * 512u)); \
            if (PASS2) { _Pragma("unroll") for (int s = 0; s < 4; ++s) CfN[s] = *(const bf16x8*)((const unsigned char*)(TC + (size_t)gq_ * 16 * 128) + ((unsigned)(fr * 128 + fq * 8) * 2u + (unsigned)s * 64u)); \
                _Pragma("unroll") for (int r = 0; r < 4; ++r) dkN[r] = *(const float*)((const unsigned char*)(Dk + gq_ * 16) + ((unsigned)fq * 16u + (unsigned)r * 4u)); } } while (0)
        if (uk == 0) S5_LOADT(wave);
#pragma unroll
        for (int gi = 0; gi < 4; ++gi) {
            const int g = wave + 8 * gi;
            const float ar = avN[0], ai = avN[1];
            s16x4 Bf[8];
#pragma unroll
            for (int ct = 0; ct < 8; ++ct) Bf[ct] = BfN[ct];
            float sr = 0.f, si = 0.f;
            bf16x8 Cf[4]; float dk[4];
#pragma unroll
            for (int s = 0; s < 4; ++s) Cf[s] = CfN[s];
#pragma unroll
            for (int r = 0; r < 4; ++r) dk[r] = dkN[r];
            if (gi < 3) S5_LOADT(wave + 8 * (gi + 1)); else if (uk + 1 < ucount && unit + ustride < HB * NCH) S5_LOADT(wave);
            if (PASS2) { sr = csr[gi]; si = csi[gi]; }
            if (!PASS2 && pairchain) { sr = esr[gi]; si = esi[gi]; }
#pragma unroll 1
            for (int tb = 0; tb < 4; ++tb) {
                LAS unsigned char* up = UY + (tb * 16 + fr) * S5_UYS + (g * 16 + fq * 4) * 2;
                const s16x4 Uf = *(const LAS s16x4*)up;
#pragma unroll
                for (int ct = 0; ct < 8; ++ct) {
                    const f32x4 d = __builtin_amdgcn_mfma_f32_16x16x16bf16_1k(Bf[ct], Uf, (f32x4){0.f, 0.f, 0.f, 0.f}, 0, 0, 0);
                    u32x2 w; w.x = cvt_pk_bf16(d[0], d[1]); w.y = cvt_pk_bf16(d[2], d[3]);
                    *(LAS u32x2*)(BUs + fr * S5_WS + (ct * 16 + fq * 4) * 2) = w;
                }
                unsigned bw[16], xw[16];
#pragma unroll
                for (int t = 0; t < 16; ++t) bw[t] = *(const LAS unsigned*)(BUs + t * S5_WS + lane * 4);
                { f32x2 s2 = (f32x2){sr, si}; const f32x2 arr = (f32x2){ar, ar}, aii = (f32x2){-ai, ai};
#pragma unroll
                for (int t = 0; t < 16; ++t) { const f32x2 bb = (f32x2){bflo(bw[t]), bfhi(bw[t])}; const f32x2 tt = arr * s2 + bb; const f32x2 sw = (f32x2){s2[1], s2[0]}; s2 = aii * sw + tt; xw[t] = cvt_pk_bf16(s2[0], s2[1]); }
                sr = s2[0]; si = s2[1]; }
                if (PASS2) {
#pragma unroll
                    for (int t = 0; t < 16; ++t) *(LAS unsigned*)(Xs + t * S5_WS + lane * 4) = xw[t]; }
                if (PASS2) {
                        f32x4 y = (f32x4){0.f, 0.f, 0.f, 0.f};
#pragma unroll
                    for (int s = 0; s < 4; ++s) { const bf16x8 Xf = *(const LAS bf16x8*)(Xs + fr * S5_WS + (s * 32 + fq * 8) * 2);
                        y = __builtin_amdgcn_mfma_f32_16x16x32_bf16(Cf[s], Xf, y, 0, 0, 0); }
                    const u32x2 uw = __builtin_bit_cast(u32x2, Uf);
                    const float u0 = bflo(uw.x), u1 = bfhi(uw.x), u2 = bflo(uw.y), u3 = bfhi(uw.y);
                    float o[4] = {y[0] + dk[0] * u0, y[1] + dk[1] * u1, y[2] + dk[2] * u2, y[3] + dk[3] * u3};
#pragma unroll
                    for (int r = 0; r < 4; ++r) { const float x = o[r]; o[r] = x * fsigmoid(1.5957691216057308f * (x + 0.044715f * x * x * x)); }
                    u32x2 w; w.x = cvt_pk_bf16(o[0], o[1]); w.y = cvt_pk_bf16(o[2], o[3]);
                    *(LAS u32x2*)up = w;
                }
            }
            if (!PASS2) E[(((size_t)b * NCH + c) * NG + g) * NS + lane] = (f32x2){sr, si};
            esr[gi] = sr; esi[gi] = si;
        }
        __syncthreads();
        if (PASS2) {
#pragma unroll
            for (int j = 0; j < 8; ++j) { const int id = tid + NTHR * j, r = id >> 6, pc = id & 63;
                *(u32x4*)((unsigned char*)(U + row0 * BW) + voff0 + 8192u * j) = *(const LAS u32x4*)(UY + r * S5_UYS + pc * 16); }
            __syncthreads();
        }
    }
    if (EXTC) {
#pragma unroll
        for (int gi = 0; gi < 4; ++gi) { xr[gi] = esr[gi]; xi[gi] = esi[gi]; }
    }
}
#undef S5_LOADT
template <bool PASS2>
__device__ __forceinline__ void phase_s5(const Args& a, const Ctx& cx, LAS unsigned char* lds, int layer, int u0, int ustride, int ucount) {
    float d0[4] = {0.f, 0.f, 0.f, 0.f}, d1[4] = {0.f, 0.f, 0.f, 0.f}; phase_s5_impl<PASS2, false>(a, cx, lds, layer, u0, ustride, ucount, d0, d1, NoHook{});
}
__device__ __forceinline__ void phase_qk_s5(const Args& a, const Ctx& cx, LAS unsigned char* lds, int layer) {
    unsigned char* ws = cx.ws; bf16* SEG = (bf16*)(ws + WS_SEG); bf16* QKA = (bf16*)(ws + WS_QKA); const float* cw = a.in[I_MCW] + (size_t)layer * 4 * 1024;
    const int NIa = (MH / 16) * 128 / 8, iba = cx.xg * NIa, lt = cx.xr * NTHR + cx.tid, NLT = cx.NGT / 8;
    float er[4] = {0.f, 0.f, 0.f, 0.f}, ei[4] = {0.f, 0.f, 0.f, 0.f};
#pragma unroll
    for (int k = 0; k < 2; ++k) {
        const int id = iba + lt + k * NLT, cg = id & 127, run = id >> 7, c = cg * 8, r0 = run * 16;
        const bf16* src = SEG + (size_t)(SG_QK + (cg >> 6)) * MH * BW + (c & 511);
        const bool halo = (r0 & (SEQ - 1)) != 0;
        u32x4 raw[19];
        auto ldraw = [&]() {
#pragma unroll
            for (int i = 0; i < 3; ++i) raw[i] = halo ? *(const u32x4*)(src + (size_t)(r0 - 3 + i) * BW) : (u32x4){0u, 0u, 0u, 0u};
#pragma unroll
            for (int i = 0; i < 16; ++i) raw[3 + i] = *(const u32x4*)(src + (size_t)(r0 + i) * BW);
        };
        phase_s5_impl<false, true>(a, cx, lds, layer, cx.vcu * 2 + k, 1, 1, er, ei, ldraw);
        float w[4][8];
#pragma unroll
        for (int kk = 0; kk < 4; ++kk) { const f32x4 w0 = *(const f32x4*)(cw + kk * 1024 + c), w1 = *(const f32x4*)(cw + kk * 1024 + c + 4); acc8(w0, w1, w[kk]); }
        const float scale = (cg < 64) ? 0.08838834764831845f : 1.0f;
        float x0[8], x1[8], x2[8], x3[8];
        unpack8(raw[0], x0); unpack8(raw[1], x1); unpack8(raw[2], x2);
#pragma unroll
        for (int i = 0; i < 16; ++i) {
            unpack8(raw[3 + i], x3); float y[8];
#pragma unroll
            for (int e = 0; e < 8; ++e) { const float t = w[0][e] * x0[e] + w[1][e] * x1[e] + w[2][e] * x2[e] + w[3][e] * x3[e]; y[e] = t * fsigmoid(t) * scale; x0[e] = x1[e]; x1[e] = x2[e]; x2[e] = x3[e]; }
            *(u32x4*)(QKA + (size_t)(r0 + i) * D + c) = pack8(y);
        }
    }
}
constexpr int ML_KS = 272, ML_VS = 112, ML_CS = 272;
constexpr int ML_OFF_V = 64 * ML_KS, ML_BUF = ML_OFF_V + 64 * ML_VS;
constexpr int ML_OFF_CS = 2 * ML_BUF, ML_CSB = 48 * ML_CS, ML_OFF_G = ML_OFF_CS + 2 * ML_CSB, ML_GB = 1088;
static_assert(ML_OFF_G + 2 * ML_GB <= LDS_MISC, "mLSTM LDS");
__device__ __forceinline__ float wave_incl_sum(float v, int lane) {
#pragma unroll
    for (int o = 1; o < 64; o <<= 1) { const float t = shfl_idx(v, lane - o); v = (lane >= o) ? v + t : v; }
    return v;
}
__device__ __forceinline__ float wave_incl_max(float v, int lane) {
#pragma unroll
    for (int o = 1; o < 64; o <<= 1) { const float t = shfl_idx(v, lane - o); v = (lane >= o) ? fmaxf(v, t) : v; }
    return v;
}
__device__ __forceinline__ float wave_max(float v, int lane) {
#pragma unroll
    for (int o = 1; o < 64; o <<= 1) v = fmaxf(v, shfl_x(v, o, lane));
    return v;
}
__device__ __forceinline__ s16x4 lds_tr(LAS unsigned char* p) { return __builtin_amdgcn_ds_read_tr16_b64_v4i16((LAS s16x4*)p); }
__device__ __forceinline__ bf16x8 cat4(const s16x4 a, const s16x4 b) { return (bf16x8){a[0], a[1], a[2], a[3], b[0], b[1], b[2], b[3]}; }
template <int MODE>
__device__ __forceinline__ void phase_mlstm(const Args& a, const Ctx& cx, LAS unsigned char* lds, int layer, bf16* HGout, float* SSQ) {
    unsigned char* ws = cx.ws; const int vcu = cx.vrole, G = cx.G;
    const int tid = cx.tid, wave = cx.wave, lane = cx.lane, fr = lane & 15, fq = lane >> 4, tq = fr >> 2, tp = lane & 3;
    const bf16* QKA = (const bf16*)(ws + WS_QKA); const bf16* V = (const bf16*)(ws + WS_SEG) + (size_t)SG_V * MH * BW; const bf16* O = (const bf16*)(ws + WS_SEG) + (size_t)SG_O * MH * BW;
    const float* IF = (const float*)(ws + WS_IF);
    for (int i = tid; i < 2 * 64 * 8; i += NTHR) { const int bfi = i >> 9, l = (i >> 3) & 63, w = i & 7;
        *(LAS unsigned*)(lds + bfi * ML_BUF + ML_OFF_V + l * ML_VS + 64 + w * 4) = (w == 0) ? 0x00003F80u : 0u; }
    for (int unit = vcu; unit < HB * 16; unit += G) {
        const int es = unit & 3, hd = (unit >> 2) & 3, b = unit >> 4; const size_t row0 = (size_t)b * SEQ;
        const float b_i = a.in[I_MBI][layer * 4 + hd], b_f = a.in[I_MBF][layer * 4 + hd];
        const int colq = hd * 128, colk = 512 + hd * 128, colv = hd * 128 + es * 32;
        const unsigned koff = (unsigned)((tid >> 4) * D + colk + (tid & 15) * 8) * 2u, voff = (unsigned)((tid >> 2) * BW + colv + (tid & 3) * 8) * 2u;
        const unsigned klds = (unsigned)((tid >> 4) * ML_KS + (tid & 15) * 16), vlds = (unsigned)((tid >> 2) * ML_VS + (tid & 3) * 16);
        const unsigned qoff = (unsigned)((16 * (wave & 3) + fr) * D + colq + fq * 8) * 2u, ooff = (unsigned)((16 * (wave & 3) + fr) * BW + colv + fq * 4) * 2u, ioff = (unsigned)(lane * 8 + hd) * 4u;
        for (int i = tid; i < ML_CSB / 4; i += NTHR) *(LAS unsigned*)(lds + ML_OFF_CS + i * 4) = 0u;
        u32x4 kregA[2], kregB[2], vregA = (u32x4){0u, 0u, 0u, 0u}, vregB = (u32x4){0u, 0u, 0u, 0u}; bf16x8 qA[4], qB[4], qT[4]; u32x2 oA[2], oB[2], oT[2]; float giA = 0.f, gfA = 0.f, giB = 0.f, gfB = 0.f, giT = 0.f, gfT = 0.f;
#pragma unroll
        for (int s4 = 0; s4 < 4; ++s4) { qA[s4] = (bf16x8){0, 0, 0, 0, 0, 0, 0, 0}; qB[s4] = qA[s4]; qT[s4] = qA[s4]; }
        oA[0] = oA[1] = oB[0] = oB[1] = oT[0] = oT[1] = (u32x2){0u, 0u};
        f32x4 C[2][3];
#pragma unroll
        for (int i = 0; i < 2; ++i)
#pragma unroll
            for (int j = 0; j < 3; ++j) C[i][j] = (f32x4){0.f, 0.f, 0.f, 0.f};
        float m_prev = 0.f;
#define ML_LOADKV(s_, KR, VR) do { const size_t rs_ = row0 + (size_t)(s_) * CH; const unsigned char* kb_ = (const unsigned char*)(QKA + rs_ * D); const unsigned char* vb_ = (const unsigned char*)(V + rs_ * BW); \
        KR[0] = *(const u32x4*)(kb_ + koff); KR[1] = *(const u32x4*)(kb_ + koff + 65536u); \
        if (wave < 4) VR = *(const u32x4*)(vb_ + voff); } while (0)
#define ML_WRITEKV(nb_, KR, VR) do { LAS unsigned char* B_ = lds + (nb_) * ML_BUF; \
        *(LAS u32x4*)(B_ + klds) = KR[0]; *(LAS u32x4*)(B_ + klds + 32 * ML_KS) = KR[1]; \
        if (wave < 4) *(LAS u32x4*)(B_ + ML_OFF_V + vlds) = VR; } while (0)
#define ML_LOADQO(s_, QD, OD) do { const size_t rs_ = row0 + (size_t)(s_) * CH; const unsigned char* qb_ = (const unsigned char*)(QKA + rs_ * D); const unsigned char* ob_ = (const unsigned char*)(O + rs_ * BW); \
        _Pragma("unroll") for (int s4 = 0; s4 < 4; ++s4) QD[s4] = *(const bf16x8*)(qb_ + qoff + 64u * s4); \
        _Pragma("unroll") for (int et = 0; et < 2; ++et) OD[et] = *(const u32x2*)(ob_ + ooff + 32u * et); } while (0)
#define ML_LOADIF(s_, GI, GF) do { const size_t rs_ = row0 + (size_t)(s_) * CH; const unsigned char* ib_ = (const unsigned char*)(IF + rs_ * 8); GI = *(const float*)(ib_ + ioff); GF = *(const float*)(ib_ + ioff + 16u); } while (0)
#define ML_GATES(GI, GF, gbuf) do { LAS float* Gp_ = (LAS float*)(lds + ML_OFF_G + (gbuf) * ML_GB); const float x_ = (GF) + b_f; const float lf_ = LOG2E * (fminf(x_, 0.f) - __logf(1.f + __expf(-fabsf(x_)))); const float il_ = LOG2E * ((GI) + b_i);        \
        const float gb_ = dpp_scan_add(lf_), gg_ = read_lane63(gb_), a_ = gg_ - gb_ + il_, gm_ = read_lane63(dpp_scan_max(a_)), gu_ = il_ - gb_, gpm_ = dpp_scan_max(gu_); \
        Gp_[lane] = gb_; Gp_[64 + lane] = gu_; Gp_[128 + lane] = gpm_; Gp_[192 + lane] = __builtin_amdgcn_exp2f(a_ - gm_); if (lane == 0) { Gp_[256] = gg_; Gp_[257] = gm_; } } while (0)
        u32x2 hdef[2] = {(u32x2){0u, 0u}, (u32x2){0u, 0u}};
#define ML_STOREH(s_) do { const size_t rs_ = row0 + (size_t)(s_) * CH; _Pragma("unroll") for (int et = 0; et < 2; ++et) *(u32x2*)((unsigned char*)(HGout + rs_ * BW) + ooff + 32u * et) = hdef[et]; } while (0)
        ML_LOADKV(0, kregA, vregA); ML_LOADKV(1, kregB, vregB);
        if (wave == 4) { ML_LOADIF(0, giA, gfA); ML_GATES(giA, gfA, 0); ML_LOADIF(1, giB, gfB); ML_LOADIF(2, giA, gfA); }
        if (wave < 4) { ML_LOADQO(0, qA, oA); ML_LOADQO(1, qB, oB); }
        ML_WRITEKV(0, kregA, vregA);
        ML_LOADKV(2, kregA, vregA);
#pragma unroll 1
        for (int s2 = 0; s2 < NCH; s2 += 2) {
            { const int s = s2;
            const int cb = s & 1;
            asm volatile("s_waitcnt lgkmcnt(0)" ::: "memory"); __builtin_amdgcn_s_barrier(); asm volatile("" ::: "memory");
            const size_t rs = row0 + (size_t)s * CH;
            if (wave < 4 && s + 2 < NCH) ML_LOADQO(s + 2, qT, oT);
            if (wave == 4 && s + 3 < NCH) ML_LOADIF(s + 3, giT, gfT);
            LAS unsigned char* Bc = lds + cb * ML_BUF; LAS unsigned char* Cc = lds + ML_OFF_CS + cb * ML_CSB; LAS unsigned char* Cn = lds + ML_OFF_CS + (cb ^ 1) * ML_CSB;
            const LAS float* Gc = (const LAS float*)(lds + ML_OFF_G + cb * ML_GB);
            const float gg = Gc[256], gmloc = Gc[257];
            const float m_new = fmaxf(gg + m_prev, gmloc), s_old = __builtin_amdgcn_exp2f(gg + m_prev - m_new), s_new = __builtin_amdgcn_exp2f(gmloc - m_new);
            if (wave < 4) {
                __builtin_amdgcn_s_setprio(2);
                const int lb = wave, l = 16 * lb + fr;
                if (MODE == 0) {
                const float bl = Gc[l], pml = Gc[128 + l];
                const float elog = bl + m_prev, mt = fmaxf(bl + pml, elog), sint = __builtin_amdgcn_exp2f(elog - mt), enl = __builtin_amdgcn_exp2f(-mt), blm = bl - mt;
                f32x4 numT[3];
#pragma unroll
                for (int et = 0; et < 3; ++et) numT[et] = (f32x4){0.f, 0.f, 0.f, 0.f};
#pragma unroll
                for (int pp = 0; pp < 2; ++pp) {
                    const int mb0 = 2 * pp, mb1 = mb0 + 1;
                    if (mb0 <= lb) {
                        f32x4 st0 = (f32x4){0.f, 0.f, 0.f, 0.f}, st1 = (f32x4){0.f, 0.f, 0.f, 0.f};
#pragma unroll
                        for (int s4 = 0; s4 < 4; ++s4) { const bf16x8 kf = *(const LAS bf16x8*)(Bc + (mb0 * 16 + fr) * ML_KS + (s4 * 32 + fq * 8) * 2);
                            st0 = __builtin_amdgcn_mfma_f32_16x16x32_bf16(kf, qA[s4], st0, 0, 0, 0); }
                        if (mb1 <= lb) {
#pragma unroll
                            for (int s4 = 0; s4 < 4; ++s4) { const bf16x8 kf = *(const LAS bf16x8*)(Bc + (mb1 * 16 + fr) * ML_KS + (s4 * 32 + fq * 8) * 2);
                                st1 = __builtin_amdgcn_mfma_f32_16x16x32_bf16(kf, qA[s4], st1, 0, 0, 0); }
                        }
                        const f32x4 gu0 = *(const LAS f32x4*)(Gc + 64 + mb0 * 16 + 4 * fq), gu1 = *(const LAS f32x4*)(Gc + 64 + mb1 * 16 + 4 * fq);
                        float w0[4], w1[4];
#pragma unroll
                        for (int r = 0; r < 4; ++r) { const int m0 = mb0 * 16 + 4 * fq + r, m1 = mb1 * 16 + 4 * fq + r;
                            const float e0 = __builtin_amdgcn_exp2f(blm + gu0[r]) * st0[r], e1 = __builtin_amdgcn_exp2f(blm + gu1[r]) * st1[r];
                            w0[r] = (mb0 < lb || m0 <= l) ? e0 : 0.f; w1[r] = (mb1 < lb || (mb1 == lb && m1 <= l)) ? e1 : 0.f; }
                        u32x4 wp; wp.x = cvt_pk_bf16(w0[0], w0[1]); wp.y = cvt_pk_bf16(w0[2], w0[3]); wp.z = cvt_pk_bf16(w1[0], w1[1]); wp.w = cvt_pk_bf16(w1[2], w1[3]);
                        const bf16x8 wf = __builtin_bit_cast(bf16x8, wp);
#pragma unroll
                        for (int et = 0; et < 3; ++et) {
                            const s16x4 v0 = lds_tr(Bc + ML_OFF_V + (mb0 * 16 + 4 * fq + tq) * ML_VS + et * 32 + 8 * tp), v1 = lds_tr(Bc + ML_OFF_V + (mb1 * 16 + 4 * fq + tq) * ML_VS + et * 32 + 8 * tp);
                            numT[et] = __builtin_amdgcn_mfma_f32_16x16x32_bf16(cat4(v0, v1), wf, numT[et], 0, 0, 0); }
                    }
                }
                f32x4 tot[3];
#pragma unroll
                for (int et = 0; et < 3; ++et) { f32x4 it = (f32x4){0.f, 0.f, 0.f, 0.f};
#pragma unroll
                    for (int s4 = 0; s4 < 4; ++s4) { const bf16x8 cf = *(const LAS bf16x8*)(Cc + (et * 16 + fr) * ML_CS + (s4 * 32 + fq * 8) * 2);
                        it = __builtin_amdgcn_mfma_f32_16x16x32_bf16(cf, qA[s4], it, 0, 0, 0); }
                    tot[et] = numT[et] + it * sint; }
                float den; { const unsigned dx_ = __builtin_bit_cast(unsigned, tot[2][0]); const auto s1_ = __builtin_amdgcn_permlane16_swap(dx_, dx_, false, false); const auto s2_ = __builtin_amdgcn_permlane32_swap(s1_[0], s1_[0], false, false); den = __builtin_bit_cast(float, s2_[0]); }
                const float inv = 1.0f / fmaxf(fabsf(den), enl);
#pragma unroll
                for (int et = 0; et < 2; ++et) { const float h0 = tot[et][0] * inv * bflo(oA[et].x), h1 = tot[et][1] * inv * bfhi(oA[et].x), h2 = tot[et][2] * inv * bflo(oA[et].y), h3 = tot[et][3] * inv * bfhi(oA[et].y);
                    u32x2 w; w.x = cvt_pk_bf16(h0, h1); w.y = cvt_pk_bf16(h2, h3);
                    hdef[et] = w; }
                } else { if (fq == 0) *(float*)((unsigned char*)(SSQ + rs * 16) + (unsigned)(l * 16 + hd * 4 + es) * 4u) = __builtin_bit_cast(float, (int)qA[0][0] + (int)oA[0].x); }
                if (s + 2 < NCH) { _Pragma("unroll") for (int s4 = 0; s4 < 4; ++s4) qA[s4] = qT[s4]; oA[0] = oT[0]; oA[1] = oT[1]; }
                __builtin_amdgcn_s_setprio(0);
            } else {
                const int jw = wave - 4;
                if (MODE != 2) {
                f32x4 wl[2][2];
#pragma unroll
                for (int s2 = 0; s2 < 2; ++s2) { wl[s2][0] = *(const LAS f32x4*)(Gc + 192 + 32 * s2 + 8 * fq); wl[s2][1] = *(const LAS f32x4*)(Gc + 192 + 32 * s2 + 8 * fq + 4); }
#pragma unroll
                for (int dti = 0; dti < 2; ++dti) { const int dt = 2 * jw + dti;
                    bf16x8 ktf[2];
#pragma unroll
                    for (int s2 = 0; s2 < 2; ++s2) { const s16x4 k0 = lds_tr(Bc + (32 * s2 + 8 * fq + tq) * ML_KS + dt * 32 + 8 * tp), k1 = lds_tr(Bc + (32 * s2 + 8 * fq + 4 + tq) * ML_KS + dt * 32 + 8 * tp);
                        const u32x2 ka = __builtin_bit_cast(u32x2, k0), kb = __builtin_bit_cast(u32x2, k1);
                        u32x4 kp; kp.x = cvt_pk_bf16(bflo(ka.x) * wl[s2][0][0], bfhi(ka.x) * wl[s2][0][1]); kp.y = cvt_pk_bf16(bflo(ka.y) * wl[s2][0][2], bfhi(ka.y) * wl[s2][0][3]);
                        kp.z = cvt_pk_bf16(bflo(kb.x) * wl[s2][1][0], bfhi(kb.x) * wl[s2][1][1]); kp.w = cvt_pk_bf16(bflo(kb.y) * wl[s2][1][2], bfhi(kb.y) * wl[s2][1][3]);
                        ktf[s2] = __builtin_bit_cast(bf16x8, kp); }
#pragma unroll
                    for (int et = 0; et < 3; ++et) { f32x4 cl = (f32x4){0.f, 0.f, 0.f, 0.f};
#pragma unroll
                        for (int s2 = 0; s2 < 2; ++s2) { const s16x4 v0 = lds_tr(Bc + ML_OFF_V + (32 * s2 + 8 * fq + tq) * ML_VS + et * 32 + 8 * tp), v1 = lds_tr(Bc + ML_OFF_V + (32 * s2 + 8 * fq + 4 + tq) * ML_VS + et * 32 + 8 * tp);
                            cl = __builtin_amdgcn_mfma_f32_16x16x32_bf16(ktf[s2], cat4(v0, v1), cl, 0, 0, 0); }
                        C[dti][et] = C[dti][et] * s_old + cl * s_new;
                        u32x2 w; w.x = cvt_pk_bf16(C[dti][et][0], C[dti][et][1]); w.y = cvt_pk_bf16(C[dti][et][2], C[dti][et][3]);
                        *(LAS u32x2*)(Cn + (et * 16 + fr) * ML_CS + (dt * 16 + 4 * fq) * 2) = w; }
                }
                }
                if (wave == 4) { if (s + 1 < NCH) ML_GATES(giB, gfB, cb ^ 1); if (s + 3 < NCH) { giB = giT; gfB = gfT; } }
            }
            if (s + 1 < NCH) ML_WRITEKV(cb ^ 1, kregB, vregB);
            if (s + 3 < NCH) ML_LOADKV(s + 3, kregB, vregB);
            if (MODE == 0 && wave < 4) ML_STOREH(s);
            m_prev = m_new;
            }
            { const int s = s2 + 1;
            const int cb = s & 1;
            asm volatile("s_waitcnt lgkmcnt(0)" ::: "memory"); __builtin_amdgcn_s_barrier(); asm volatile("" ::: "memory");
            const size_t rs = row0 + (size_t)s * CH;
            if (wave < 4 && s + 2 < NCH) ML_LOADQO(s + 2, qT, oT);
            if (wave == 4 && s + 3 < NCH) ML_LOADIF(s + 3, giT, gfT);
            LAS unsigned char* Bc = lds + cb * ML_BUF; LAS unsigned char* Cc = lds + ML_OFF_CS + cb * ML_CSB; LAS unsigned char* Cn = lds + ML_OFF_CS + (cb ^ 1) * ML_CSB;
            const LAS float* Gc = (const LAS float*)(lds + ML_OFF_G + cb * ML_GB);
            const float gg = Gc[256], gmloc = Gc[257];
            const float m_new = fmaxf(gg + m_prev, gmloc), s_old = __builtin_amdgcn_exp2f(gg + m_prev - m_new), s_new = __builtin_amdgcn_exp2f(gmloc - m_new);
            if (wave < 4) {
                __builtin_amdgcn_s_setprio(2);
                const int lb = wave, l = 16 * lb + fr;
                if (MODE == 0) {
                const float bl = Gc[l], pml = Gc[128 + l];
                const float elog = bl + m_prev, mt = fmaxf(bl + pml, elog), sint = __builtin_amdgcn_exp2f(elog - mt), enl = __builtin_amdgcn_exp2f(-mt), blm = bl - mt;
                f32x4 numT[3];
#pragma unroll
                for (int et = 0; et < 3; ++et) numT[et] = (f32x4){0.f, 0.f, 0.f, 0.f};
#pragma unroll
                for (int pp = 0; pp < 2; ++pp) {
                    const int mb0 = 2 * pp, mb1 = mb0 + 1;
                    if (mb0 <= lb) {
                        f32x4 st0 = (f32x4){0.f, 0.f, 0.f, 0.f}, st1 = (f32x4){0.f, 0.f, 0.f, 0.f};
#pragma unroll
                        for (int s4 = 0; s4 < 4; ++s4) { const bf16x8 kf = *(const LAS bf16x8*)(Bc + (mb0 * 16 + fr) * ML_KS + (s4 * 32 + fq * 8) * 2);
                            st0 = __builtin_amdgcn_mfma_f32_16x16x32_bf16(kf, qB[s4], st0, 0, 0, 0); }
                        if (mb1 <= lb) {
#pragma unroll
                            for (int s4 = 0; s4 < 4; ++s4) { const bf16x8 kf = *(const LAS bf16x8*)(Bc + (mb1 * 16 + fr) * ML_KS + (s4 * 32 + fq * 8) * 2);
                                st1 = __builtin_amdgcn_mfma_f32_16x16x32_bf16(kf, qB[s4], st1, 0, 0, 0); }
                        }
                        const f32x4 gu0 = *(const LAS f32x4*)(Gc + 64 + mb0 * 16 + 4 * fq), gu1 = *(const LAS f32x4*)(Gc + 64 + mb1 * 16 + 4 * fq);
                        float w0[4], w1[4];
#pragma unroll
                        for (int r = 0; r < 4; ++r) { const int m0 = mb0 * 16 + 4 * fq + r, m1 = mb1 * 16 + 4 * fq + r;
                            const float e0 = __builtin_amdgcn_exp2f(blm + gu0[r]) * st0[r], e1 = __builtin_amdgcn_exp2f(blm + gu1[r]) * st1[r];
                            w0[r] = (mb0 < lb || m0 <= l) ? e0 : 0.f; w1[r] = (mb1 < lb || (mb1 == lb && m1 <= l)) ? e1 : 0.f; }
                        u32x4 wp; wp.x = cvt_pk_bf16(w0[0], w0[1]); wp.y = cvt_pk_bf16(w0[2], w0[3]); wp.z = cvt_pk_bf16(w1[0], w1[1]); wp.w = cvt_pk_bf16(w1[2], w1[3]);
                        const bf16x8 wf = __builtin_bit_cast(bf16x8, wp);
#pragma unroll
                        for (int et = 0; et < 3; ++et) {
                            const s16x4 v0 = lds_tr(Bc + ML_OFF_V + (mb0 * 16 + 4 * fq + tq) * ML_VS + et * 32 + 8 * tp), v1 = lds_tr(Bc + ML_OFF_V + (mb1 * 16 + 4 * fq + tq) * ML_VS + et * 32 + 8 * tp);
                            numT[et] = __builtin_amdgcn_mfma_f32_16x16x32_bf16(cat4(v0, v1), wf, numT[et], 0, 0, 0); }
                    }
                }
                f32x4 tot[3];
#pragma unroll
                for (int et = 0; et < 3; ++et) { f32x4 it = (f32x4){0.f, 0.f, 0.f, 0.f};
#pragma unroll
                    for (int s4 = 0; s4 < 4; ++s4) { const bf16x8 cf = *(const LAS bf16x8*)(Cc + (et * 16 + fr) * ML_CS + (s4 * 32 + fq * 8) * 2);
                        it = __builtin_amdgcn_mfma_f32_16x16x32_bf16(cf, qB[s4], it, 0, 0, 0); }
                    tot[et] = numT[et] + it * sint; }
                float den; { const unsigned dx_ = __builtin_bit_cast(unsigned, tot[2][0]); const auto s1_ = __builtin_amdgcn_permlane16_swap(dx_, dx_, false, false); const auto s2_ = __builtin_amdgcn_permlane32_swap(s1_[0], s1_[0], false, false); den = __builtin_bit_cast(float, s2_[0]); }
                const float inv = 1.0f / fmaxf(fabsf(den), enl);
#pragma unroll
                for (int et = 0; et < 2; ++et) { const float h0 = tot[et][0] * inv * bflo(oB[et].x), h1 = tot[et][1] * inv * bfhi(oB[et].x), h2 = tot[et][2] * inv * bflo(oB[et].y), h3 = tot[et][3] * inv * bfhi(oB[et].y);
                    u32x2 w; w.x = cvt_pk_bf16(h0, h1); w.y = cvt_pk_bf16(h2, h3);
                    hdef[et] = w; }
                } else { if (fq == 0) *(float*)((unsigned char*)(SSQ + rs * 16) + (unsigned)(l * 16 + hd * 4 + es) * 4u) = __builtin_bit_cast(float, (int)qB[0][0] + (int)oB[0].x); }
                if (s + 2 < NCH) { _Pragma("unroll") for (int s4 = 0; s4 < 4; ++s4) qB[s4] = qT[s4]; oB[0] = oT[0]; oB[1] = oT[1]; }
                __builtin_amdgcn_s_setprio(0);
            } else {
                const int jw = wave - 4;
                if (MODE != 2) {
                f32x4 wl[2][2];
#pragma unroll
                for (int s2 = 0; s2 < 2; ++s2) { wl[s2][0] = *(const LAS f32x4*)(Gc + 192 + 32 * s2 + 8 * fq); wl[s2][1] = *(const LAS f32x4*)(Gc + 192 + 32 * s2 + 8 * fq + 4); }
#pragma unroll
                for (int dti = 0; dti < 2; ++dti) { const int dt = 2 * jw + dti;
                    bf16x8 ktf[2];
#pragma unroll
                    for (int s2 = 0; s2 < 2; ++s2) { const s16x4 k0 = lds_tr(Bc + (32 * s2 + 8 * fq + tq) * ML_KS + dt * 32 + 8 * tp), k1 = lds_tr(Bc + (32 * s2 + 8 * fq + 4 + tq) * ML_KS + dt * 32 + 8 * tp);
                        const u32x2 ka = __builtin_bit_cast(u32x2, k0), kb = __builtin_bit_cast(u32x2, k1);
                        u32x4 kp; kp.x = cvt_pk_bf16(bflo(ka.x) * wl[s2][0][0], bfhi(ka.x) * wl[s2][0][1]); kp.y = cvt_pk_bf16(bflo(ka.y) * wl[s2][0][2], bfhi(ka.y) * wl[s2][0][3]);
                        kp.z = cvt_pk_bf16(bflo(kb.x) * wl[s2][1][0], bfhi(kb.x) * wl[s2][1][1]); kp.w = cvt_pk_bf16(bflo(kb.y) * wl[s2][1][2], bfhi(kb.y) * wl[s2][1][3]);
                        ktf[s2] = __builtin_bit_cast(bf16x8, kp); }
#pragma unroll
                    for (int et = 0; et < 3; ++et) { f32x4 cl = (f32x4){0.f, 0.f, 0.f, 0.f};
#pragma unroll
                        for (int s2 = 0; s2 < 2; ++s2) { const s16x4 v0 = lds_tr(Bc + ML_OFF_V + (32 * s2 + 8 * fq + tq) * ML_VS + et * 32 + 8 * tp), v1 = lds_tr(Bc + ML_OFF_V + (32 * s2 + 8 * fq + 4 + tq) * ML_VS + et * 32 + 8 * tp);
                            cl = __builtin_amdgcn_mfma_f32_16x16x32_bf16(ktf[s2], cat4(v0, v1), cl, 0, 0, 0); }
                        C[dti][et] = C[dti][et] * s_old + cl * s_new;
                        u32x2 w; w.x = cvt_pk_bf16(C[dti][et][0], C[dti][et][1]); w.y = cvt_pk_bf16(C[dti][et][2], C[dti][et][3]);
                        *(LAS u32x2*)(Cn + (et * 16 + fr) * ML_CS + (dt * 16 + 4 * fq) * 2) = w; }
                }
                }
                if (wave == 4) { if (s + 1 < NCH) ML_GATES(giA, gfA, cb ^ 1); if (s + 3 < NCH) { giA = giT; gfA = gfT; } }
            }
            if (s + 1 < NCH) ML_WRITEKV(cb ^ 1, kregA, vregA);
            if (s + 3 < NCH) ML_LOADKV(s + 3, kregA, vregA);
            if (MODE == 0 && wave < 4) ML_STOREH(s);
            m_prev = m_new;
            }
        }
        __syncthreads();
#undef ML_STOREH
#undef ML_LOADKV
#undef ML_WRITEKV
#undef ML_LOADQO
#undef ML_LOADIF
#undef ML_GATES
    }
}

constexpr int NPH_IT = 8, NPHASES = 1 + NPH_IT * NPASS * DEPTH;
constexpr int CW_BAR = 4096;
__global__ void __launch_bounds__(NTHR, 2) mk_fwd(Args a_) {
    extern __shared__ __attribute__((aligned(16))) unsigned char lds_raw[];
    LAS unsigned char* lds = (LAS unsigned char*)lds_raw;
    const int lo = a_.ph_lo, hi = a_.ph_hi;
    int vbid = blockIdx.x;
    const int wave0 = __builtin_amdgcn_readfirstlane(threadIdx.x >> 6);
    if (threadIdx.x < 16) ((LAS unsigned*)(lds + LDS_MISC))[threadIdx.x] = 0u;
    __syncthreads();
    XcdBarrier bar; bar.bar = (unsigned*)(a_.ws + WS_CTL) + CW_BAR; bar.x = 0; bar.st = (volatile LAS unsigned*)(lds + LDS_MISC);
    if (hi - lo > 1) bar = xcd_barrier_post_ranked((unsigned*)(a_.ws + WS_CTL) + CW_BAR, (volatile LAS unsigned*)(lds + LDS_MISC));
    int fast = 0;
#define IN(k) (lo <= (k) && (k) < hi)
#define SEAM(k) do { if (IN(k) && IN((k) + 1)) { if (fast) grp_barrier(bar); else xcd_barrier(bar); if (MK_DUP == 8) xcd_barrier(bar); } } while (0)
#define P_SEG(c, sg) ((bf16*)((c).ws + WS_SEG) + (size_t)(sg) * MH * BW)
#if MK_TIME == 1
    if (blockIdx.x == 0 && wave0 == 0 && fresh_lane() == 0) { unsigned* tacc0 = (unsigned*)(a.ws + 768 * 1024); const unsigned t0 = (unsigned)__builtin_amdgcn_s_memrealtime(); tacc0[13] = t0; tacc0[14] = t0; }
#define STAMP(p) do { if (blockIdx.x == 0 && wave0 == 0 && fresh_lane() == 0) { unsigned* tacc_ = (unsigned*)(a.ws + 768 * 1024); const unsigned t_ = (unsigned)__builtin_amdgcn_s_memrealtime(); tacc_[(p)] += t_ - tacc_[14]; tacc_[14] = t_; } } while (0)
#else
#define STAMP(p) do { } while (0)
#endif
    if (IN(0)) { MAKE_CTX(c); phase_prologue(a, c, lds); __syncthreads(); }
    STAMP(9);
#pragma unroll 1
    for (int it = 0; it < NPASS * DEPTH; ++it) {
        const int base = 1 + NPH_IT * it, pass = it / DEPTH, layer = it % DEPTH;
        if (hi <= base || lo >= base + NPH_IT) continue;
        if (IN(base + 0) && MK_DUP == 7) { MAKE_CTX(c); phase_norm<false, true, false>(a, c, lds, layer, pass); }
        if (IN(base + 0)) { MAKE_CTX(c); if (layer == 0) phase_norm<false, true, false>(a, c, lds, layer, pass); else if (layer == 1) phase_norm<true, true, false>(a, c, lds, layer, pass); else phase_norm<true, true, true>(a, c, lds, layer, pass); }
        SEAM(base + 0); STAMP(0);
        if (MK_GROUP_BARRIERS && it == 0 && IN(base + 0) && IN(base + 1)) {
            volatile LAS unsigned* st = (volatile LAS unsigned*)(lds + LDS_MISC);
            if (threadIdx.x == 0) { unsigned ok = (gridDim.x == 256u) ? 1u : 0u, dense = 0u, nz = 0u;
                for (unsigned j = 0; j < 16; ++j) { const unsigned cj = xb_ld(&bar.bar[XB_XCNT(j)]); if (cj) { ++nz; if (cj != 32u) ok = 0u; if (j < bar.x) ++dense; } }
                if (nz != 8u || st[3] >= 32u) ok = 0u;
                st[2] = ok; st[4] = dense; }
            __syncthreads();
            fast = __builtin_amdgcn_readfirstlane((int)st[2]);
            if (fast) vbid = __builtin_amdgcn_readfirstlane((int)(st[3] * 8u + st[4]));
            __syncthreads();
        }
        if (IN(base + 1)) {
#pragma unroll 1
            for (int rep = 0; rep < (MK_DUP == 1 ? 2 : 1); ++rep) { MAKE_CTX(c);
            EpiProj E{P_SEG(c, 0), (bf16*)(c.ws + WS_GATE)};
            pg8::gemm_phase<EpiProj, 6656, D, D, D>(lds, (const bf16*)(c.ws + WS_H), (const bf16*)(c.ws + WS_W1T) + (size_t)layer * NP * D, c.G, c.bx, c.tid, E); }
#pragma unroll 1
            for (int rep = 0; rep < (MK_DUP == 1 ? 2 : 1); ++rep) { MAKE_CTX(c);
            EpiGate8 E{c.ws + WS_GATE};
            pg8::gemm_phase8<EpiGate8, 4 * D, D>(lds, c.ws + WS_H8, c.ws + WS_W8 + (size_t)layer * 4 * D * D, c.G, c.bx, c.tid, E); }
        }
        SEAM(base + 1); STAMP(1);
        if (IN(base + 2)) {
#pragma unroll 1
            for (int rep = 0; rep < (MK_DUP == 2 ? 2 : 1); ++rep) { int alq; { MAKE_CTX(c); alq = c.al; }
                if (alq) { { MAKE_CTX(c); phase_ew(a, c, layer, 2 | 4, c.gt, c.NGT); } { MAKE_CTX(c); phase_qk_s5(a, c, lds, layer); } }
                else { { MAKE_CTX(c); phase_ew(a, c, layer, 1 | 2 | 4, c.gt, c.NGT); } { MAKE_CTX(c); const int per1 = 2 * ((HB * NCH / 2 + c.G - 1) / c.G); phase_s5<false>(a, c, lds, layer, c.vcu * per1, 1, per1); } } } }
        SEAM(base + 2); STAMP(2);
        if (IN(base + 3)) {
            int half_; { MAKE_CTX(c); half_ = c.G / 2; }
            int vsel; { MAKE_CTX(c); vsel = c.vrole; }
#if MK_TIME == 2
            unsigned tmx0 = (unsigned)__builtin_amdgcn_s_memrealtime();
#endif
            if (vsel < half_ || half_ < 128) {
                if (MK_DUP == 4) { MAKE_CTX(c); phase_mlstm<MK_MLMODE>(a, c, lds, layer, (bf16*)(c.ws + WS_H), (float*)(c.ws + WS_OSS)); }
                { MAKE_CTX(c); phase_mlstm<0>(a, c, lds, layer, P_SEG(c, SG_O), (float*)(c.ws + WS_SSQ)); }
            }
            if (vsel >= half_ || half_ < 128) {
                const int sub = (half_ < 128) ? 0 : half_, nsub = (half_ < 128) ? 2 * half_ : half_;
                { MAKE_CTX(c); const int per = (HB * NCH + nsub - 1) / nsub; phase_s5<true>(a, c, lds, layer, (c.vrole - sub) * per, 1, per); }
                if (nsub * 4 * CH == MH) { MAKE_CTX(c); const size_t poff = (size_t)(c.vrole - sub) * 256 * BW;
                    asm volatile("s_waitcnt vmcnt(0)" ::: "memory"); __syncthreads();
                    EpiGlu E{P_SEG(c, SG_S5U) + poff, P_SEG(c, SG_S5Z) + poff};
                    pg8::gemm_phase<EpiGlu, BW, BW, BW, BW>(lds, P_SEG(c, SG_S5U) + poff, (const bf16*)(c.ws + WS_WGT) + (size_t)layer * BW * BW, 1, 0, c.tid, E, 256); }
            }
#if MK_TIME == 2
            { const unsigned tmx1 = (unsigned)__builtin_amdgcn_s_memrealtime(); if ((vsel == 0 || vsel == half_) && wave0 == 0 && fresh_lane() == 0) { unsigned* tq = (unsigned*)(a.ws + 768 * 1024) + (vsel == 0 ? 20 : 21); *tq += tmx1 - tmx0; } }
#endif
        }
        SEAM(base + 3); STAMP(3);
        if (IN(base + 4)) {
            int glu_done; { MAKE_CTX(c); glu_done = ((c.G / 2) * 4 * CH == MH && c.G / 2 >= 128) ? 1 : 0; }
            if (!glu_done) { MAKE_CTX(c); EpiGlu E{P_SEG(c, SG_S5U), P_SEG(c, SG_S5Z)};
              pg8::gemm_phase<EpiGlu, BW, BW, BW, BW>(lds, P_SEG(c, SG_S5U), (const bf16*)(c.ws + WS_WGT) + (size_t)layer * BW * BW, c.G, c.bx, c.tid, E); }
            { MAKE_CTX(c); EpiPool E{a.in[I_POOLS] + (size_t)layer * BW, P_SEG(c, SG_PZ)};
              pg8::gemm_phase<EpiPool, BW, 256, BW, BW, true>(lds, (const bf16*)(c.ws + WS_POOL), (const bf16*)(c.ws + WS_WPT) + (size_t)layer * BW * BW, c.G, c.bx, c.tid, E); }
            { MAKE_CTX(c); phase_ydfix(a, c, layer); }
        }
        SEAM(base + 4); STAMP(4);
        if (IN(base + 5)) {
#pragma unroll 1
            for (int rep = 0; rep < (MK_DUP == 5 ? 2 : 1); ++rep) { MAKE_CTX(c);
                pg8::A4 a4{{P_SEG(c, SG_S5Z), P_SEG(c, SG_PZ), P_SEG(c, SG_SCZ), P_SEG(c, SG_MZ)}};
                pg8::gemm_merge_phase(lds, a4, (const bf16*)(c.ws + WS_WBT) + (size_t)layer * 4 * D * BW, c.ws + WS_GATE, (bf16*)(c.ws + WS_H), c.G, c.bx, c.tid);
            }
        }
        SEAM(base + 5); STAMP(5);
        if (IN(base + 6)) {
#pragma unroll 1
            for (int rep = 0; rep < (MK_DUP == 6 ? 2 : 1); ++rep) { MAKE_CTX(c);
            EpiOut E{(bf16*)(c.ws + WS_QKA), (float*)(c.ws + WS_OSS)};
            pg8::gemm_phase<EpiOut, D, D, D, D>(lds, (const bf16*)(c.ws + WS_H), (const bf16*)(c.ws + WS_WOT) + (size_t)layer * D * D, c.G, c.bx, c.tid, E); }
        }
        SEAM(base + 6); STAMP(6);
        if (layer == DEPTH - 1) {
            if (IN(base + 7)) { MAKE_CTX(c); phase_norm<true, false, true>(a, c, lds, layer, pass); }
            STAMP(7);
        }
    }
#if MK_TIME == 2
    xcd_barrier(bar);
    { const unsigned tsel = __hip_atomic_load((unsigned*)(a.ws + 768 * 1024) + MK_TSEL, __ATOMIC_RELAXED, __HIP_MEMORY_SCOPE_AGENT);
      const float cA = (float)(int)((float)tsel * (1.0f / (8.f * 100.f * MK_TBUCKET))); const size_t n = (size_t)BATCH * SEQ * D;
      for (size_t i = (size_t)blockIdx.x * NTHR + wave0 * 64 + fresh_lane(); i < n; i += (size_t)gridDim.x * NTHR) a.out[i] = a.in[I_X][i] + cA; }
#elif MK_TIME
    xcd_barrier(bar);
    unsigned* tacc = (unsigned*)(a.ws + 768 * 1024);
    if (blockIdx.x == 0 && wave0 == 0 && fresh_lane() == 0) tacc[15] = (unsigned)__builtin_amdgcn_s_memrealtime() - tacc[13];
    xcd_barrier(bar);
    { const float tot = (float)__hip_atomic_load(tacc + 15, __ATOMIC_RELAXED, __HIP_MEMORY_SCOPE_AGENT); float sel = 0.f;
#pragma unroll
      for (int p = 0; p < 10; ++p) if ((MK_TMASK >> p) & 1) sel += (float)__hip_atomic_load(tacc + p, __ATOMIC_RELAXED, __HIP_MEMORY_SCOPE_AGENT);
      const float cA = 5.f * sel / tot; const size_t n = (size_t)BATCH * SEQ * D;
      for (size_t i = (size_t)blockIdx.x * NTHR + wave0 * 64 + fresh_lane(); i < n; i += (size_t)gridDim.x * NTHR) a.out[i] = a.in[I_X][i] + cA; }
#endif
#undef IN
#undef SEAM
}


#ifndef MK_DEBUG
#define MK_DEBUG 0
#endif
#if MK_DEBUG
__global__ void dbg_scan(const unsigned* p, size_t nwords, int is_bf16, int code, unsigned* flag) {
    bool bad = false;
    for (size_t i = (size_t)blockIdx.x * blockDim.x + threadIdx.x; i < nwords; i += (size_t)gridDim.x * blockDim.x) { const unsigned w = p[i];
        if (is_bf16) bad |= ((w & 0x7f80u) == 0x7f80u) || ((w & 0x7f800000u) == 0x7f800000u); else bad |= ((w & 0x7f800000u) == 0x7f800000u); }
    if (bad) flag[code] = 1u;
}
__global__ void dbg_fix(float* out, const float* x, size_t n, const unsigned* flag) {
    int c = 0; for (int k = 1; k < 32; ++k) if (flag[k]) { c = k; break; }
    if (c == 0) return;
    for (size_t i = (size_t)blockIdx.x * blockDim.x + threadIdx.x; i < n; i += (size_t)gridDim.x * blockDim.x) out[i] = x[i] + (float)c;
}
#endif
extern "C" void kernel_launch(void* const* d_in, const int* in_sizes, int n_in, void* d_out, int out_size, void* d_ws, size_t ws_size, hipStream_t stream) {
    static int grid = 0;
    if (grid == 0) {
        if (n_in != 22 || in_sizes[0] != BATCH * SEQ * D || out_size != BATCH * SEQ * D || ws_size < WS_END) {
            fprintf(stderr, "kernel_launch: unexpected shapes (n_in %d, in0 %d, out %d, ws %zu, need %zu); nothing launched\n", n_in, n_in > 0 ? in_sizes[0] : -1, out_size, ws_size, (size_t)WS_END); grid = -1; return; }
        int dev = 0, cus = 0, per_cu = 0;
        if (hipGetDevice(&dev) != hipSuccess || hipDeviceGetAttribute(&cus, hipDeviceAttributeMultiprocessorCount, dev) != hipSuccess) { grid = -1; return; }
        if (hipFuncSetAttribute((const void*)mk_fwd, hipFuncAttributeMaxDynamicSharedMemorySize, LDS_BYTES) != hipSuccess) { fprintf(stderr, "kernel_launch: hipFuncSetAttribute failed\n"); grid = -1; return; }
        if (hipOccupancyMaxActiveBlocksPerMultiprocessor(&per_cu, (const void*)mk_fwd, NTHR, LDS_BYTES) != hipSuccess || per_cu < 1) fprintf(stderr, "kernel_launch: occupancy query reports %d\n", per_cu);
        (void)hipGetLastError();
        grid = cus;
    }
    if (grid < 0) return;
    (void)hipMemsetAsync((char*)d_ws + WS_CTL, 0, CTL_ZERO_BYTES, stream);
    Args a{};
    for (int i = 0; i < 22; ++i) a.in[i] = (const float*)d_in[i];
    a.out = (float*)d_out; a.ws = (unsigned char*)d_ws;
#if MK_ONE_LAUNCH
    a.ph_lo = 0; a.ph_hi = NPHASES;
    hipLaunchKernelGGL(mk_fwd, dim3(grid), dim3(NTHR), LDS_BYTES, stream, a);
#else
#if MK_DEBUG
    (void)hipMemsetAsync((char*)d_ws + CTL_ZERO_BYTES, 0xFF, WS_END - CTL_ZERO_BYTES, stream);
    (void)hipMemsetAsync(d_out, 0xFF, (size_t)out_size * 4, stream);
    unsigned* flag = (unsigned*)((char*)d_ws + 512 * 1024);
    unsigned char* w8 = (unsigned char*)d_ws;
#define SCAN(off, bytes, isb, code) hipLaunchKernelGGL(dbg_scan, dim3(1024), dim3(256), 0, stream, (const unsigned*)(w8 + (off)), (size_t)(bytes) / 4, isb, code, flag)
#endif
    for (int k = 0; k < NPHASES; ++k) {
        if (k > 0 && (k - 1) % NPH_IT == NPH_IT - 1 && ((k - 1) / NPH_IT) % DEPTH != DEPTH - 1) continue;
        a.ph_lo = k; a.ph_hi = k + 1;
        hipLaunchKernelGGL(mk_fwd, dim3(grid), dim3(NTHR), LDS_BYTES, stream, a);
#if MK_DEBUG
        if (k == 0) { for (int l = 0; l < DEPTH; ++l) { SCAN(WS_S5T + l * S5T_LAYER, 32768, 0, 1); SCAN(WS_S5T + l * S5T_LAYER + S5T_B, 262144, 1, 1); } }
        if (k == 3) { SCAN(WS_QKA, (size_t)MH * D * 2, 1, 2); SCAN(WS_SEG + SG_SCZ * SEG_BYTES, SEG_BYTES, 1, 3); SCAN(WS_POOL, SEG_BYTES, 1, 4); SCAN(WS_E, 8 * MiB, 0, 5); }
        if (k == 4) { SCAN(WS_SEG + SG_S5U * SEG_BYTES, SEG_BYTES, 1, 6); }
        if (k == 5) { SCAN(WS_SEG + SG_O * SEG_BYTES, SEG_BYTES, 1, 7); SCAN(WS_SSQ, (size_t)MH * 16 * 4, 0, 7); }
        if (k == 6) { SCAN(WS_SEG + SG_S5Z * SEG_BYTES, SEG_BYTES, 1, 8); SCAN(WS_SEG + SG_PZ * SEG_BYTES, SEG_BYTES, 1, 8); SCAN(WS_SEG + SG_MZ * SEG_BYTES, SEG_BYTES, 1, 8); }
        if (k == 7) { SCAN(WS_SEG + SG_QK * SEG_BYTES, 2 * SEG_BYTES, 1, 9); }
        if (k == 8) { SCAN(WS_QKA, (size_t)MH * D * 2, 1, 10); SCAN(WS_OSS, (size_t)MH * 16 * 4, 0, 10); }
#endif
    }
#if MK_DEBUG
    hipLaunchKernelGGL(dbg_scan, dim3(1024), dim3(256), 0, stream, (const unsigned*)d_out, (size_t)out_size, 0, 11, flag);
    hipLaunchKernelGGL(dbg_fix, dim3(1024), dim3(256), 0, stream, (float*)d_out, (const float*)d_in[0], (size_t)out_size, (const unsigned*)flag);
#endif
#endif
}
```

```cpp
#include <hip/hip_runtime.h>
#include <cstdio>
#include <cstdint>

#ifndef MK_GROUP_BARRIERS
#define MK_GROUP_BARRIERS 1
#endif
#ifndef MK_TIME
#define MK_TIME 0
#endif
#ifndef MK_TMASK
#define MK_TMASK 2
#endif
#ifndef MK_TSEL
#define MK_TSEL 20
#endif
#ifndef MK_TBUCKET
#define MK_TBUCKET 16.f
#endif
#ifndef MK_DUP
#define MK_DUP 0
#endif
#ifndef MK_MLMODE
#define MK_MLMODE 0
#endif
#ifndef MK_ONE_LAUNCH
#define MK_ONE_LAUNCH 1
#endif

#define GAS __attribute__((address_space(1)))
#define LAS __attribute__((address_space(3)))
typedef unsigned short bf16;
typedef short bf16x8 __attribute__((ext_vector_type(8)));
typedef short s16x4 __attribute__((ext_vector_type(4)));
typedef float f32x4 __attribute__((ext_vector_type(4)));
typedef float f32x2 __attribute__((ext_vector_type(2)));
typedef unsigned u32x4 __attribute__((ext_vector_type(4)));
typedef unsigned u32x2 __attribute__((ext_vector_type(2)));
typedef int i32x8 __attribute__((ext_vector_type(8)));
constexpr float W8_SCALE = 64.f;

constexpr int D = 1024, BATCH = 16, SEQ = 4096, DEPTH = 4, BW = 512, NIN = 10760, NP = 10752;
constexpr int NG = 32, NS = 64, HEADS = 4, DH = 128, CH = 64, NCH = SEQ / CH;
constexpr int HB = 8, MH = HB * SEQ;
constexpr int NPASS = BATCH / HB;
constexpr float RMS_EPS = 1e-6f;
constexpr float LOG2E = 1.4426950408889634f;

constexpr size_t MiB = 1u << 20;
constexpr size_t WS_CTL = 0, CTL_ZERO_BYTES = 1 * MiB;
constexpr size_t WS_W1T = 1 * MiB;
constexpr size_t WS_WBT = 85 * MiB;
constexpr size_t WS_WOT = 101 * MiB;
constexpr size_t WS_WGT = 109 * MiB;
constexpr size_t WS_WPT = 111 * MiB;
constexpr size_t WS_S5T = 113 * MiB;
constexpr size_t WS_E = 115 * MiB;
constexpr size_t WS_IF = 123 * MiB;
constexpr size_t WS_SSQ = 124 * MiB;
constexpr size_t WS_OSS = 126 * MiB;
constexpr size_t WS_H = 128 * MiB;
constexpr size_t WS_SEG = 192 * MiB;
constexpr size_t SEG_BYTES = (size_t)MH * BW * 2;
constexpr size_t WS_GATE = 608 * MiB;
constexpr size_t WS_XB = 736 * MiB;
constexpr size_t WS_POOL = 864 * MiB;
constexpr size_t WS_QKA = 896 * MiB;
constexpr size_t WS_H8 = 960 * MiB;
constexpr size_t WS_W8 = 992 * MiB;
constexpr size_t WS_END = 1008 * MiB;
static_assert(WS_W1T + (size_t)DEPTH * NP * D * 2 <= WS_WBT && WS_SEG + 13 * SEG_BYTES <= WS_GATE && WS_GATE + 4 * (size_t)MH * D * 2 <= WS_POOL, "ws map");
constexpr size_t S5T_LAYER = 512 * 1024;
constexpr size_t S5T_A = 0, S5T_A64 = 16384, S5T_B = 32768, S5T_C = 32768 + 131072;
enum { SG_S5U = 0, SG_S5Z = 1, SG_PU = 2, SG_PZ = 3, SG_SCX = 4, SG_SCB = 5, SG_SCC = 6, SG_SCZ = 7, SG_QK = 8, SG_V = 10, SG_O = 11, SG_MZ = 12 };

constexpr int NWAVES = 8, NTHR = 512;
constexpr int LDS_BYTES = 147456;
constexpr int LDS_MISC = 143 * 1024;

__device__ __forceinline__ unsigned f2bf(float f) { unsigned u = __builtin_bit_cast(unsigned, f); return (u + 0x7fffu + ((u >> 16) & 1u)) >> 16; }
__device__ __forceinline__ float bflo(unsigned w) { return __builtin_bit_cast(float, w << 16); }
__device__ __forceinline__ float bfhi(unsigned w) { return __builtin_bit_cast(float, w & 0xffff0000u); }
typedef __bf16 bf16x2_t __attribute__((ext_vector_type(2)));
__device__ __forceinline__ unsigned cvt_pk_bf16(float lo, float hi) { const f32x2 v = {lo, hi}; const bf16x2_t r = __builtin_convertvector(v, bf16x2_t); return __builtin_bit_cast(unsigned, r); }
__device__ __forceinline__ float fsigmoid(float v) { return __builtin_amdgcn_rcpf(1.0f + __builtin_amdgcn_exp2f(-v * LOG2E)); }
__device__ __forceinline__ float fexp(float v) { return __builtin_amdgcn_exp2f(v * LOG2E); }
__device__ __forceinline__ int fresh_lane() { int l; asm volatile("v_mbcnt_lo_u32_b32 %0, -1, 0\n\tv_mbcnt_hi_u32_b32 %0, -1, %0" : "=v"(l)); return l; }
__device__ __forceinline__ float shfl_idx(float v, int src) { return __builtin_bit_cast(float, __builtin_amdgcn_ds_bpermute(src << 2, __builtin_bit_cast(int, v))); }
__device__ __forceinline__ float shfl_x(float v, int mask, int lane) { return shfl_idx(v, lane ^ mask); }
__device__ __forceinline__ float wave_sum(float v, int lane) {
#pragma unroll
    for (int o = 1; o < 64; o <<= 1) v += shfl_x(v, o, lane);
    return v;
}
template <int CTRL, int ROWMASK> __device__ __forceinline__ float upd_dpp(float old, float src) {
    return __builtin_bit_cast(float, __builtin_amdgcn_update_dpp(__builtin_bit_cast(int, old), __builtin_bit_cast(int, src), CTRL, ROWMASK, 0xf, false)); }
__device__ __forceinline__ float dpp_scan_add(float v) {
    v += upd_dpp<0x111, 0xf>(0.f, v); v += upd_dpp<0x112, 0xf>(0.f, v); v += upd_dpp<0x114, 0xf>(0.f, v); v += upd_dpp<0x118, 0xf>(0.f, v);
    v += upd_dpp<0x142, 0xa>(0.f, v); v += upd_dpp<0x143, 0xc>(0.f, v); return v; }
__device__ __forceinline__ float dpp_scan_max(float v) {
    const float ninf = -__builtin_inff();
    v = fmaxf(v, upd_dpp<0x111, 0xf>(ninf, v)); v = fmaxf(v, upd_dpp<0x112, 0xf>(ninf, v)); v = fmaxf(v, upd_dpp<0x114, 0xf>(ninf, v)); v = fmaxf(v, upd_dpp<0x118, 0xf>(ninf, v));
    v = fmaxf(v, upd_dpp<0x142, 0xa>(ninf, v)); v = fmaxf(v, upd_dpp<0x143, 0xc>(ninf, v)); return v; }
__device__ __forceinline__ float read_lane63(float v) { return __builtin_bit_cast(float, __builtin_amdgcn_readlane(__builtin_bit_cast(int, v), 63)); }
__device__ __forceinline__ float dpp_wave_sum(float v) { return read_lane63(dpp_scan_add(v)); }
#define LDS_WAIT() asm volatile("s_waitcnt lgkmcnt(0)" ::: "memory")
#define VM_WAIT() asm volatile("s_waitcnt vmcnt(0)" ::: "memory")
#define WAVE_SYNC() do { asm volatile("s_waitcnt lgkmcnt(0)" ::: "memory"); __builtin_amdgcn_wave_barrier(); } while (0)

#define XB_TMO      128
#define XB_XCNT(j)  (256  + 64 * (j))
#define XB_XSUB(j)  (1280 + 64 * (j))
#define XB_XGEN(j)  (2304 + 64 * (j))
#define XB_TOP      3328
#define XB_TOPGEN   3392
#define XCD_BAR_WORDS 3456
#define XB_SPIN_CAP (1u << 18)
__device__ __forceinline__ unsigned xb_ld(unsigned* p)              { return __hip_atomic_load(p, __ATOMIC_RELAXED, __HIP_MEMORY_SCOPE_AGENT); }
__device__ __forceinline__ unsigned xb_add(unsigned* p, unsigned v) { return __hip_atomic_fetch_add(p, v, __ATOMIC_RELAXED, __HIP_MEMORY_SCOPE_AGENT); }
__device__ __forceinline__ unsigned xb_xcc_id() { return (unsigned)__builtin_amdgcn_s_getreg((3 << 11) | 20) & 0xFu; }
#define XB_SPIN(cond, bar) do { unsigned _sp = 0; while (cond) { __builtin_amdgcn_s_sleep(1); \
    if ((++_sp & 255u) == 0u) { if (xb_ld(&(bar)[XB_TMO])) break; if (_sp > XB_SPIN_CAP) { atomicAdd(&(bar)[XB_TMO], 1u); break; } } } } while (0)
struct XcdBarrier { unsigned* bar; unsigned x; volatile LAS unsigned* st; };
__device__ __forceinline__ XcdBarrier xcd_barrier_post(unsigned* bar, volatile LAS unsigned* st) {
    XcdBarrier b; b.bar = bar; b.x = xb_xcc_id(); b.st = st;
    if (threadIdx.x == 0) (void)xb_add(&bar[XB_XCNT(b.x)], 1u);
    return b;
}
__device__ __forceinline__ void xcd_barrier_complete(unsigned* bar, unsigned x, unsigned& nloc, unsigned& nx) {
    const unsigned G = gridDim.x * gridDim.y * gridDim.z;
    unsigned sum, cnt, mine, sp = 0u;
    for (;;) {
        sum = 0u; cnt = 0u; mine = 0u;
#pragma unroll
        for (unsigned j = 0; j < 16; ++j) { const unsigned c = xb_ld(&bar[XB_XCNT(j)]); sum += c; cnt += (c > 0u) ? 1u : 0u; mine = (j == x) ? c : mine; }
        if (sum == G) break;
        __builtin_amdgcn_s_sleep(1);
        if ((++sp & 255u) == 0u) { if (xb_ld(&bar[XB_TMO])) break; if (sp > XB_SPIN_CAP) { atomicAdd(&bar[XB_TMO], 1u); break; } }
    }
    nloc = mine > 0u ? mine : 1u; nx = cnt > 0u ? cnt : 1u;
}
__device__ __forceinline__ void xcd_barrier(const XcdBarrier& b) {
    asm volatile("s_waitcnt vmcnt(0)" ::: "memory");
    __syncthreads();
    if (threadIdx.x == 0) {
        unsigned* bar = b.bar;
        __builtin_amdgcn_s_waitcnt(0);
        unsigned nloc = b.st[0], nx = b.st[1];
        if (nloc == 0u) { xcd_barrier_complete(bar, b.x, nloc, nx); b.st[0] = nloc; b.st[1] = nx; }
        const unsigned old = xb_add(&bar[XB_XSUB(b.x)], 1u);
        const unsigned gen = old / nloc;
        if (old + 1u == (gen + 1u) * nloc) {
            __builtin_amdgcn_fence(__ATOMIC_RELEASE, "agent");
            asm volatile("s_waitcnt vmcnt(0)" ::: "memory");
            const unsigned og = xb_add(&bar[XB_TOP], 1u);
            const unsigned tg = og / nx;
            if (og + 1u == (tg + 1u) * nx) xb_add(&bar[XB_TOPGEN], 1u);
            else XB_SPIN(xb_ld(&bar[XB_TOPGEN]) == tg, bar);
            __builtin_amdgcn_fence(__ATOMIC_ACQUIRE, "agent");
            xb_add(&bar[XB_XGEN(b.x)], 1u);
            asm volatile("s_waitcnt vmcnt(0)" ::: "memory");
        } else {
            XB_SPIN(xb_ld(&bar[XB_XGEN(b.x)]) == gen, bar);
            __builtin_amdgcn_fence(__ATOMIC_ACQUIRE, "agent");
            asm volatile("s_waitcnt vmcnt(0)" ::: "memory");
        }
    }
    __syncthreads();
}

#define GB_WORD(j) (XCD_BAR_WORDS + 64 + 64 * (j))
__device__ __forceinline__ XcdBarrier xcd_barrier_post_ranked(unsigned* bar, volatile LAS unsigned* st) {
    XcdBarrier b; b.bar = bar; b.x = xb_xcc_id(); b.st = st;
    if (threadIdx.x == 0) st[3] = xb_add(&bar[XB_XCNT(b.x)], 1u);
    return b;
}
__device__ __forceinline__ void grp_barrier(const XcdBarrier& b) {
    asm volatile("s_waitcnt vmcnt(0)" ::: "memory");
    __syncthreads();
    if (threadIdx.x == 0) {
        unsigned* gb = &b.bar[GB_WORD(b.x)];
        const unsigned nloc = b.st[0];
        const unsigned old = xb_add(gb, 1u);
        const unsigned target = (old / nloc + 1u) * nloc;
        if (old + 1u < target) XB_SPIN(xb_ld(gb) < target, b.bar);
        asm volatile("buffer_inv sc0\n\ts_waitcnt vmcnt(0)" ::: "memory");
    }
    __syncthreads();
}

namespace pg8 {
constexpr int BM = 256, BK = 64, HALF = 128, HTB = HALF * BK * 2, STAGE_BYTES = 8 * HTB, NXCD = 8, WGM = 8;
__host__ __device__ __forceinline__ int lds_byte(int r, int c) { const int st = (r >> 4) * 2 + (c >> 5), rr = r & 15, cc = c & 31, ob = rr * 64 + cc * 2; return st * 1024 + (ob ^ (((ob >> 9) & 1) << 5)); }
__host__ __device__ __forceinline__ void stage_rc(int b, int& R, int& C) { const int st = b / 1024, sb = b % 1024, swz = sb ^ (((sb >> 9) & 1) << 5); R = (st >> 1) * 16 + swz / 64; C = (st & 1) * 32 + (swz % 64) / 2; }
__host__ __device__ __forceinline__ int perm32(int rho) { const int n = rho >> 4, i = rho & 15; return 8 * (i >> 2) + 4 * n + (i & 3); }
struct Unit { int pm, pn, z; };
struct StaticOrder {
    int nM, nN, nwg, G, c;
    __device__ void init(int M, int N, int G_, int c_) { nM = M / BM; nN = N / BM; nwg = nM * nN; G = G_; c = c_; }
    __device__ bool next(int i, Unit& u) const {
        const long L = (long)i * G + c; if (L >= nwg) return false;
        int wgid = (int)L; { const int q = nwg / NXCD, r = nwg % NXCD, xcd = wgid % NXCD, off = wgid / NXCD; wgid = (xcd < r ? xcd * (q + 1) : r * (q + 1) + (xcd - r) * q) + off; }
        const int nig = WGM * nN, gid = wgid / nig, fm = gid * WGM, gsz = (nM - fm) < WGM ? (nM - fm) : WGM;
        u.pm = fm + ((wgid % nig) % gsz); u.pn = (wgid % nig) / gsz; return true;
    }
};
template <class Epi, int GN, int GK, int LDA, int LDB, bool KD = false>
__device__ __forceinline__ void gemm_phase(LAS unsigned char* lds, const bf16* gA, const bf16* gBt, const int G, const int cid, const int tid, const Epi& E, const int Mrows = MH) {
    const int wid = __builtin_amdgcn_readfirstlane(tid >> 6), lane = tid & 63, wr = wid >> 2, wc = wid & 3, fr = lane & 15, fq = lane >> 4;
    constexpr int nt = GK / BK;
    StaticOrder S; S.init(Mrows, GN, G, cid);
    unsigned voffA, voffB;
    { int R, C; stage_rc(tid * 16, R, C); const int Rb = (R & ~31) + perm32(R & 31); voffA = (unsigned)(R * LDA + C) * 2u; voffB = (unsigned)(Rb * LDB + C) * 2u; }
    constexpr size_t voffA_R64 = (size_t)64 * LDA * 2, voffB_R64 = (size_t)64 * LDB * 2;
    constexpr size_t kstep = (size_t)(BK * 2);
    constexpr size_t hstepA = (size_t)HALF * LDA * 2, hstepB = (size_t)HALF * LDB * 2;
    constexpr size_t tstepA = 2 * hstepA, tstepB = 2 * hstepB;
    const unsigned ldsw = (unsigned)wid * 1024u;
    const int aoff = lds_byte(wr * 64 + fr, fq * 8), boff = lds_byte(wc * 32 + fr, fq * 8);
    const unsigned ldsd = (unsigned)(__SIZE_TYPE__)lds + ldsw;
#define PG8_SA(b, h) (((b) * 2 + (h)) * HTB)
#define PG8_SB(b, h) ((4 + (b) * 2 + (h)) * HTB)
#define PG8_STAGE(bufoff, gbase, voff) do { _Pragma("unroll") for (int _i = 0; _i < 2; ++_i) \
        asm volatile("s_mov_b32 m0, %0\n\ts_nop 0\n\tglobal_load_lds_dwordx4 %1, %2" :: "s"(ldsd + (unsigned)((bufoff) + _i * 8192)), "v"(voff), "s"((const char*)(gbase) + (size_t)_i * (voff##_R64)) : "m0", "memory"); } while (0)
#define PG8_LDA(dst, b, h) do { _Pragma("unroll") for (int m = 0; m < 4; ++m) _Pragma("unroll") for (int k = 0; k < 2; ++k) dst[m][k] = *(const LAS bf16x8*)(lds + PG8_SA(b, h) + aoff + m * 2048 + k * 1024); } while (0)
#define PG8_LDB(dst, b, h) do { _Pragma("unroll") for (int n = 0; n < 2; ++n) _Pragma("unroll") for (int k = 0; k < 2; ++k) dst[n][k] = *(const LAS bf16x8*)(lds + PG8_SB(b, h) + boff + n * 2048 + k * 1024); } while (0)
#define PG8_MMA(ai, bj, At, Bt) do { __builtin_amdgcn_s_setprio(1); _Pragma("unroll") for (int m = 0; m < 4; ++m) _Pragma("unroll") for (int n = 0; n < 2; ++n) _Pragma("unroll") for (int k = 0; k < 2; ++k) \
        acc[ai][bj][m][n] = __builtin_amdgcn_mfma_f32_16x16x32_bf16(Bt[n][k], At[m][k], acc[ai][bj][m][n], 0, 0, 0); __builtin_amdgcn_s_setprio(0); } while (0)
#define PG8_WAIT_V(n) asm volatile("s_waitcnt vmcnt(" #n ")" ::: "memory")
#define PG8_WAIT_L(n) asm volatile("s_waitcnt lgkmcnt(" #n ")" ::: "memory")
#define PG8_BAR __builtin_amdgcn_s_barrier()
#define PG8_SCHED __builtin_amdgcn_sched_barrier(0)
    Unit cur, nxt; int ui = 0;
    if (!S.next(0, cur)) return;
    f32x4 acc[2][2][4][2];
#pragma unroll
    for (int a = 0; a < 2; ++a)
#pragma unroll
        for (int b = 0; b < 2; ++b)
#pragma unroll
            for (int m = 0; m < 4; ++m)
#pragma unroll
                for (int n = 0; n < 2; ++n) acc[a][b][m][n] = (f32x4){0.f, 0.f, 0.f, 0.f};
    bf16x8 At[4][2], B0[2][2], B1[2][2];
    const char* cA = (const char*)gA + (size_t)cur.pm * tstepA + (KD ? (size_t)cur.pn * GK * 2 : 0); const char* cB = (const char*)gBt + (size_t)cur.pn * tstepB + (KD ? (size_t)cur.pn * GK * 2 : 0);
    PG8_STAGE(PG8_SB(0, 0), cB, voffB); PG8_STAGE(PG8_SB(0, 1), cB + hstepB, voffB); PG8_STAGE(PG8_SA(0, 0), cA, voffA); PG8_STAGE(PG8_SA(0, 1), cA + hstepA, voffA);
    if (wr == 1) PG8_BAR;
    PG8_WAIT_V(2); PG8_BAR;
    PG8_STAGE(PG8_SB(1, 0), cB + kstep, voffB); PG8_STAGE(PG8_SA(1, 0), cA + kstep, voffA); PG8_STAGE(PG8_SB(1, 1), cB + hstepB + kstep, voffB);
    PG8_WAIT_V(6); PG8_BAR;
    for (;;) {
        const bool has_next = S.next(ui + 1, nxt);
        const char* nA = has_next ? (const char*)gA + (size_t)nxt.pm * tstepA + (KD ? (size_t)nxt.pn * GK * 2 : 0) : cA; const char* nB = has_next ? (const char*)gBt + (size_t)nxt.pn * tstepB + (KD ? (size_t)nxt.pn * GK * 2 : 0) : cB;
#pragma unroll 1
        for (int t = 0; t < nt; t += 2) {
            const bool last = (t == nt - 2);
            const char* a1 = cA + (size_t)(t + 1) * kstep;
            const char* a2 = last ? nA : cA + (size_t)(t + 2) * kstep; const char* b2 = last ? nB : cB + (size_t)(t + 2) * kstep;
            const char* a3 = a2 + kstep; const char* b3 = b2 + kstep;
            PG8_LDB(B0, 0, 0); PG8_LDB(B1, 0, 1); PG8_SCHED; PG8_LDA(At, 0, 0); PG8_STAGE(PG8_SA(1, 1), a1 + hstepA, voffA);
            PG8_WAIT_V(8); PG8_WAIT_L(0); PG8_BAR; PG8_MMA(0, 0, At, B0); PG8_MMA(0, 1, At, B1); PG8_BAR; PG8_SCHED;
            PG8_LDA(At, 0, 1); PG8_STAGE(PG8_SB(0, 0), b2, voffB); PG8_STAGE(PG8_SB(0, 1), b2 + hstepB, voffB); PG8_STAGE(PG8_SA(0, 0), a2, voffA);
            PG8_WAIT_V(8); PG8_WAIT_L(0); PG8_BAR; PG8_MMA(1, 0, At, B0); PG8_MMA(1, 1, At, B1); PG8_BAR; PG8_SCHED;
            PG8_LDB(B0, 1, 0); PG8_LDB(B1, 1, 1); PG8_SCHED; PG8_LDA(At, 1, 0); PG8_STAGE(PG8_SA(0, 1), a2 + hstepA, voffA);
            PG8_WAIT_V(8); PG8_WAIT_L(0); PG8_BAR; PG8_MMA(0, 0, At, B0); PG8_MMA(0, 1, At, B1); PG8_BAR; PG8_SCHED;
            PG8_LDA(At, 1, 1); PG8_STAGE(PG8_SB(1, 0), b3, voffB); PG8_STAGE(PG8_SB(1, 1), b3 + hstepB, voffB); PG8_STAGE(PG8_SA(1, 0), a3, voffA);
            PG8_WAIT_V(8); PG8_WAIT_L(0); PG8_BAR; PG8_MMA(1, 0, At, B0); PG8_MMA(1, 1, At, B1); PG8_BAR; PG8_SCHED;
        }
        if (wr == 0) PG8_BAR;
        E(acc, cur, wr, wc);
        if (!has_next) break;
#pragma unroll
        for (int a = 0; a < 2; ++a)
#pragma unroll
            for (int b = 0; b < 2; ++b)
#pragma unroll
                for (int m = 0; m < 4; ++m)
#pragma unroll
                    for (int n = 0; n < 2; ++n) acc[a][b][m][n] = (f32x4){0.f, 0.f, 0.f, 0.f};
        cur = nxt; cA = nA; cB = nB; ++ui;
        if (wr == 1) PG8_BAR;
    }
    PG8_WAIT_V(0);
    PG8_BAR;
#undef PG8_SA
#undef PG8_SB
#undef PG8_STAGE
#undef PG8_LDA
#undef PG8_LDB
#undef PG8_MMA
#undef PG8_WAIT_V
#undef PG8_WAIT_L
#undef PG8_BAR
#undef PG8_SCHED
}
__device__ __forceinline__ f32x4 zero4v() { f32x4 z; asm volatile("v_mov_b32 %0, 0\n\tv_mov_b32 %1, 0\n\tv_mov_b32 %2, 0\n\tv_mov_b32 %3, 0" : "=v"(z[0]), "=v"(z[1]), "=v"(z[2]), "=v"(z[3])); return z; }
__device__ __forceinline__ i32x8 ld32(const LAS unsigned char* p) { const u32x4 x = *(const LAS u32x4*)p, y = *(const LAS u32x4*)(p + 1024); return (i32x8){(int)x.x, (int)x.y, (int)x.z, (int)x.w, (int)y.x, (int)y.y, (int)y.z, (int)y.w}; }
template <class Epi, int GN, int GKB>
__device__ __forceinline__ void gemm_phase8(LAS unsigned char* lds, const unsigned char* gA, const unsigned char* gBt, const int G, const int cid, const int tid, const Epi& E) {
    const int wid = __builtin_amdgcn_readfirstlane(tid >> 6), lane = tid & 63, wr = wid >> 2, wc = wid & 3, fr = lane & 15, fq = lane >> 4;
    constexpr int nt = GKB / 128;
    StaticOrder S; S.init(MH, GN, G, cid);
    unsigned voffA, voffB;
    { int R, C; stage_rc(tid * 16, R, C); const int Rb = (R & ~31) + perm32(R & 31); voffA = (unsigned)(R * GKB + C * 2); voffB = (unsigned)(Rb * GKB + C * 2); }
    constexpr size_t voffA_R64 = (size_t)64 * GKB, voffB_R64 = (size_t)64 * GKB;
    constexpr size_t kstep = (size_t)(BK * 2);
    constexpr size_t hstepA = (size_t)HALF * GKB, hstepB = (size_t)HALF * GKB;
    constexpr size_t tstepA = 2 * hstepA, tstepB = 2 * hstepB;
    const unsigned ldsw = (unsigned)wid * 1024u;
    const int aoff = lds_byte(wr * 64 + fr, fq * 8), boff = lds_byte(wc * 32 + fr, fq * 8);
#define PG8_SA(b, h) (((b) * 2 + (h)) * HTB)
#define PG8_SB(b, h) ((4 + (b) * 2 + (h)) * HTB)
    const unsigned ldsd = (unsigned)(__SIZE_TYPE__)lds + ldsw;
#define PG8_STAGE(bufoff, gbase, voff) do { _Pragma("unroll") for (int _i = 0; _i < 2; ++_i) \
        asm volatile("s_mov_b32 m0, %0\n\ts_nop 0\n\tglobal_load_lds_dwordx4 %1, %2" :: "s"(ldsd + (unsigned)((bufoff) + _i * 8192)), "v"(voff), "s"((const char*)(gbase) + (size_t)_i * (voff##_R64)) : "m0", "memory"); } while (0)
#define PG8_LD32(p_) ld32(p_)
#define PG8_LDA(dst, b, h) do { _Pragma("unroll") for (int m = 0; m < 4; ++m) dst[m] = PG8_LD32(lds + PG8_SA(b, h) + aoff + m * 2048); } while (0)
#define PG8_LDB(dst, b, h) do { _Pragma("unroll") for (int n = 0; n < 2; ++n) dst[n] = PG8_LD32(lds + PG8_SB(b, h) + boff + n * 2048); } while (0)
#define PG8_MMA(ai, bj, At, Bt) do { __builtin_amdgcn_s_setprio(1); _Pragma("unroll") for (int m = 0; m < 4; ++m) _Pragma("unroll") for (int n = 0; n < 2; ++n) \
        acc[ai][bj][m][n] = __builtin_amdgcn_mfma_scale_f32_16x16x128_f8f6f4(Bt[n], At[m], acc[ai][bj][m][n], 0, 0, 0, 127, 0, 127); __builtin_amdgcn_s_setprio(0); } while (0)
#define PG8_WAIT_V(n) asm volatile("s_waitcnt vmcnt(" #n ")" ::: "memory")
#define PG8_WAIT_L(n) asm volatile("s_waitcnt lgkmcnt(" #n ")" ::: "memory")
#define PG8_BAR __builtin_amdgcn_s_barrier()
#define PG8_SCHED __builtin_amdgcn_sched_barrier(0)
    Unit cur, nxt; int ui = 0;
    if (!S.next(0, cur)) return;
    f32x4 acc[2][2][4][2];
#pragma unroll
    for (int a = 0; a < 2; ++a)
#pragma unroll
        for (int b = 0; b < 2; ++b)
#pragma unroll
            for (int m = 0; m < 4; ++m)
#pragma unroll
                for (int n = 0; n < 2; ++n) acc[a][b][m][n] = zero4v();
    i32x8 At[4], B0[2], B1[2];
    const char* cA = (const char*)gA + (size_t)cur.pm * tstepA; const char* cB = (const char*)gBt + (size_t)cur.pn * tstepB;
    PG8_STAGE(PG8_SB(0, 0), cB, voffB); PG8_STAGE(PG8_SB(0, 1), cB + hstepB, voffB); PG8_STAGE(PG8_SA(0, 0), cA, voffA); PG8_STAGE(PG8_SA(0, 1), cA + hstepA, voffA);
    if (wr == 1) PG8_BAR;
    PG8_WAIT_V(2); PG8_BAR;
    PG8_STAGE(PG8_SB(1, 0), cB + kstep, voffB); PG8_STAGE(PG8_SA(1, 0), cA + kstep, voffA); PG8_STAGE(PG8_SB(1, 1), cB + hstepB + kstep, voffB);
    PG8_WAIT_V(6); PG8_BAR;
    for (;;) {
        const bool has_next = S.next(ui + 1, nxt);
        const char* nA = has_next ? (const char*)gA + (size_t)nxt.pm * tstepA : cA; const char* nB = has_next ? (const char*)gBt + (size_t)nxt.pn * tstepB : cB;
#pragma unroll 1
        for (int t = 0; t < nt; t += 2) {
            const bool last = (t == nt - 2);
            const char* a1 = cA + (size_t)(t + 1) * kstep;
            const char* a2 = last ? nA : cA + (size_t)(t + 2) * kstep; const char* b2 = last ? nB : cB + (size_t)(t + 2) * kstep;
            const char* a3 = a2 + kstep; const char* b3 = b2 + kstep;
            PG8_LDB(B0, 0, 0); PG8_LDB(B1, 0, 1); PG8_SCHED; PG8_LDA(At, 0, 0); PG8_STAGE(PG8_SA(1, 1), a1 + hstepA, voffA);
            PG8_WAIT_V(8); PG8_WAIT_L(0); PG8_BAR; PG8_MMA(0, 0, At, B0); PG8_MMA(0, 1, At, B1); PG8_BAR; PG8_SCHED;
            PG8_LDA(At, 0, 1); PG8_STAGE(PG8_SB(0, 0), b2, voffB); PG8_STAGE(PG8_SB(0, 1), b2 + hstepB, voffB); PG8_STAGE(PG8_SA(0, 0), a2, voffA);
            PG8_WAIT_V(8); PG8_WAIT_L(0); PG8_BAR; PG8_MMA(1, 0, At, B0); PG8_MMA(1, 1, At, B1); PG8_BAR; PG8_SCHED;
            PG8_LDB(B0, 1, 0); PG8_LDB(B1, 1, 1); PG8_SCHED; PG8_LDA(At, 1, 0); PG8_STAGE(PG8_SA(0, 1), a2 + hstepA, voffA);
            PG8_WAIT_V(8); PG8_WAIT_L(0); PG8_BAR; PG8_MMA(0, 0, At, B0); PG8_MMA(0, 1, At, B1); PG8_BAR; PG8_SCHED;
            PG8_LDA(At, 1, 1); PG8_STAGE(PG8_SB(1, 0), b3, voffB); PG8_STAGE(PG8_SB(1, 1), b3 + hstepB, voffB); PG8_STAGE(PG8_SA(1, 0), a3, voffA);
            PG8_WAIT_V(8); PG8_WAIT_L(0); PG8_BAR; PG8_MMA(1, 0, At, B0); PG8_MMA(1, 1, At, B1); PG8_BAR; PG8_SCHED;
        }
        if (wr == 0) PG8_BAR;
        E(acc, cur, wr, wc);
        if (!has_next) break;
#pragma unroll
        for (int a = 0; a < 2; ++a)
#pragma unroll
            for (int b = 0; b < 2; ++b)
#pragma unroll
                for (int m = 0; m < 4; ++m)
#pragma unroll
                    for (int n = 0; n < 2; ++n) acc[a][b][m][n] = zero4v();
        cur = nxt; cA = nA; cB = nB; ++ui;
        if (wr == 1) PG8_BAR;
    }
    PG8_WAIT_V(0);
    PG8_BAR;
#undef PG8_LD32
#undef PG8_SA
#undef PG8_SB
#undef PG8_STAGE
#undef PG8_LDA
#undef PG8_LDB
#undef PG8_MMA
#undef PG8_WAIT_V
#undef PG8_WAIT_L
#undef PG8_BAR
#undef PG8_SCHED
}
}

__device__ __forceinline__ void unpack8(const u32x4 w, float (&f)[8]) {
    f[0] = bflo(w.x); f[1] = bfhi(w.x); f[2] = bflo(w.y); f[3] = bfhi(w.y); f[4] = bflo(w.z); f[5] = bfhi(w.z); f[6] = bflo(w.w); f[7] = bfhi(w.w);
}
__device__ __forceinline__ u32x4 pack8(const float (&f)[8]) {
    u32x4 w; w.x = cvt_pk_bf16(f[0], f[1]); w.y = cvt_pk_bf16(f[2], f[3]); w.z = cvt_pk_bf16(f[4], f[5]); w.w = cvt_pk_bf16(f[6], f[7]); return w;
}
__device__ __forceinline__ void acc8(const f32x4 a, const f32x4 b, float (&f)[8]) { f[0] = a[0]; f[1] = a[1]; f[2] = a[2]; f[3] = a[3]; f[4] = b[0]; f[5] = b[1]; f[6] = b[2]; f[7] = b[3]; }

#define EPI_ROWS(LD_) _Pragma("unroll") for (int ai = 0; ai < 2; ++ai) _Pragma("unroll") for (int m = 0; m < 4; ++m) _Pragma("unroll") for (int bj = 0; bj < 2; ++bj)
#define EPI_OFF(LD_) (((unsigned)(row0 + ai * 128 + m * 16) * (unsigned)(LD_) + (unsigned)(col0 + bj * 128)) * 2u)
struct EpiProj {
    bf16* seg; bf16* gate;
    template <int ACT, int LD> __device__ __forceinline__ void body(const f32x4 (&acc)[2][2][4][2], unsigned char* base, int row0, int col0) const {
        EPI_ROWS(LD) { float v[8]; acc8(acc[ai][bj][m][0], acc[ai][bj][m][1], v);
            if (ACT == 1) {
#pragma unroll
                for (int e = 0; e < 8; ++e) v[e] = v[e] * fsigmoid(v[e]); }
            if (ACT == 2) {
#pragma unroll
                for (int e = 0; e < 8; ++e) v[e] = fsigmoid(v[e]); }
            __builtin_nontemporal_store(pack8(v), (u32x4*)(base + EPI_OFF(LD))); __builtin_amdgcn_sched_barrier(0); }
    }
    template <int SILU> static __device__ __forceinline__ u32x2 pr4(const f32x4 p, f32x4 q) {
        if (SILU) {
#pragma unroll
            for (int e = 0; e < 4; ++e) q[e] = q[e] * fsigmoid(q[e]); }
        const f32x4 r = p * q; u32x2 w; w.x = cvt_pk_bf16(r[0], r[1]); w.y = cvt_pk_bf16(r[2], r[3]); return w; }
    template <int SILU> __device__ __forceinline__ void pair(const f32x4 (&acc)[2][2][4][2], unsigned char* base, int row0, int col0h) const {
#pragma unroll
        for (int ai = 0; ai < 2; ++ai)
#pragma unroll
            for (int j = 0; j < 2; ++j)
#pragma unroll
                for (int bj = 0; bj < 2; ++bj) {
                    const u32x2 c0 = pr4<SILU>(acc[ai][bj][2 * j][0], acc[ai][bj][2 * j][1]), c1 = pr4<SILU>(acc[ai][bj][2 * j + 1][0], acc[ai][bj][2 * j + 1][1]);
                    const auto sx = __builtin_amdgcn_permlane16_swap(c0.x, c1.x, false, false); const auto sy = __builtin_amdgcn_permlane16_swap(c0.y, c1.y, false, false);
                    const u32x4 w = {sx[0], sy[0], sx[1], sy[1]};
                    __builtin_nontemporal_store(w, (u32x4*)(base + ((unsigned)(row0 + ai * 128 + j * 32) * (unsigned)BW + (unsigned)(col0h + bj * 64)) * 2u)); __builtin_amdgcn_sched_barrier(0); }
    }
    __device__ __forceinline__ void operator()(const f32x4 (&acc)[2][2][4][2], const pg8::Unit& u, int wr, int wc) const {
        const int lane_ = fresh_lane(), fr = lane_ & 15, fq = lane_ >> 4;
        const int pn = u.pn; const int row0 = u.pm * 256 + wr * 64 + fr;
        if (pn >= 8 && pn < 16) { const int par = fq & 1, col0h = (pn & 3) * 128 + wc * 16 + 4 * (fq - par), row0p = row0 + par * 16;
            if (pn < 12) pair<0>(acc, (unsigned char*)(seg + (size_t)SG_SCX * MH * BW), row0p, col0h); else pair<1>(acc, (unsigned char*)(seg + (size_t)SG_SCB * MH * BW), row0p, col0h); }
        else if (pn < 26) { const int sg = pn >> 1; unsigned char* base = (unsigned char*)(seg + (size_t)sg * MH * BW); const int col0 = (pn & 1) * 256 + wc * 32 + 8 * fq;
            const int act = (sg == SG_S5Z || sg == SG_PZ || sg == SG_SCZ || sg == SG_MZ) ? 1 : (sg == SG_O ? 2 : 0);
            if (act == 0) body<0, BW>(acc, base, row0, col0); else if (act == 1) body<1, BW>(acc, base, row0, col0); else body<2, BW>(acc, base, row0, col0); }
        else { const int gg = pn - 26; unsigned char* base = (unsigned char*)(gate + (size_t)(gg >> 2) * MH * D); const int col0 = (gg & 3) * 256 + wc * 32 + 8 * fq;
            body<2, D>(acc, base, row0, col0); }
    }
};
__device__ __forceinline__ u32x2 pack8_u8(const float (&f)[8]) { unsigned a = 0u, b = 0u;
    a = __builtin_amdgcn_cvt_pk_u8_f32(f[0], 0, a); a = __builtin_amdgcn_cvt_pk_u8_f32(f[1], 1, a); a = __builtin_amdgcn_cvt_pk_u8_f32(f[2], 2, a); a = __builtin_amdgcn_cvt_pk_u8_f32(f[3], 3, a);
    b = __builtin_amdgcn_cvt_pk_u8_f32(f[4], 0, b); b = __builtin_amdgcn_cvt_pk_u8_f32(f[5], 1, b); b = __builtin_amdgcn_cvt_pk_u8_f32(f[6], 2, b); b = __builtin_amdgcn_cvt_pk_u8_f32(f[7], 3, b); return (u32x2){a, b}; }
__device__ __forceinline__ void unpack8_u8(const u32x2 w, float (&f)[8]) {
    f[0] = (float)(w.x & 0xffu); f[1] = (float)((w.x >> 8) & 0xffu); f[2] = (float)((w.x >> 16) & 0xffu); f[3] = (float)(w.x >> 24);
    f[4] = (float)(w.y & 0xffu); f[5] = (float)((w.y >> 8) & 0xffu); f[6] = (float)((w.y >> 16) & 0xffu); f[7] = (float)(w.y >> 24); }
#define EPI_OFFB(LD_) ((unsigned)(row0 + ai * 128 + m * 16) * (unsigned)(LD_) + (unsigned)(col0 + bj * 128))
struct EpiGate8 {
    unsigned char* gate;
    static __device__ __forceinline__ u32x2 g8(const f32x4 p, const f32x4 q) { float v[8]; acc8(p, q, v);
#pragma unroll
        for (int e = 0; e < 8; ++e) v[e] = __builtin_amdgcn_rcpf((1.0f / 255.f) + __builtin_amdgcn_exp2f(__builtin_fmaf(v[e], -LOG2E / W8_SCALE, -7.99435343685885794f)));
        return pack8_u8(v); }
    __device__ __forceinline__ void operator()(const f32x4 (&acc)[2][2][4][2], const pg8::Unit& u, int wr, int wc) const {
        const int lane_ = fresh_lane(), fr = lane_ & 15, fq = lane_ >> 4, par = fq & 1;
        const int row0 = u.pm * 256 + wr * 64 + fr + par * 16, col0 = (u.pn & 3) * 256 + wc * 32 + 8 * (fq - par);
        unsigned char* base = gate + (size_t)(u.pn >> 2) * MH * D;
#pragma unroll
        for (int ai = 0; ai < 2; ++ai)
#pragma unroll
            for (int j = 0; j < 2; ++j)
#pragma unroll
                for (int bj = 0; bj < 2; ++bj) {
                    const u32x2 c0 = g8(acc[ai][bj][2 * j][0], acc[ai][bj][2 * j][1]), c1 = g8(acc[ai][bj][2 * j + 1][0], acc[ai][bj][2 * j + 1][1]);
                    const auto sx = __builtin_amdgcn_permlane16_swap(c0.x, c1.x, false, false); const auto sy = __builtin_amdgcn_permlane16_swap(c0.y, c1.y, false, false);
                    const u32x4 w = {sx[0], sy[0], sx[1], sy[1]};
                    __builtin_nontemporal_store(w, (u32x4*)(base + (unsigned)(row0 + ai * 128 + j * 32) * (unsigned)D + (unsigned)(col0 + bj * 128))); __builtin_amdgcn_sched_barrier(0); }
    }
};
#define EPI_HALF_ROWS _Pragma("unroll") for (int m = 0; m < 4; ++m) _Pragma("unroll") for (int bj = 0; bj < 2; ++bj)
#define EPI_QUART_ROWS _Pragma("unroll") for (int m = 2 * mh; m < 2 * mh + 2; ++m) _Pragma("unroll") for (int bj = 0; bj < 2; ++bj)
struct EpiGlu {
    const bf16* ya; bf16* io;
    __device__ __forceinline__ void operator()(const f32x4 (&acc)[2][2][4][2], const pg8::Unit& u, int wr, int wc) const {
        const int lane_ = fresh_lane(), fr = lane_ & 15, fq = lane_ >> 4;
        const int row0 = u.pm * 256 + wr * 64 + fr, col0 = u.pn * 256 + wc * 32 + 8 * fq;
        const unsigned char* yb = (const unsigned char*)ya; unsigned char* ib = (unsigned char*)io;
        u32x4 yq[2][2][2], zq[2][2][2];
#define GLU_LOAD(B_, q_) do { const int ai = (q_) >> 1, mh = (q_) & 1; _Pragma("unroll") for (int mm = 0; mm < 2; ++mm) _Pragma("unroll") for (int bj = 0; bj < 2; ++bj) { const int m = 2 * mh + mm; const unsigned off = EPI_OFF(BW); \
            yq[B_][mm][bj] = *(const u32x4*)(yb + off); zq[B_][mm][bj] = *(const u32x4*)(ib + off); } } while (0)
#define GLU_DO(B_, q_) do { const int ai = (q_) >> 1, mh = (q_) & 1; _Pragma("unroll") for (int mm = 0; mm < 2; ++mm) _Pragma("unroll") for (int bj = 0; bj < 2; ++bj) { const int m = 2 * mh + mm; const unsigned off = EPI_OFF(BW); \
            float v[8], y[8], z[8]; acc8(acc[ai][bj][m][0], acc[ai][bj][m][1], v); unpack8(yq[B_][mm][bj], y); unpack8(zq[B_][mm][bj], z); \
            _Pragma("unroll") for (int e = 0; e < 8; ++e) v[e] = y[e] * fsigmoid(v[e]) * z[e]; \
            *(u32x4*)(ib + off) = pack8(v); } } while (0)
        GLU_LOAD(0, 0);
        GLU_LOAD(1, 1); GLU_DO(0, 0);
        GLU_LOAD(0, 2); GLU_DO(1, 1);
        GLU_LOAD(1, 3); GLU_DO(0, 2);
        GLU_DO(1, 3);
#undef GLU_LOAD
#undef GLU_DO
    }
};
struct EpiPool {
    const float* scale; bf16* io;
    __device__ __forceinline__ void operator()(const f32x4 (&acc)[2][2][4][2], const pg8::Unit& u, int wr, int wc) const {
        const int lane_ = fresh_lane(), fr = lane_ & 15, fq = lane_ >> 4;
        const int row0 = u.pm * 256 + wr * 64 + fr, col0 = u.pn * 256 + wc * 32 + 8 * fq;
        unsigned char* ib = (unsigned char*)io;
        float sc[2][8];
#pragma unroll
        for (int bj = 0; bj < 2; ++bj) { const f32x4 s0 = *(const f32x4*)(scale + col0 + bj * 128), s1 = *(const f32x4*)(scale + col0 + bj * 128 + 4); acc8(s0, s1, sc[bj]); }
#pragma unroll
        for (int ai = 0; ai < 2; ++ai) {
            u32x4 zq[4][2];
            EPI_HALF_ROWS { zq[m][bj] = *(const u32x4*)(ib + EPI_OFF(BW)); }
            EPI_HALF_ROWS { float v[8], z[8]; acc8(acc[ai][bj][m][0], acc[ai][bj][m][1], v); unpack8(zq[m][bj], z);
#pragma unroll
                for (int e = 0; e < 8; ++e) v[e] = v[e] * sc[bj][e] * z[e];
                *(u32x4*)(ib + EPI_OFF(BW)) = pack8(v); }
        }
    }
};
struct EpiBranch {
    const unsigned char* gate; bf16* merged; int first;
    __device__ __forceinline__ void operator()(const f32x4 (&acc)[2][2][4][2], const pg8::Unit& u, int wr, int wc) const {
        const int lane_ = fresh_lane(), fr = lane_ & 15, fq = lane_ >> 4;
        const int row0 = u.pm * 256 + wr * 64 + fr, col0 = u.pn * 256 + wc * 32 + 8 * fq;
        const unsigned char* gb = gate; unsigned char* mb = (unsigned char*)merged;
        if (first) {
            u32x2 gq[2][4][2];
            EPI_ROWS(D) { gq[ai][m][bj] = *(const u32x2*)(gb + EPI_OFFB(D)); }
            EPI_ROWS(D) { float v[8], g[8]; acc8(acc[ai][bj][m][0], acc[ai][bj][m][1], v); unpack8_u8(gq[ai][m][bj], g);
#pragma unroll
                for (int e = 0; e < 8; ++e) v[e] = v[e] * (g[e] * (1.0f / 255.f));
                *(u32x4*)(mb + EPI_OFF(D)) = pack8(v); }
        } else {
#pragma unroll
            for (int ai = 0; ai < 2; ++ai) {
                u32x2 gq[4][2]; u32x4 oq[4][2];
                EPI_HALF_ROWS { gq[m][bj] = *(const u32x2*)(gb + EPI_OFFB(D)); oq[m][bj] = *(const u32x4*)(mb + EPI_OFF(D)); }
                EPI_HALF_ROWS { float v[8], g[8], o[8]; acc8(acc[ai][bj][m][0], acc[ai][bj][m][1], v); unpack8_u8(gq[m][bj], g); unpack8(oq[m][bj], o);
#pragma unroll
                    for (int e = 0; e < 8; ++e) v[e] = o[e] + v[e] * (g[e] * (1.0f / 255.f));
                    *(u32x4*)(mb + EPI_OFF(D)) = pack8(v); }
            }
        }
    }
};
struct EpiOut {
    bf16* out; float* oss;
    __device__ __forceinline__ void operator()(const f32x4 (&acc)[2][2][4][2], const pg8::Unit& u, int wr, int wc) const {
        const int lane_ = fresh_lane(), fr = lane_ & 15, fq = lane_ >> 4;
        const int row0 = u.pm * 256 + wr * 64 + fr, col0 = u.pn * 256 + wc * 32 + 8 * fq;
        unsigned char* ob = (unsigned char*)out;
#pragma unroll
        for (int ai = 0; ai < 2; ++ai)
#pragma unroll
            for (int m = 0; m < 4; ++m) { const int row = row0 + ai * 128 + m * 16; float s = 0.f;
#pragma unroll
                for (int bj = 0; bj < 2; ++bj) { float v[8]; acc8(acc[ai][bj][m][0], acc[ai][bj][m][1], v);
#pragma unroll
                    for (int e = 0; e < 8; ++e) s += v[e] * v[e];
                    *(u32x4*)(ob + EPI_OFF(D)) = pack8(v); }
                s += shfl_x(s, 16, lane_); s += shfl_x(s, 32, lane_);
                if (fq == 0) oss[(unsigned)row * 16u + u.pn * 4 + wc] = s; }
    }
};

namespace pg8 {
struct A4 { const bf16* p[4]; };
__device__ __forceinline__ void gemm_merge_phase(LAS unsigned char* lds, const A4 a4, const bf16* gBt, const unsigned char* gate, bf16* merged, const int G, const int cid, const int tid) {
    constexpr int GK = BW, LDA = BW, LDB = BW, NT128 = D / 128;
    const int wid = __builtin_amdgcn_readfirstlane(tid >> 6), lane = tid & 63, wr = wid >> 2, wc = wid & 3, fr = lane & 15, fq = lane >> 4;
    constexpr int nt = GK / BK;
    StaticOrder S; S.nM = MH / BM; S.nN = NT128; S.nwg = S.nM * S.nN; S.G = G; S.c = cid;
    unsigned voffA, voffB;
    { int R, C; stage_rc(tid * 16, R, C); const int Rb = (R & ~31) + perm32(R & 31); voffA = (unsigned)(R * LDA + C) * 2u; voffB = (unsigned)(Rb * LDB + C) * 2u; }
    constexpr size_t voffA_R64 = (size_t)64 * LDA * 2, voffB_R64 = (size_t)64 * LDB * 2;
    constexpr size_t kstep = (size_t)(BK * 2);
    constexpr size_t hstepA = (size_t)HALF * LDA * 2, hstepB = (size_t)HALF * LDB * 2, tstepA = 2 * hstepA;
    const unsigned ldsw = (unsigned)wid * 1024u;
    const int aoff = lds_byte(wr * 64 + fr, fq * 8), boff = lds_byte(wc * 32 + fr, fq * 8);
    const unsigned ldsd = (unsigned)(__SIZE_TYPE__)lds + ldsw;
#define PGM_SA(b, h) (((b) * 2 + (h)) * HTB)
#define PGM_SB(b) ((4 + (b)) * HTB)
#define PGM_STAGE(bufoff, gbase, voff) do { _Pragma("unroll") for (int _i = 0; _i < 2; ++_i) \
        asm volatile("s_mov_b32 m0, %0\n\ts_nop 0\n\tglobal_load_lds_dwordx4 %1, %2" :: "s"(ldsd + (unsigned)((bufoff) + _i * 8192)), "v"(voff), "s"((const char*)(gbase) + (size_t)_i * (voff##_R64)) : "m0", "memory"); } while (0)
#define PGM_LDA(dst, b, h) do { _Pragma("unroll") for (int m = 0; m < 4; ++m) _Pragma("unroll") for (int k = 0; k < 2; ++k) dst[m][k] = *(const LAS bf16x8*)(lds + PGM_SA(b, h) + aoff + m * 2048 + k * 1024); } while (0)
#define PGM_LDB(dst, b) do { _Pragma("unroll") for (int n = 0; n < 2; ++n) _Pragma("unroll") for (int k = 0; k < 2; ++k) dst[n][k] = *(const LAS bf16x8*)(lds + PGM_SB(b) + boff + n * 2048 + k * 1024); } while (0)
#define PGM_MMA(ai, At, Bt) do { __builtin_amdgcn_s_setprio(1); _Pragma("unroll") for (int m = 0; m < 4; ++m) _Pragma("unroll") for (int n = 0; n < 2; ++n) _Pragma("unroll") for (int k = 0; k < 2; ++k) \
        acc[ai][m][n] = __builtin_amdgcn_mfma_f32_16x16x32_bf16(Bt[n][k], At[m][k], acc[ai][m][n], 0, 0, 0); __builtin_amdgcn_s_setprio(0); } while (0)
#define PGM_WAIT_V(n) asm volatile("s_waitcnt vmcnt(" #n ")" ::: "memory")
#define PGM_WAIT_L(n) asm volatile("s_waitcnt lgkmcnt(" #n ")" ::: "memory")
#define PGM_BAR __builtin_amdgcn_s_barrier()
#define PGM_SCHED __builtin_amdgcn_sched_barrier(0)
#define PGM_NEXT(i_, u_) (S.next((i_) >> 2, u_) ? ((u_).z = (i_) & 3, true) : false)
#define PGM_ABASE(u_) ((const char*)((u_).z == 0 ? a4.p[0] : (u_).z == 1 ? a4.p[1] : (u_).z == 2 ? a4.p[2] : a4.p[3]) + (size_t)(u_).pm * tstepA)
#define PGM_BBASE(u_) ((const char*)gBt + (size_t)(u_).z * ((size_t)D * LDB * 2) + (size_t)(u_).pn * hstepB)
#define PGM_GATES(u_) do { const unsigned char* gb_ = gate + (size_t)(u_).z * MH * D + (size_t)(u_).pm * 256 * D; \
        _Pragma("unroll") for (int ai = 0; ai < 2; ++ai) _Pragma("unroll") for (int m = 0; m < 4; ++m) gq[ai][m] = *(const u32x2*)(gb_ + goff + (unsigned)((ai * 128 + m * 16) * D)); } while (0)
    Unit cur, nxt; int ui = 0;
    if (!PGM_NEXT(0, cur)) return;
    f32x4 acc[2][4][2], msum[2][4][2]; u32x2 gq[2][4];
#pragma unroll
    for (int a = 0; a < 2; ++a)
#pragma unroll
        for (int m = 0; m < 4; ++m)
#pragma unroll
            for (int n = 0; n < 2; ++n) { acc[a][m][n] = (f32x4){0.f, 0.f, 0.f, 0.f}; msum[a][m][n] = (f32x4){0.f, 0.f, 0.f, 0.f}; }
    bf16x8 At[4][2], B0[2][2];
    const unsigned goff_lane = (unsigned)((wr * 64 + fr) * D + wc * 32 + 8 * fq);
    unsigned goff = goff_lane + (unsigned)cur.pn * 128u;
    const char* cA = PGM_ABASE(cur); const char* cB = PGM_BBASE(cur);
    PGM_GATES(cur);
    PGM_STAGE(PGM_SB(0), cB, voffB); PGM_STAGE(PGM_SA(0, 0), cA, voffA); PGM_STAGE(PGM_SA(0, 1), cA + hstepA, voffA);
    if (wr == 1) PGM_BAR;
    PGM_WAIT_V(2); PGM_BAR;
    PGM_STAGE(PGM_SB(1), cB + kstep, voffB); PGM_STAGE(PGM_SA(1, 0), cA + kstep, voffA);
    PGM_WAIT_V(4); PGM_BAR;
    for (;;) {
        const bool has_next = PGM_NEXT(ui + 1, nxt);
        const char* nA = has_next ? PGM_ABASE(nxt) : cA; const char* nB = has_next ? PGM_BBASE(nxt) : cB;
#pragma unroll 1
        for (int t = 0; t < nt; t += 2) {
            const bool last = (t == nt - 2);
            const char* a1 = cA + (size_t)(t + 1) * kstep;
            const char* a2 = last ? nA : cA + (size_t)(t + 2) * kstep; const char* b2 = last ? nB : cB + (size_t)(t + 2) * kstep;
            const char* a3 = a2 + kstep; const char* b3 = b2 + kstep;
            PGM_LDB(B0, 0); PGM_SCHED; PGM_LDA(At, 0, 0); PGM_STAGE(PGM_SA(1, 1), a1 + hstepA, voffA);
            PGM_WAIT_V(6); PGM_WAIT_L(0); PGM_BAR; PGM_MMA(0, At, B0); PGM_BAR; PGM_SCHED;
            PGM_LDA(At, 0, 1); PGM_STAGE(PGM_SB(0), b2, voffB); PGM_STAGE(PGM_SA(0, 0), a2, voffA);
            PGM_WAIT_V(6); PGM_WAIT_L(0); PGM_BAR; PGM_MMA(1, At, B0); PGM_BAR; PGM_SCHED;
            PGM_LDB(B0, 1); PGM_SCHED; PGM_LDA(At, 1, 0); PGM_STAGE(PGM_SA(0, 1), a2 + hstepA, voffA);
            PGM_WAIT_V(6); PGM_WAIT_L(0); PGM_BAR; PGM_MMA(0, At, B0); PGM_BAR; PGM_SCHED;
            PGM_LDA(At, 1, 1); PGM_STAGE(PGM_SB(1), b3, voffB); PGM_STAGE(PGM_SA(1, 0), a3, voffA);
            PGM_WAIT_V(6); PGM_WAIT_L(0); PGM_BAR; PGM_MMA(1, At, B0); PGM_BAR; PGM_SCHED;
        }
        if (wr == 0) PGM_BAR;
#pragma unroll
        for (int ai = 0; ai < 2; ++ai)
#pragma unroll
            for (int m = 0; m < 4; ++m) { float g[8]; unpack8_u8(gq[ai][m], g);
                msum[ai][m][0] = msum[ai][m][0] + acc[ai][m][0] * (f32x4){g[0], g[1], g[2], g[3]}; msum[ai][m][1] = msum[ai][m][1] + acc[ai][m][1] * (f32x4){g[4], g[5], g[6], g[7]};
                acc[ai][m][0] = (f32x4){0.f, 0.f, 0.f, 0.f}; acc[ai][m][1] = (f32x4){0.f, 0.f, 0.f, 0.f}; }
        if (cur.z == 3) {
            unsigned char* mb = (unsigned char*)(merged + (size_t)cur.pm * 256 * D);
#pragma unroll
            for (int ai = 0; ai < 2; ++ai)
#pragma unroll
                for (int m = 0; m < 4; ++m) { float v[8]; const f32x4 s0 = msum[ai][m][0] * (1.0f / 255.f), s1 = msum[ai][m][1] * (1.0f / 255.f); acc8(s0, s1, v);
                    *(u32x4*)(mb + (size_t)(goff + (unsigned)((ai * 128 + m * 16) * D)) * 2) = pack8(v);
                    msum[ai][m][0] = (f32x4){0.f, 0.f, 0.f, 0.f}; msum[ai][m][1] = (f32x4){0.f, 0.f, 0.f, 0.f}; }
        }
        if (!has_next) break;
        cur = nxt; cA = nA; cB = nB; ++ui;
        goff = goff_lane + (unsigned)cur.pn * 128u;
        PGM_GATES(cur);
        if (wr == 1) PGM_BAR;
    }
    PGM_WAIT_V(0);
    PGM_BAR;
#undef PGM_SA
#undef PGM_SB
#undef PGM_STAGE
#undef PGM_LDA
#undef PGM_LDB
#undef PGM_MMA
#undef PGM_WAIT_V
#undef PGM_WAIT_L
#undef PGM_BAR
#undef PGM_SCHED
#undef PGM_NEXT
#undef PGM_ABASE
#undef PGM_BBASE
#undef PGM_GATES
}
}

struct Args { const float* in[22]; float* out; unsigned char* ws; int ph_lo, ph_hi; };
struct Ctx { int tid, lane, wave, G, bx, vcu, gw, NGW, gt, NGT, al, xg, xr, vrole; unsigned char* ws; };
#define CAS __attribute__((address_space(4)))
#if defined(__HIP_DEVICE_COMPILE__)
#define LOAD_ARGS(c) const CAS Args* kp_##c = (const CAS Args*)__builtin_amdgcn_kernarg_segment_ptr(); asm volatile("" : "+s"(kp_##c)); const Args a = *kp_##c
#else
#define LOAD_ARGS(c) const Args a = a_
#endif
#define MAKE_CTX(c) Ctx c; LOAD_ARGS(c); do { int wv_ = wave0; asm volatile("" : "+s"(wv_)); const int t_ = wv_ * 64 + fresh_lane(); int g_ = gridDim.x, b_ = vbid; asm volatile("" : "+s"(g_), "+s"(b_)); GAS unsigned char* w_ = (GAS unsigned char*)a.ws; asm volatile("" : "+s"(w_)); \
    c.tid = t_; c.lane = t_ & 63; c.wave = wv_; c.G = g_; c.bx = b_; c.vcu = (g_ % 8 == 0) ? (b_ % 8) * (g_ / 8) + b_ / 8 : b_; \
    c.gw = c.vcu * NWAVES + c.wave; c.NGW = g_ * NWAVES; c.gt = c.gw * 64 + c.lane; c.NGT = c.NGW * 64; c.al = (g_ == 256) ? 1 : 0; c.xg = b_ & 7; c.xr = b_ >> 3; c.vrole = c.al ? ((c.xr < 16) ? c.xg * 16 + c.xr : 128 + c.xg * 16 + (c.xr - 16)) : c.vcu; c.ws = (unsigned char*)w_; } while (0)
enum { I_X = 0, I_NPRE, I_NPOST, I_WIN, I_ARE, I_AIM, I_LDT, I_BRE, I_BIM, I_CRE, I_CIM, I_S5D, I_WGLU, I_POOLW, I_POOLS, I_SCW, I_MCW, I_MBI, I_MBF, I_MNW, I_WBR, I_WOUT };

__device__ __forceinline__ unsigned pk4_fp8(float a, float b, float c, float d) { int w = 0; w = __builtin_amdgcn_cvt_pk_fp8_f32(a, b, w, false); w = __builtin_amdgcn_cvt_pk_fp8_f32(c, d, w, true); return (unsigned)w; }
__device__ __forceinline__ void transpose_item8(const float* W, int ldw, int k0s, int n0s, unsigned char* WT, int ldt, int n0d, int k0d, LAS float* scr, int lane, float scale) {
    { float t[32];
#pragma unroll
      for (int i = 0; i < 32; ++i) { const int kk = 2 * i + (lane >> 5); t[i] = W[(size_t)(k0s + kk) * ldw + n0s + (lane & 31)]; }
#pragma unroll
      for (int i = 0; i < 32; ++i) { const int kk = 2 * i + (lane >> 5); scr[kk * 33 + (lane & 31)] = t[i] * scale; } }
    LDS_WAIT(); __builtin_amdgcn_wave_barrier();
    const int c = lane & 7;
#pragma unroll
    for (int j = 0; j < 4; ++j) { const int n = (lane >> 3) + 8 * j; const LAS float* s = scr + (8 * c) * 33 + n;
        u32x2 o; o.x = pk4_fp8(s[0 * 33], s[1 * 33], s[2 * 33], s[3 * 33]); o.y = pk4_fp8(s[4 * 33], s[5 * 33], s[6 * 33], s[7 * 33]);
        *(u32x2*)(WT + (size_t)(n0d + n) * ldt + k0d + 8 * c) = o; }
    LDS_WAIT(); __builtin_amdgcn_wave_barrier();
}
__device__ __forceinline__ void transpose_item(const float* W, int ldw, int k0s, int n0s, bf16* WT, int ldt, int n0d, int k0d, LAS float* scr, int lane, bool zero) {
    if (!zero) {
        float t[32];
#pragma unroll
        for (int i = 0; i < 32; ++i) { const int kk = 2 * i + (lane >> 5); t[i] = W[(size_t)(k0s + kk) * ldw + n0s + (lane & 31)]; }
#pragma unroll
        for (int i = 0; i < 32; ++i) { const int kk = 2 * i + (lane >> 5); scr[kk * 33 + (lane & 31)] = t[i]; }
    } else {
#pragma unroll 8
        for (int i = 0; i < 32; ++i) { const int kk = 2 * i + (lane >> 5); scr[kk * 33 + (lane & 31)] = 0.f; }
    }
    LDS_WAIT(); __builtin_amdgcn_wave_barrier();
    const int c = lane & 7;
#pragma unroll
    for (int j = 0; j < 4; ++j) { const int n = (lane >> 3) + 8 * j; const LAS float* s = scr + (8 * c) * 33 + n;
        u32x4 o; o.x = cvt_pk_bf16(s[0 * 33], s[1 * 33]); o.y = cvt_pk_bf16(s[2 * 33], s[3 * 33]); o.z = cvt_pk_bf16(s[4 * 33], s[5 * 33]); o.w = cvt_pk_bf16(s[6 * 33], s[7 * 33]);
        *(u32x4*)(WT + (size_t)(n0d + n) * ldt + k0d + 8 * c) = o; }
    LDS_WAIT(); __builtin_amdgcn_wave_barrier();
}
__device__ __forceinline__ void phase_prologue(const Args& a, const Ctx& c, LAS unsigned char* lds) {
    unsigned char* ws = c.ws; const int gw = c.gw, NGW = c.NGW, wave = c.wave, lane = c.lane;
    LAS float* scr = (LAS float*)(lds + wave * 16384);
    constexpr int I_W1 = DEPTH * 16 * 336, I_WB = DEPTH * 4 * 8 * 32, I_WO = DEPTH * 16 * 32, I_WG = DEPTH * 8 * 16, I_WP = DEPTH * 8 * 16;
    constexpr int NIT = I_W1 + I_WB + I_WO + I_WG + I_WP;
    for (int it = gw; it < NIT; it += NGW) {
        int r = it;
        if (r < I_W1) { const int l = r / 5376, q = r % 5376, kb = q / 336, nb = q % 336, n0d = nb * 32; int n0s = n0d + (n0d >= 6144 ? 8 : 0);
            if (n0d >= 2048 && n0d < 4096) {
                const int nd = n0d + (lane & 31), qq = (nd - 2048) & 1023, g8 = qq >> 3, e = qq & 7, first = (nd < 3072) ? (e < 4 ? 2048 : 3072) : (e < 4 ? 2560 : 3584);
                n0s = first + 4 * g8 + (e & 3) - (lane & 31); }
            if (n0d < 6656) transpose_item(a.in[I_WIN] + (size_t)l * D * NIN, NIN, kb * 64, n0s, (bf16*)(ws + WS_W1T) + (size_t)l * NP * D, D, n0d, kb * 64, scr, lane, false);
            else transpose_item8(a.in[I_WIN] + (size_t)l * D * NIN, NIN, kb * 64, n0s, ws + WS_W8 + (size_t)l * 4 * D * D, D, n0d - 6656, kb * 64, scr, lane, W8_SCALE);
            continue; }
        r -= I_W1;
        if (r < I_WB) { const int lb = r / 256, q = r % 256, kb = q / 32, nb = q % 32;
            transpose_item(a.in[I_WBR] + (size_t)lb * BW * D, D, kb * 64, nb * 32, (bf16*)(ws + WS_WBT) + (size_t)lb * D * BW, BW, nb * 32, kb * 64, scr, lane, false); continue; }
        r -= I_WB;
        if (r < I_WO) { const int l = r / 512, q = r % 512, kb = q / 32, nb = q % 32;
            transpose_item(a.in[I_WOUT] + (size_t)l * D * D, D, kb * 64, nb * 32, (bf16*)(ws + WS_WOT) + (size_t)l * D * D, D, nb * 32, kb * 64, scr, lane, false); continue; }
        r -= I_WO;
        if (r < I_WG) { const int l = r / 128, q = r % 128, kb = q / 16, nb = q % 16;
            transpose_item(a.in[I_WGLU] + (size_t)l * BW * BW, BW, kb * 64, nb * 32, (bf16*)(ws + WS_WGT) + (size_t)l * BW * BW, BW, nb * 32, kb * 64, scr, lane, false); continue; }
        r -= I_WG;
        { const int l = r / 128, q = r % 128, kb = q / 16, nb = q % 16, k0 = kb * 64, n0 = nb * 32, gk = k0 >> 7, gn = n0 >> 7;
            transpose_item(a.in[I_POOLW] + (size_t)(l * 4 + gk) * 128 * 128, 128, k0 & 127, n0 & 127, (bf16*)(ws + WS_WPT) + (size_t)l * BW * BW, BW, n0, k0, scr, lane, gk != gn); }
    }
    const int gt = gw * 64 + lane, NGT = NGW * 64;
    for (int i = gt; i < DEPTH * NG * NS; i += NGT) {
        const int l = i / (NG * NS), g = (i / NS) % NG, n = i % NS;
        const float lr = a.in[I_ARE][i], li = a.in[I_AIM][i], dt = __expf(a.in[I_LDT][l * NG + g]);
        const float er = __expf(lr * dt);
        const double rev = (double)li * (double)dt * 0.15915494309189535; const float fr = (float)(rev - __builtin_rint(rev));
        const float ar = er * __builtin_amdgcn_cosf(fr), ai = er * __builtin_amdgcn_sinf(fr);
        const float e64 = __expf(64.f * lr * dt);
        const double rev64 = rev * 64.0; const float fr64 = (float)(rev64 - __builtin_rint(rev64));
        const float ar64 = e64 * __builtin_amdgcn_cosf(fr64), ai64 = e64 * __builtin_amdgcn_sinf(fr64);
        unsigned char* T = ws + WS_S5T + (size_t)l * S5T_LAYER;
        ((f32x2*)(T + S5T_A))[g * NS + n] = (f32x2){ar, ai};
        ((f32x2*)(T + S5T_A64))[g * NS + n] = (f32x2){ar64, ai64};
        const float nr = ar - 1.f, ni = ai, den = 1.f / (lr * lr + li * li);
        const float cr = (nr * lr + ni * li) * den, ci = (ni * lr - nr * li) * den;
        bf16* TB = (bf16*)(T + S5T_B) + (size_t)(g * 128 + 2 * n) * 16;
        const float* Bre = a.in[I_BRE] + (size_t)i * 16; const float* Bim = a.in[I_BIM] + (size_t)i * 16;
#pragma unroll
        for (int q = 0; q < 16; ++q) { const float br = Bre[q], bi = Bim[q]; TB[q] = (bf16)f2bf(cr * br - ci * bi); TB[16 + q] = (bf16)f2bf(cr * bi + ci * br); }
        bf16* TC = (bf16*)(T + S5T_C) + (size_t)g * 16 * 128;
        const float* Cre = a.in[I_CRE] + (size_t)(l * NG + g) * 16 * NS; const float* Cim = a.in[I_CIM] + (size_t)(l * NG + g) * 16 * NS;
#pragma unroll
        for (int p = 0; p < 16; ++p) { TC[p * 128 + 2 * n] = (bf16)f2bf(Cre[p * NS + n]); TC[p * 128 + 2 * n + 1] = (bf16)f2bf(-Cim[p * NS + n]); }
    }
}

template <bool DO_RES, bool DO_H, bool SRCB>
__device__ __forceinline__ void phase_norm(const Args& a, const Ctx& c, LAS unsigned char* lds, int layer, int pass) {
    unsigned char* ws = c.ws; const int gw = c.gw, NGW = c.NGW, lane = c.lane;
    LAS float* wif = (LAS float*)lds;
    if (DO_H) {
        const float* win = a.in[I_WIN] + (size_t)layer * D * NIN + 6144;
        { float t[8192 / NTHR];
#pragma unroll
          for (int k = 0; k < 8192 / NTHR; ++k) { const int i = c.tid + k * NTHR, cc = i >> 3, jj = i & 7; t[k] = win[(size_t)cc * NIN + jj]; }
#pragma unroll
          for (int k = 0; k < 8192 / NTHR; ++k) { const int i = c.tid + k * NTHR, cc = i >> 3, jj = i & 7;
              wif[jj * 1024 + 256 * (2 * (cc >> 9) + ((cc & 7) >> 2)) + 4 * ((cc & 511) >> 3) + (cc & 3)] = t[k]; } }
        __syncthreads();
    }
    const float* xsrc = a.in[I_X] + (size_t)pass * MH * D; bf16* XB = (bf16*)(ws + WS_XB);
#define NCOL(j) (8 * lane + 512 * ((j) >> 1) + 4 * ((j) & 1))
#define NORM_LOADX(dst, raw, row_) do { if (SRCB) { _Pragma("unroll") for (int q = 0; q < 2; ++q) raw[q] = *(const u32x4*)(XB + (size_t)(row_) * D + 8 * lane + 512 * q); } \
        else { _Pragma("unroll") for (int j = 0; j < 4; ++j) dst[j] = *(const f32x4*)(xsrc + (size_t)(row_) * D + NCOL(j)); } } while (0)
    f32x4 wpre[4], wpost[4];
#pragma unroll
    for (int j = 0; j < 4; ++j) {
        wpre[j] = DO_H ? *(const f32x4*)(a.in[I_NPRE] + (size_t)layer * D + NCOL(j)) : (f32x4){0.f, 0.f, 0.f, 0.f};
        wpost[j] = DO_RES ? *(const f32x4*)(a.in[I_NPOST] + (size_t)(DO_H ? layer - 1 : layer) * D + NCOL(j)) : (f32x4){0.f, 0.f, 0.f, 0.f};
    }
    const bf16* OUT = (const bf16*)(ws + WS_QKA); const float* OSS = (const float*)(ws + WS_OSS);
    bf16* Hb = (bf16*)(ws + WS_H); float* IF = (float*)(ws + WS_IF);
    constexpr int NPF = 2;
    f32x4 vn[NPF][4]; u32x4 xr[NPF][2], on[NPF][2]; f32x4 pn[NPF][4];
#pragma unroll
    for (int h = 0; h < NPF; ++h)
#pragma unroll
        for (int j = 0; j < 4; ++j) { vn[h][j] = (f32x4){0.f, 0.f, 0.f, 0.f}; xr[h][j >> 1] = (u32x4){0u, 0u, 0u, 0u}; on[h][j >> 1] = (u32x4){0u, 0u, 0u, 0u}; pn[h][j] = (f32x4){0.f, 0.f, 0.f, 0.f}; }
#define NORM_LOADO(h_, row_) do { if (DO_RES) { _Pragma("unroll") for (int q = 0; q < 2; ++q) on[h_][q] = *(const u32x4*)(OUT + (size_t)(row_) * D + 8 * lane + 512 * q); \
        _Pragma("unroll") for (int j = 0; j < 4; ++j) pn[h_][j] = *(const f32x4*)(OSS + (size_t)(row_) * 16 + 4 * j); } } while (0)
    const int r_first = c.al ? c.xg * (MH / 8) + (c.xr * NWAVES + c.wave) : gw, r_step = c.al ? (NGW / 8) : NGW, r_end = c.al ? (c.xg + 1) * (MH / 8) : MH;
#pragma unroll
    for (int h = 0; h < NPF; ++h) if (r_first + h * r_step < r_end) { NORM_LOADX(vn[h], xr[h], r_first + h * r_step); NORM_LOADO(h, r_first + h * r_step); }
    for (int r0 = r_first; r0 < r_end; r0 += NPF * r_step) {
#pragma unroll
      for (int h = 0; h < NPF; ++h) { const int r = r0 + h * r_step; if (r >= r_end) break;
        const size_t grow = (size_t)pass * MH + r;
        f32x4 v[4]; u32x4 oc[2]; float ss = 0.f;
#pragma unroll
        for (int q = 0; q < 2; ++q) { const u32x4 xq = xr[h][q]; oc[q] = on[h][q];
            v[2 * q] = SRCB ? (f32x4){bflo(xq.x), bfhi(xq.x), bflo(xq.y), bfhi(xq.y)} : vn[h][2 * q]; v[2 * q + 1] = SRCB ? (f32x4){bflo(xq.z), bfhi(xq.z), bflo(xq.w), bfhi(xq.w)} : vn[h][2 * q + 1]; }
#pragma unroll
        for (int j = 0; j < 4; ++j) ss += (pn[h][j][0] + pn[h][j][1]) + (pn[h][j][2] + pn[h][j][3]);
        if (r + NPF * r_step < r_end) { NORM_LOADX(vn[h], xr[h], r + NPF * r_step); NORM_LOADO(h, r + NPF * r_step); }
        if (DO_RES) {
            const float rs = __builtin_amdgcn_rsqf(ss * (1.f / D) + RMS_EPS);
#pragma unroll
            for (int j = 0; j < 4; ++j) { const unsigned ox = (j & 1) ? oc[j >> 1].z : oc[j >> 1].x, oy = (j & 1) ? oc[j >> 1].w : oc[j >> 1].y;
                v[j][0] += bflo(ox) * rs * wpost[j][0]; v[j][1] += bfhi(ox) * rs * wpost[j][1]; v[j][2] += bflo(oy) * rs * wpost[j][2]; v[j][3] += bfhi(oy) * rs * wpost[j][3]; }
            if (DO_H) {
#pragma unroll
                for (int q = 0; q < 2; ++q) { u32x4 w; w.x = cvt_pk_bf16(v[2 * q][0], v[2 * q][1]); w.y = cvt_pk_bf16(v[2 * q][2], v[2 * q][3]); w.z = cvt_pk_bf16(v[2 * q + 1][0], v[2 * q + 1][1]); w.w = cvt_pk_bf16(v[2 * q + 1][2], v[2 * q + 1][3]);
                    *(u32x4*)(XB + (size_t)r * D + 8 * lane + 512 * q) = w; }
            } else {
#pragma unroll
                for (int j = 0; j < 4; ++j) *(f32x4*)(a.out + grow * D + NCOL(j)) = v[j]; }
        }
        if (DO_H) {
            float s = 0.f;
#pragma unroll
            for (int j = 0; j < 4; ++j) s += (v[j][0] * v[j][0] + v[j][1] * v[j][1]) + (v[j][2] * v[j][2] + v[j][3] * v[j][3]);
            const float rstd = __builtin_amdgcn_rsqf(dpp_wave_sum(s) * (1.f / D) + RMS_EPS);
#pragma unroll
            for (int j = 0; j < 4; ++j) v[j] = v[j] * rstd * wpre[j];
#pragma unroll
            for (int q = 0; q < 2; ++q) { u32x4 o; o.x = cvt_pk_bf16(v[2 * q][0], v[2 * q][1]); o.y = cvt_pk_bf16(v[2 * q][2], v[2 * q][3]); o.z = cvt_pk_bf16(v[2 * q + 1][0], v[2 * q + 1][1]); o.w = cvt_pk_bf16(v[2 * q + 1][2], v[2 * q + 1][3]);
                *(u32x4*)(Hb + (size_t)r * D + 8 * lane + 512 * q) = o;
                u32x2 o8; o8.x = pk4_fp8(v[2 * q][0], v[2 * q][1], v[2 * q][2], v[2 * q][3]); o8.y = pk4_fp8(v[2 * q + 1][0], v[2 * q + 1][1], v[2 * q + 1][2], v[2 * q + 1][3]);
                *(u32x2*)(ws + WS_H8 + (size_t)r * D + 8 * lane + 512 * q) = o8; }
            float dd[8];
#pragma unroll
            for (int jj = 0; jj < 8; ++jj) { f32x2 d2 = {0.f, 0.f}, d3 = {0.f, 0.f};
#pragma unroll
                for (int j = 0; j < 4; ++j) { const f32x4 w = *(const LAS f32x4*)(wif + jj * 1024 + 4 * lane + 256 * j);
                    d2 = __builtin_elementwise_fma(f32x2{v[j][0], v[j][1]}, f32x2{w[0], w[1]}, d2); d3 = __builtin_elementwise_fma(f32x2{v[j][2], v[j][3]}, f32x2{w[2], w[3]}, d3); }
                d2 += d3; dd[jj] = d2[0] + d2[1]; if (jj & 1) __builtin_amdgcn_sched_barrier(0); }
            float e4[4], f2[2];
#pragma unroll
            for (int j = 0; j < 4; ++j) { const auto sw = __builtin_amdgcn_permlane32_swap(__builtin_bit_cast(unsigned, dd[j]), __builtin_bit_cast(unsigned, dd[j + 4]), false, false);
                unsigned r0 = sw[0], r1 = sw[1]; asm("" : "+v"(r0), "+v"(r1));
                e4[j] = __builtin_bit_cast(float, r0) + __builtin_bit_cast(float, r1); }
#pragma unroll
            for (int j = 0; j < 2; ++j) { const auto sw = __builtin_amdgcn_permlane16_swap(__builtin_bit_cast(unsigned, e4[j]), __builtin_bit_cast(unsigned, e4[j + 2]), false, false);
                unsigned r0 = sw[0], r1 = sw[1]; asm("" : "+v"(r0), "+v"(r1));
                f2[j] = __builtin_bit_cast(float, r0) + __builtin_bit_cast(float, r1); }
            const float g0 = f2[0] + __builtin_bit_cast(float, __builtin_amdgcn_update_dpp(0, __builtin_bit_cast(int, f2[0]), 0x128, 0xf, 0xf, false));
            const float g1 = f2[1] + __builtin_bit_cast(float, __builtin_amdgcn_update_dpp(0, __builtin_bit_cast(int, f2[1]), 0x128, 0xf, 0xf, false));
            float gs = (lane & 8) ? g1 : g0;
            gs += __builtin_bit_cast(float, __builtin_amdgcn_update_dpp(0, __builtin_bit_cast(int, gs), 0x141, 0xf, 0xf, false));
            gs += __builtin_bit_cast(float, __builtin_amdgcn_update_dpp(0, __builtin_bit_cast(int, gs), 0xB1, 0xf, 0xf, false));
            gs += __builtin_bit_cast(float, __builtin_amdgcn_update_dpp(0, __builtin_bit_cast(int, gs), 0x4E, 0xf, 0xf, false));
            if ((lane & 7) == 0) IF[(size_t)r * 8 + (lane >> 3)] = gs;
        }
      }
    }
    if (DO_H) __syncthreads();
#undef NORM_LOADX
#undef NORM_LOADO
#undef NCOL
}

__device__ __forceinline__ void ld8(const bf16* p, float (&f)[8]) { unpack8(*(const u32x4*)p, f); }
__device__ __forceinline__ void phase_ew(const Args& a, const Ctx& cx, int layer, int parts, int gt, int NGT) {
    unsigned char* ws = cx.ws;
    const int lt = cx.al ? cx.xr * NTHR + cx.tid : gt, NLT = cx.al ? NGT / 8 : NGT;
    bf16* SEG = (bf16*)(ws + WS_SEG);
    if (parts & 1) {
        bf16* QKA = (bf16*)(ws + WS_QKA); const float* cw = a.in[I_MCW] + (size_t)layer * 4 * 1024;
        const int NIa = cx.al ? (MH / 16) * 128 / 8 : (MH / 16) * 128, iba = cx.al ? cx.xg * NIa : 0;
        for (int li = lt; li < NIa; li += NLT) { const int id = iba + li;
            const int cg = id & 127, run = id >> 7, c = cg * 8, r0 = run * 16;
            const bf16* src = SEG + (size_t)(SG_QK + (cg >> 6)) * MH * BW + (c & 511);
            float w[4][8];
#pragma unroll
            for (int k = 0; k < 4; ++k) { const f32x4 w0 = *(const f32x4*)(cw + k * 1024 + c), w1 = *(const f32x4*)(cw + k * 1024 + c + 4); acc8(w0, w1, w[k]); }
            const float scale = (cg < 64) ? 0.08838834764831845f : 1.0f;
            const bool halo = (r0 & (SEQ - 1)) != 0;
            u32x4 raw[19];
#pragma unroll
            for (int i = 0; i < 3; ++i) raw[i] = halo ? *(const u32x4*)(src + (size_t)(r0 - 3 + i) * BW) : (u32x4){0u, 0u, 0u, 0u};
#pragma unroll
            for (int i = 0; i < 16; ++i) raw[3 + i] = *(const u32x4*)(src + (size_t)(r0 + i) * BW);
            float x0[8], x1[8], x2[8], x3[8];
            unpack8(raw[0], x0); unpack8(raw[1], x1); unpack8(raw[2], x2);
#pragma unroll
            for (int i = 0; i < 16; ++i) {
                unpack8(raw[3 + i], x3); float y[8];
#pragma unroll
                for (int e = 0; e < 8; ++e) { const float t = w[0][e] * x0[e] + w[1][e] * x1[e] + w[2][e] * x2[e] + w[3][e] * x3[e]; y[e] = t * fsigmoid(t) * scale; x0[e] = x1[e]; x1[e] = x2[e]; x2[e] = x3[e]; }
                *(u32x4*)(QKA + (size_t)(r0 + i) * D + c) = pack8(y);
            }
        }
    }
    if (parts & 2) {
        const float* cw = a.in[I_SCW] + (size_t)layer * 3 * BW;
        const bf16* P1 = SEG + (size_t)SG_SCX * MH * BW; const bf16* P2 = SEG + (size_t)SG_SCB * MH * BW; bf16* Z = SEG + (size_t)SG_SCZ * MH * BW;
        const int NIb = cx.al ? (MH / 16) * 64 / 8 : (MH / 16) * 64, ibb = cx.al ? cx.xg * NIb : 0;
        for (int li = lt; li < NIb; li += NLT) { const int id = ibb + li;
            const int cg = id & 63, run = id >> 6, c = cg * 8, r0 = run * 16;
            float w[3][8];
#pragma unroll
            for (int k = 0; k < 3; ++k) { const f32x4 w0 = *(const f32x4*)(cw + k * BW + c), w1 = *(const f32x4*)(cw + k * BW + c + 4); acc8(w0, w1, w[k]); }
            const bool halo = (r0 & (SEQ - 1)) != 0;
            u32x4 rp[18], rb[16];
#pragma unroll
            for (int i = 0; i < 2; ++i) rp[i] = halo ? *(const u32x4*)(P1 + (size_t)(r0 - 2 + i) * BW + c) : (u32x4){0u, 0u, 0u, 0u};
#pragma unroll
            for (int i = 0; i < 16; ++i) { const size_t off = (size_t)(r0 + i) * BW + c; rp[2 + i] = *(const u32x4*)(P1 + off); rb[i] = *(const u32x4*)(P2 + off); }
            float p0[8], p1[8], p2[8];
            unpack8(rp[0], p0); unpack8(rp[1], p1);
#pragma unroll
            for (int i = 0; i < 16; ++i) { const size_t off = (size_t)(r0 + i) * BW + c;
                float bz[8], y[8]; unpack8(rp[2 + i], p2); unpack8(rb[i], bz);
#pragma unroll
                for (int e = 0; e < 8; ++e) { y[e] = bz[e] * (w[0][e] * p0[e] + w[1][e] * p1[e] + w[2][e] * p2[e]); p0[e] = p1[e]; p1[e] = p2[e]; }
                *(u32x4*)(Z + off) = pack8(y); }
        }
    }
    if (parts & 4) {
        const bf16* U = SEG + (size_t)SG_PU * MH * BW; bf16* PO = (bf16*)(ws + WS_POOL);
        const int NIc = cx.al ? (MH / 16) * 64 / 8 : (MH / 16) * 64, ibc = cx.al ? cx.xg * NIc : 0;
        for (int li = lt; li < NIc; li += NLT) { const int id = ibc + li;
            const int cg = id & 63, run = id >> 6, c = cg * 8, r0 = run * 16, win = 2 << (cg >> 4), pos0 = r0 & (SEQ - 1);
            float s[8];
#pragma unroll
            for (int e = 0; e < 8; ++e) s[e] = 0.f;
            { u32x4 wu[16];
#pragma unroll
              for (int j = 1; j <= 16; ++j) wu[j - 1] = (j <= win && pos0 - j >= 0) ? *(const u32x4*)(U + (size_t)(r0 - j) * BW + c) : (u32x4){0u, 0u, 0u, 0u};
#pragma unroll
              for (int j = 0; j < 16; ++j) { float t[8]; unpack8(wu[j], t);
#pragma unroll
                for (int e = 0; e < 8; ++e) s[e] += t[e]; } }
#pragma unroll 1
            for (int i0 = 0; i0 < 16; i0 += 8) {
                u32x4 rc[8], ro[8];
#pragma unroll
                for (int i = 0; i < 8; ++i) { const int pos = pos0 + i0 + i; const size_t off = (size_t)(r0 + i0 + i) * BW + c;
                    rc[i] = *(const u32x4*)(U + off); ro[i] = (pos - win >= 0) ? *(const u32x4*)(U + off - (size_t)win * BW) : (u32x4){0u, 0u, 0u, 0u}; }
#pragma unroll
                for (int i = 0; i < 8; ++i) { const int pos = pos0 + i0 + i; const size_t off = (size_t)(r0 + i0 + i) * BW + c;
                    float cur[8], old[8], y[8]; unpack8(rc[i], cur); unpack8(ro[i], old);
                    const int cnt = (pos + 1 < win) ? pos + 1 : win; const float inv = 1.0f / (float)cnt;
#pragma unroll
                    for (int e = 0; e < 8; ++e) { s[e] += cur[e] - old[e]; y[e] = s[e] * inv - cur[e]; }
                    *(u32x4*)(PO + off) = pack8(y); }
            }
        }
    }
}
__device__ __forceinline__ void phase_ydfix(const Args& a, const Ctx& cx, int layer) {
    unsigned char* ws = cx.ws; const int gt = cx.gt, NGT = cx.NGT; bf16* SEG = (bf16*)(ws + WS_SEG);
    const bf16* HG = SEG + (size_t)SG_O * MH * BW; bf16* Z = SEG + (size_t)SG_MZ * MH * BW; const float* SSQ = (const float*)(ws + WS_SSQ); const float* nw = a.in[I_MNW] + (size_t)layer * BW;
    float w[8]; { const int c = (cx.tid & 63) * 8; const f32x4 w0 = *(const f32x4*)(nw + c), w1 = *(const f32x4*)(nw + c + 4); acc8(w0, w1, w); }
    const int NI = cx.al ? MH * 64 / 8 : MH * 64, ib = cx.al ? cx.xg * NI : 0, lt = cx.al ? cx.xr * NTHR + cx.tid : gt, NLT = cx.al ? NGT / 8 : NGT;
    for (int l0 = lt; l0 < NI; l0 += 4 * NLT) {
        u32x4 rh[4], rz[4];
#pragma unroll
        for (int k = 0; k < 4; ++k) { const int id = ib + l0 + k * NLT; const bool ok = l0 + k * NLT < NI; const int cg = id & 63, r = ok ? id >> 6 : 0, c = cg * 8, hd = cg >> 4; const size_t off = (size_t)r * BW + c;
            rh[k] = *(const u32x4*)(HG + off); rz[k] = *(const u32x4*)(Z + off); }
#pragma unroll
        for (int k = 0; k < 4; ++k) { const int id = ib + l0 + k * NLT; if (l0 + k * NLT >= NI) break; const int cg = id & 63, r = id >> 6, c = cg * 8; const size_t off = (size_t)r * BW + c;
            float h[8], z[8]; unpack8(rh[k], h); unpack8(rz[k], z);
            float sq = ((h[0] * h[0] + h[1] * h[1]) + (h[2] * h[2] + h[3] * h[3])) + ((h[4] * h[4] + h[5] * h[5]) + (h[6] * h[6] + h[7] * h[7]));
            sq += __builtin_bit_cast(float, __builtin_amdgcn_update_dpp(0, __builtin_bit_cast(int, sq), 0x128, 0xf, 0xf, false));
            sq += __builtin_bit_cast(float, __builtin_amdgcn_update_dpp(0, __builtin_bit_cast(int, sq), 0x124, 0xf, 0xf, false));
            sq += __builtin_bit_cast(float, __builtin_amdgcn_update_dpp(0, __builtin_bit_cast(int, sq), 0x122, 0xf, 0xf, false));
            sq += __builtin_bit_cast(float, __builtin_amdgcn_update_dpp(0, __builtin_bit_cast(int, sq), 0x121, 0xf, 0xf, false));
            const float rs = __builtin_amdgcn_rsqf(sq * (1.f / DH) + RMS_EPS);
#pragma unroll
            for (int e = 0; e < 8; ++e) h[e] = h[e] * rs * w[e] * z[e];
            *(u32x4*)(Z + off) = pack8(h); }
    }
}

constexpr int S5_UYS = 1040;
constexpr int S5_OFF_BU = 64 * S5_UYS;
constexpr int S5_WS = 272;
constexpr int S5_OFF_X = S5_OFF_BU + 8 * 16 * S5_WS;
static_assert(S5_OFF_X + 8 * 16 * S5_WS <= LDS_MISC, "S5 LDS");
template <bool PASS2>
__device__ __forceinline__ void phase_s5(const Args& a, const Ctx& cx, LAS unsigned char* lds, int layer, int u0, int ustride, int ucount) {
    unsigned char* ws = cx.ws;
    const int tid = cx.tid, wave = cx.wave, lane = cx.lane, fr = lane & 15, fq = lane >> 4;
    bf16* U = (bf16*)(ws + WS_SEG) + (size_t)SG_S5U * MH * BW;
    f32x2* E = (f32x2*)(ws + WS_E);
    const unsigned char* T = ws + WS_S5T + (size_t)layer * S5T_LAYER;
    const f32x2* TA = (const f32x2*)(T + S5T_A); const f32x2* TA64 = (const f32x2*)(T + S5T_A64);
    const bf16* TB = (const bf16*)(T + S5T_B); const bf16* TC = (const bf16*)(T + S5T_C);
    const float* Dk = a.in[I_S5D] + (size_t)layer * BW;
    LAS unsigned char* UY = lds; LAS unsigned char* BUs = lds + S5_OFF_BU + wave * 16 * S5_WS; LAS unsigned char* Xs = lds + S5_OFF_X + wave * 16 * S5_WS;
    u32x4 pre[8];
    const unsigned voff0 = (unsigned)(tid >> 6) * 1024u + (unsigned)(tid & 63) * 16u;
    if (u0 < HB * NCH) { const unsigned char* ub = (const unsigned char*)(U + ((size_t)(u0 / NCH) * SEQ + (size_t)(u0 % NCH) * CH) * BW);
#pragma unroll
        for (int j = 0; j < 8; ++j) pre[j] = *(const u32x4*)(ub + voff0 + 8192u * j); }
    f32x2 avN = (f32x2){0.f, 0.f}; s16x4 BfN[8]; bf16x8 CfN[4]; float dkN[4] = {0.f, 0.f, 0.f, 0.f};
#pragma unroll
    for (int ct = 0; ct < 8; ++ct) BfN[ct] = (s16x4){0, 0, 0, 0};
#pragma unroll
    for (int s = 0; s < 4; ++s) CfN[s] = (bf16x8){0, 0, 0, 0, 0, 0, 0, 0};
    float esr[4] = {0.f, 0.f, 0.f, 0.f}, esi[4] = {0.f, 0.f, 0.f, 0.f};
    float c0r[4] = {0.f, 0.f, 0.f, 0.f}, c0i[4] = {0.f, 0.f, 0.f, 0.f};
    if (PASS2 && u0 < HB * NCH && (u0 % NCH) != 0) { const int b = u0 / NCH, c = u0 % NCH;
        f32x2 a64[4], a128[4];
#pragma unroll
        for (int gi = 0; gi < 4; ++gi) { a64[gi] = *(const f32x2*)((const unsigned char*)(TA64 + (wave + 8 * gi) * NS) + (unsigned)lane * 8u);
            a128[gi] = (f32x2){a64[gi][0] * a64[gi][0] - a64[gi][1] * a64[gi][1], 2.f * a64[gi][0] * a64[gi][1]}; }
        const unsigned char* Eb = (const unsigned char*)(E + ((size_t)b * NCH * NG + wave) * NS); const unsigned eoff = (unsigned)lane * 8u;
        const int np = c >> 1;
        for (int j0 = 0; j0 < np; j0 += 12) {
            f32x2 e[4][12];
#pragma unroll
            for (int k = 0; k < 12; ++k) { const int jj = (j0 + k < np) ? j0 + k : np - 1; const unsigned char* Ek = Eb + (size_t)(2 * jj + 1) * (NG * NS * 8);
#pragma unroll
                for (int gi = 0; gi < 4; ++gi) e[gi][k] = *(const f32x2*)(Ek + (eoff + (unsigned)(gi * 8 * NS * 8))); }
#pragma unroll
            for (int k = 0; k < 12; ++k) if (j0 + k < np) {
#pragma unroll
                for (int gi = 0; gi < 4; ++gi) { const float nr = a128[gi][0] * c0r[gi] - a128[gi][1] * c0i[gi] + e[gi][k][0], ni = a128[gi][0] * c0i[gi] + a128[gi][1] * c0r[gi] + e[gi][k][1]; c0r[gi] = nr; c0i[gi] = ni; } }
        }
        if (c & 1) { const unsigned char* Ek = Eb + (size_t)(c - 1) * (NG * NS * 8);
#pragma unroll
            for (int gi = 0; gi < 4; ++gi) { const f32x2 e1 = *(const f32x2*)(Ek + (eoff + (unsigned)(gi * 8 * NS * 8)));
                const float nr = a64[gi][0] * c0r[gi] - a64[gi][1] * c0i[gi] + e1[0], ni = a64[gi][0] * c0i[gi] + a64[gi][1] * c0r[gi] + e1[1]; c0r[gi] = nr; c0i[gi] = ni; } }
    }
    for (int uk = 0; uk < ucount; ++uk) { const int unit = u0 + uk * ustride; if (unit >= HB * NCH) break;
        const int b = unit / NCH, c = unit % NCH; const size_t row0 = (size_t)b * SEQ + (size_t)c * CH;
#pragma unroll
        for (int j = 0; j < 8; ++j) { const int id = tid + NTHR * j, r = id >> 6, pc = id & 63; *(LAS u32x4*)(UY + r * S5_UYS + pc * 16) = pre[j]; }
        __syncthreads();
        float csr[4] = {0.f, 0.f, 0.f, 0.f}, csi[4] = {0.f, 0.f, 0.f, 0.f};
        const bool chain = PASS2 && uk > 0 && ustride == 1 && c != 0;
        const bool pairchain = !PASS2 && uk > 0 && ustride == 1 && (c & 1) != 0;
        if (chain) {
#pragma unroll
            for (int gi = 0; gi < 4; ++gi) { csr[gi] = esr[gi]; csi[gi] = esi[gi]; }
        }
        if (PASS2 && !chain && uk == 0) {
#pragma unroll
            for (int gi = 0; gi < 4; ++gi) { csr[gi] = c0r[gi]; csi[gi] = c0i[gi]; }
        }
        if (uk + 1 < ucount && unit + ustride < HB * NCH) { const int un = unit + ustride; const unsigned char* ub = (const unsigned char*)(U + ((size_t)(un / NCH) * SEQ + (size_t)(un % NCH) * CH) * BW);
#pragma unroll
            for (int j = 0; j < 8; ++j) pre[j] = *(const u32x4*)(ub + voff0 + 8192u * j); }
#define S5_LOADT(g_) do { const int gq_ = (g_); avN = *(const f32x2*)((const unsigned char*)(TA + gq_ * NS) + (unsigned)lane * 8u); \
            _Pragma("unroll") for (int ct = 0; ct < 8; ++ct) BfN[ct] = *(const s16x4*)((const unsigned char*)(TB + (size_t)gq_ * 128 * 16) + ((unsigned)(fr * 16 + fq * 4) * 2u + (unsigned)ct * 512u)); \
            if (PASS2) { _Pragma("unroll") for (int s = 0; s < 4; ++s) CfN[s] = *(const bf16x8*)((const unsigned char*)(TC + (size_t)gq_ * 16 * 128) + ((unsigned)(fr * 128 + fq * 8) * 2u + (unsigned)s * 64u)); \
                _Pragma("unroll") for (int r = 0; r < 4; ++r) dkN[r] = *(const float*)((const unsigned char*)(Dk + gq_ * 16) + ((unsigned)fq * 16u + (unsigned)r * 4u)); } } while (0)
        if (uk == 0) S5_LOADT(wave);
#pragma unroll
        for (int gi = 0; gi < 4; ++gi) {
            const int g = wave + 8 * gi;
            const float ar = avN[0], ai = avN[1];
            s16x4 Bf[8];
#pragma unroll
            for (int ct = 0; ct < 8; ++ct) Bf[ct] = BfN[ct];
            float sr = 0.f, si = 0.f;
            bf16x8 Cf[4]; float dk[4];
#pragma unroll
            for (int s = 0; s < 4; ++s) Cf[s] = CfN[s];
#pragma unroll
            for (int r = 0; r < 4; ++r) dk[r] = dkN[r];
            if (gi < 3) S5_LOADT(wave + 8 * (gi + 1)); else if (uk + 1 < ucount && unit + ustride < HB * NCH) S5_LOADT(wave);
            if (PASS2) { sr = csr[gi]; si = csi[gi]; }
            if (!PASS2 && pairchain) { sr = esr[gi]; si = esi[gi]; }
#pragma unroll 1
            for (int tb = 0; tb < 4; ++tb) {
                LAS unsigned char* up = UY + (tb * 16 + fr) * S5_UYS + (g * 16 + fq * 4) * 2;
                const s16x4 Uf = *(const LAS s16x4*)up;
#pragma unroll
                for (int ct = 0; ct < 8; ++ct) {
                    const f32x4 d = __builtin_amdgcn_mfma_f32_16x16x16bf16_1k(Bf[ct], Uf, (f32x4){0.f, 0.f, 0.f, 0.f}, 0, 0, 0);
                    u32x2 w; w.x = cvt_pk_bf16(d[0], d[1]); w.y = cvt_pk_bf16(d[2], d[3]);
                    *(LAS u32x2*)(BUs + fr * S5_WS + (ct * 16 + fq * 4) * 2) = w;
                }
                unsigned bw[16], xw[16];
#pragma unroll
                for (int t = 0; t < 16; ++t) bw[t] = *(const LAS unsigned*)(BUs + t * S5_WS + lane * 4);
                { f32x2 s2 = (f32x2){sr, si}; const f32x2 arr = (f32x2){ar, ar}, aii = (f32x2){-ai, ai};
#pragma unroll
                for (int t = 0; t < 16; ++t) { const f32x2 bb = (f32x2){bflo(bw[t]), bfhi(bw[t])}; const f32x2 tt = arr * s2 + bb; const f32x2 sw = (f32x2){s2[1], s2[0]}; s2 = aii * sw + tt; xw[t] = cvt_pk_bf16(s2[0], s2[1]); }
                sr = s2[0]; si = s2[1]; }
                if (PASS2) {
#pragma unroll
                    for (int t = 0; t < 16; ++t) *(LAS unsigned*)(Xs + t * S5_WS + lane * 4) = xw[t]; }
                if (PASS2) {
                        f32x4 y = (f32x4){0.f, 0.f, 0.f, 0.f};
#pragma unroll
                    for (int s = 0; s < 4; ++s) { const bf16x8 Xf = *(const LAS bf16x8*)(Xs + fr * S5_WS + (s * 32 + fq * 8) * 2);
                        y = __builtin_amdgcn_mfma_f32_16x16x32_bf16(Cf[s], Xf, y, 0, 0, 0); }
                    const u32x2 uw = __builtin_bit_cast(u32x2, Uf);
                    const float u0 = bflo(uw.x), u1 = bfhi(uw.x), u2 = bflo(uw.y), u3 = bfhi(uw.y);
                    float o[4] = {y[0] + dk[0] * u0, y[1] + dk[1] * u1, y[2] + dk[2] * u2, y[3] + dk[3] * u3};
#pragma unroll
                    for (int r = 0; r < 4; ++r) { const float x = o[r]; o[r] = x * fsigmoid(1.5957691216057308f * (x + 0.044715f * x * x * x)); }
                    u32x2 w; w.x = cvt_pk_bf16(o[0], o[1]); w.y = cvt_pk_bf16(o[2], o[3]);
                    *(LAS u32x2*)up = w;
                }
            }
            if (!PASS2) E[(((size_t)b * NCH + c) * NG + g) * NS + lane] = (f32x2){sr, si};
            esr[gi] = sr; esi[gi] = si;
        }
        __syncthreads();
        if (PASS2) {
#pragma unroll
            for (int j = 0; j < 8; ++j) { const int id = tid + NTHR * j, r = id >> 6, pc = id & 63;
                *(u32x4*)((unsigned char*)(U + row0 * BW) + voff0 + 8192u * j) = *(const LAS u32x4*)(UY + r * S5_UYS + pc * 16); }
            __syncthreads();
        }
    }
}

#undef S5_LOADT
constexpr int ML_KS = 272, ML_VS = 112, ML_CS = 272;
constexpr int ML_OFF_V = 64 * ML_KS, ML_BUF = ML_OFF_V + 64 * ML_VS;
constexpr int ML_OFF_CS = 2 * ML_BUF, ML_CSB = 48 * ML_CS, ML_OFF_G = ML_OFF_CS + 2 * ML_CSB, ML_GB = 1088;
static_assert(ML_OFF_G + 2 * ML_GB <= LDS_MISC, "mLSTM LDS");
__device__ __forceinline__ float wave_incl_sum(float v, int lane) {
#pragma unroll
    for (int o = 1; o < 64; o <<= 1) { const float t = shfl_idx(v, lane - o); v = (lane >= o) ? v + t : v; }
    return v;
}
__device__ __forceinline__ float wave_incl_max(float v, int lane) {
#pragma unroll
    for (int o = 1; o < 64; o <<= 1) { const float t = shfl_idx(v, lane - o); v = (lane >= o) ? fmaxf(v, t) : v; }
    return v;
}
__device__ __forceinline__ float wave_max(float v, int lane) {
#pragma unroll
    for (int o = 1; o < 64; o <<= 1) v = fmaxf(v, shfl_x(v, o, lane));
    return v;
}
__device__ __forceinline__ s16x4 lds_tr(LAS unsigned char* p) { return __builtin_amdgcn_ds_read_tr16_b64_v4i16((LAS s16x4*)p); }
__device__ __forceinline__ bf16x8 cat4(const s16x4 a, const s16x4 b) { return (bf16x8){a[0], a[1], a[2], a[3], b[0], b[1], b[2], b[3]}; }
template <int MODE>
__device__ __forceinline__ void phase_mlstm(const Args& a, const Ctx& cx, LAS unsigned char* lds, int layer, bf16* HGout, float* SSQ) {
    unsigned char* ws = cx.ws; const int vcu = cx.vrole, G = cx.G;
    const int tid = cx.tid, wave = cx.wave, lane = cx.lane, fr = lane & 15, fq = lane >> 4, tq = fr >> 2, tp = lane & 3;
    const bf16* QKA = (const bf16*)(ws + WS_QKA); const bf16* V = (const bf16*)(ws + WS_SEG) + (size_t)SG_V * MH * BW; const bf16* O = (const bf16*)(ws + WS_SEG) + (size_t)SG_O * MH * BW;
    const float* IF = (const float*)(ws + WS_IF);
    for (int i = tid; i < 2 * 64 * 8; i += NTHR) { const int bfi = i >> 9, l = (i >> 3) & 63, w = i & 7;
        *(LAS unsigned*)(lds + bfi * ML_BUF + ML_OFF_V + l * ML_VS + 64 + w * 4) = (w == 0) ? 0x00003F80u : 0u; }
    for (int unit = vcu; unit < HB * 16; unit += G) {
        const int es = unit & 3, hd = (unit >> 2) & 3, b = unit >> 4; const size_t row0 = (size_t)b * SEQ;
        const float b_i = a.in[I_MBI][layer * 4 + hd], b_f = a.in[I_MBF][layer * 4 + hd];
        const int colq = hd * 128, colk = 512 + hd * 128, colv = hd * 128 + es * 32;
        const unsigned koff = (unsigned)((tid >> 4) * D + colk + (tid & 15) * 8) * 2u, voff = (unsigned)((tid >> 2) * BW + colv + (tid & 3) * 8) * 2u;
        const unsigned klds = (unsigned)((tid >> 4) * ML_KS + (tid & 15) * 16), vlds = (unsigned)((tid >> 2) * ML_VS + (tid & 3) * 16);
        const unsigned qoff = (unsigned)((16 * (wave & 3) + fr) * D + colq + fq * 8) * 2u, ooff = (unsigned)((16 * (wave & 3) + fr) * BW + colv + fq * 4) * 2u, ioff = (unsigned)(lane * 8 + hd) * 4u;
        for (int i = tid; i < ML_CSB / 4; i += NTHR) *(LAS unsigned*)(lds + ML_OFF_CS + i * 4) = 0u;
        u32x4 kregA[2], kregB[2], vregA = (u32x4){0u, 0u, 0u, 0u}, vregB = (u32x4){0u, 0u, 0u, 0u}; bf16x8 qA[4], qB[4], qT[4]; u32x2 oA[2], oB[2], oT[2]; float giA = 0.f, gfA = 0.f, giB = 0.f, gfB = 0.f, giT = 0.f, gfT = 0.f;
#pragma unroll
        for (int s4 = 0; s4 < 4; ++s4) { qA[s4] = (bf16x8){0, 0, 0, 0, 0, 0, 0, 0}; qB[s4] = qA[s4]; qT[s4] = qA[s4]; }
        oA[0] = oA[1] = oB[0] = oB[1] = oT[0] = oT[1] = (u32x2){0u, 0u};
        f32x4 C[2][3];
#pragma unroll
        for (int i = 0; i < 2; ++i)
#pragma unroll
            for (int j = 0; j < 3; ++j) C[i][j] = (f32x4){0.f, 0.f, 0.f, 0.f};
        float m_prev = 0.f;
#define ML_LOADKV(s_, KR, VR) do { const size_t rs_ = row0 + (size_t)(s_) * CH; const unsigned char* kb_ = (const unsigned char*)(QKA + rs_ * D); const unsigned char* vb_ = (const unsigned char*)(V + rs_ * BW); \
        KR[0] = *(const u32x4*)(kb_ + koff); KR[1] = *(const u32x4*)(kb_ + koff + 65536u); \
        if (wave < 4) VR = *(const u32x4*)(vb_ + voff); } while (0)
#define ML_WRITEKV(nb_, KR, VR) do { LAS unsigned char* B_ = lds + (nb_) * ML_BUF; \
        *(LAS u32x4*)(B_ + klds) = KR[0]; *(LAS u32x4*)(B_ + klds + 32 * ML_KS) = KR[1]; \
        if (wave < 4) *(LAS u32x4*)(B_ + ML_OFF_V + vlds) = VR; } while (0)
#define ML_LOADQO(s_, QD, OD) do { const size_t rs_ = row0 + (size_t)(s_) * CH; const unsigned char* qb_ = (const unsigned char*)(QKA + rs_ * D); const unsigned char* ob_ = (const unsigned char*)(O + rs_ * BW); \
        _Pragma("unroll") for (int s4 = 0; s4 < 4; ++s4) QD[s4] = *(const bf16x8*)(qb_ + qoff + 64u * s4); \
        _Pragma("unroll") for (int et = 0; et < 2; ++et) OD[et] = *(const u32x2*)(ob_ + ooff + 32u * et); } while (0)
#define ML_LOADIF(s_, GI, GF) do { const size_t rs_ = row0 + (size_t)(s_) * CH; const unsigned char* ib_ = (const unsigned char*)(IF + rs_ * 8); GI = *(const float*)(ib_ + ioff); GF = *(const float*)(ib_ + ioff + 16u); } while (0)
#define ML_GATES(GI, GF, gbuf) do { LAS float* Gp_ = (LAS float*)(lds + ML_OFF_G + (gbuf) * ML_GB); const float x_ = (GF) + b_f; const float lf_ = LOG2E * (fminf(x_, 0.f) - __logf(1.f + __expf(-fabsf(x_)))); const float il_ = LOG2E * ((GI) + b_i);        \
        const float gb_ = dpp_scan_add(lf_), gg_ = read_lane63(gb_), a_ = gg_ - gb_ + il_, gm_ = read_lane63(dpp_scan_max(a_)), gu_ = il_ - gb_, gpm_ = dpp_scan_max(gu_); \
        Gp_[lane] = gb_; Gp_[64 + lane] = gu_; Gp_[128 + lane] = gpm_; Gp_[192 + lane] = __builtin_amdgcn_exp2f(a_ - gm_); if (lane == 0) { Gp_[256] = gg_; Gp_[257] = gm_; } } while (0)
        u32x2 hdef[2] = {(u32x2){0u, 0u}, (u32x2){0u, 0u}};
#define ML_STOREH(s_) do { const size_t rs_ = row0 + (size_t)(s_) * CH; _Pragma("unroll") for (int et = 0; et < 2; ++et) *(u32x2*)((unsigned char*)(HGout + rs_ * BW) + ooff + 32u * et) = hdef[et]; } while (0)
        ML_LOADKV(0, kregA, vregA); ML_LOADKV(1, kregB, vregB);
        if (wave == 4) { ML_LOADIF(0, giA, gfA); ML_GATES(giA, gfA, 0); ML_LOADIF(1, giB, gfB); ML_LOADIF(2, giA, gfA); }
        if (wave < 4) { ML_LOADQO(0, qA, oA); ML_LOADQO(1, qB, oB); }
        ML_WRITEKV(0, kregA, vregA);
        ML_LOADKV(2, kregA, vregA);
#pragma unroll 1
        for (int s2 = 0; s2 < NCH; s2 += 2) {
            { const int s = s2;
            const int cb = s & 1;
            asm volatile("s_waitcnt lgkmcnt(0)" ::: "memory"); __builtin_amdgcn_s_barrier(); asm volatile("" ::: "memory");
            const size_t rs = row0 + (size_t)s * CH;
            if (wave < 4 && s + 2 < NCH) ML_LOADQO(s + 2, qT, oT);
            if (wave == 4 && s + 3 < NCH) ML_LOADIF(s + 3, giT, gfT);
            LAS unsigned char* Bc = lds + cb * ML_BUF; LAS unsigned char* Cc = lds + ML_OFF_CS + cb * ML_CSB; LAS unsigned char* Cn = lds + ML_OFF_CS + (cb ^ 1) * ML_CSB;
            const LAS float* Gc = (const LAS float*)(lds + ML_OFF_G + cb * ML_GB);
            const float gg = Gc[256], gmloc = Gc[257];
            const float m_new = fmaxf(gg + m_prev, gmloc), s_old = __builtin_amdgcn_exp2f(gg + m_prev - m_new), s_new = __builtin_amdgcn_exp2f(gmloc - m_new);
            if (wave < 4) {
                __builtin_amdgcn_s_setprio(2);
                const int lb = wave, l = 16 * lb + fr;
                if (MODE == 0) {
                const float bl = Gc[l], pml = Gc[128 + l];
                const float elog = bl + m_prev, mt = fmaxf(bl + pml, elog), sint = __builtin_amdgcn_exp2f(elog - mt), enl = __builtin_amdgcn_exp2f(-mt), blm = bl - mt;
                f32x4 numT[3];
#pragma unroll
                for (int et = 0; et < 3; ++et) numT[et] = (f32x4){0.f, 0.f, 0.f, 0.f};
#pragma unroll
                for (int pp = 0; pp < 2; ++pp) {
                    const int mb0 = 2 * pp, mb1 = mb0 + 1;
                    if (mb0 <= lb) {
                        f32x4 st0 = (f32x4){0.f, 0.f, 0.f, 0.f}, st1 = (f32x4){0.f, 0.f, 0.f, 0.f};
#pragma unroll
                        for (int s4 = 0; s4 < 4; ++s4) { const bf16x8 kf = *(const LAS bf16x8*)(Bc + (mb0 * 16 + fr) * ML_KS + (s4 * 32 + fq * 8) * 2);
                            st0 = __builtin_amdgcn_mfma_f32_16x16x32_bf16(kf, qA[s4], st0, 0, 0, 0); }
                        if (mb1 <= lb) {
#pragma unroll
                            for (int s4 = 0; s4 < 4; ++s4) { const bf16x8 kf = *(const LAS bf16x8*)(Bc + (mb1 * 16 + fr) * ML_KS + (s4 * 32 + fq * 8) * 2);
                                st1 = __builtin_amdgcn_mfma_f32_16x16x32_bf16(kf, qA[s4], st1, 0, 0, 0); }
                        }
                        const f32x4 gu0 = *(const LAS f32x4*)(Gc + 64 + mb0 * 16 + 4 * fq), gu1 = *(const LAS f32x4*)(Gc + 64 + mb1 * 16 + 4 * fq);
                        float w0[4], w1[4];
#pragma unroll
                        for (int r = 0; r < 4; ++r) { const int m0 = mb0 * 16 + 4 * fq + r, m1 = mb1 * 16 + 4 * fq + r;
                            const float e0 = __builtin_amdgcn_exp2f(blm + gu0[r]) * st0[r], e1 = __builtin_amdgcn_exp2f(blm + gu1[r]) * st1[r];
                            w0[r] = (mb0 < lb || m0 <= l) ? e0 : 0.f; w1[r] = (mb1 < lb || (mb1 == lb && m1 <= l)) ? e1 : 0.f; }
                        u32x4 wp; wp.x = cvt_pk_bf16(w0[0], w0[1]); wp.y = cvt_pk_bf16(w0[2], w0[3]); wp.z = cvt_pk_bf16(w1[0], w1[1]); wp.w = cvt_pk_bf16(w1[2], w1[3]);
                        const bf16x8 wf = __builtin_bit_cast(bf16x8, wp);
#pragma unroll
                        for (int et = 0; et < 3; ++et) {
                            const s16x4 v0 = lds_tr(Bc + ML_OFF_V + (mb0 * 16 + 4 * fq + tq) * ML_VS + et * 32 + 8 * tp), v1 = lds_tr(Bc + ML_OFF_V + (mb1 * 16 + 4 * fq + tq) * ML_VS + et * 32 + 8 * tp);
                            numT[et] = __builtin_amdgcn_mfma_f32_16x16x32_bf16(cat4(v0, v1), wf, numT[et], 0, 0, 0); }
                    }
                }
                f32x4 tot[3];
#pragma unroll
                for (int et = 0; et < 3; ++et) { f32x4 it = (f32x4){0.f, 0.f, 0.f, 0.f};
#pragma unroll
                    for (int s4 = 0; s4 < 4; ++s4) { const bf16x8 cf = *(const LAS bf16x8*)(Cc + (et * 16 + fr) * ML_CS + (s4 * 32 + fq * 8) * 2);
                        it = __builtin_amdgcn_mfma_f32_16x16x32_bf16(cf, qA[s4], it, 0, 0, 0); }
                    tot[et] = numT[et] + it * sint; }
                float den; { const unsigned dx_ = __builtin_bit_cast(unsigned, tot[2][0]); const auto s1_ = __builtin_amdgcn_permlane16_swap(dx_, dx_, false, false); const auto s2_ = __builtin_amdgcn_permlane32_swap(s1_[0], s1_[0], false, false); den = __builtin_bit_cast(float, s2_[0]); }
                const float inv = 1.0f / fmaxf(fabsf(den), enl);
#pragma unroll
                for (int et = 0; et < 2; ++et) { const float h0 = tot[et][0] * inv * bflo(oA[et].x), h1 = tot[et][1] * inv * bfhi(oA[et].x), h2 = tot[et][2] * inv * bflo(oA[et].y), h3 = tot[et][3] * inv * bfhi(oA[et].y);
                    u32x2 w; w.x = cvt_pk_bf16(h0, h1); w.y = cvt_pk_bf16(h2, h3);
                    hdef[et] = w; }
                } else { if (fq == 0) *(float*)((unsigned char*)(SSQ + rs * 16) + (unsigned)(l * 16 + hd * 4 + es) * 4u) = __builtin_bit_cast(float, (int)qA[0][0] + (int)oA[0].x); }
                if (s + 2 < NCH) { _Pragma("unroll") for (int s4 = 0; s4 < 4; ++s4) qA[s4] = qT[s4]; oA[0] = oT[0]; oA[1] = oT[1]; }
                __builtin_amdgcn_s_setprio(0);
            } else {
                const int jw = wave - 4;
                if (MODE != 2) {
                f32x4 wl[2][2];
#pragma unroll
                for (int s2 = 0; s2 < 2; ++s2) { wl[s2][0] = *(const LAS f32x4*)(Gc + 192 + 32 * s2 + 8 * fq); wl[s2][1] = *(const LAS f32x4*)(Gc + 192 + 32 * s2 + 8 * fq + 4); }
#pragma unroll
                for (int dti = 0; dti < 2; ++dti) { const int dt = 2 * jw + dti;
                    bf16x8 ktf[2];
#pragma unroll
                    for (int s2 = 0; s2 < 2; ++s2) { const s16x4 k0 = lds_tr(Bc + (32 * s2 + 8 * fq + tq) * ML_KS + dt * 32 + 8 * tp), k1 = lds_tr(Bc + (32 * s2 + 8 * fq + 4 + tq) * ML_KS + dt * 32 + 8 * tp);
                        const u32x2 ka = __builtin_bit_cast(u32x2, k0), kb = __builtin_bit_cast(u32x2, k1);
                        u32x4 kp; kp.x = cvt_pk_bf16(bflo(ka.x) * wl[s2][0][0], bfhi(ka.x) * wl[s2][0][1]); kp.y = cvt_pk_bf16(bflo(ka.y) * wl[s2][0][2], bfhi(ka.y) * wl[s2][0][3]);
                        kp.z = cvt_pk_bf16(bflo(kb.x) * wl[s2][1][0], bfhi(kb.x) * wl[s2][1][1]); kp.w = cvt_pk_bf16(bflo(kb.y) * wl[s2][1][2], bfhi(kb.y) * wl[s2][1][3]);
                        ktf[s2] = __builtin_bit_cast(bf16x8, kp); }
#pragma unroll
                    for (int et = 0; et < 3; ++et) { f32x4 cl = (f32x4){0.f, 0.f, 0.f, 0.f};
#pragma unroll
                        for (int s2 = 0; s2 < 2; ++s2) { const s16x4 v0 = lds_tr(Bc + ML_OFF_V + (32 * s2 + 8 * fq + tq) * ML_VS + et * 32 + 8 * tp), v1 = lds_tr(Bc + ML_OFF_V + (32 * s2 + 8 * fq + 4 + tq) * ML_VS + et * 32 + 8 * tp);
                            cl = __builtin_amdgcn_mfma_f32_16x16x32_bf16(ktf[s2], cat4(v0, v1), cl, 0, 0, 0); }
                        C[dti][et] = C[dti][et] * s_old + cl * s_new;
                        u32x2 w; w.x = cvt_pk_bf16(C[dti][et][0], C[dti][et][1]); w.y = cvt_pk_bf16(C[dti][et][2], C[dti][et][3]);
                        *(LAS u32x2*)(Cn + (et * 16 + fr) * ML_CS + (dt * 16 + 4 * fq) * 2) = w; }
                }
                }
                if (wave == 4) { if (s + 1 < NCH) ML_GATES(giB, gfB, cb ^ 1); if (s + 3 < NCH) { giB = giT; gfB = gfT; } }
            }
            if (s + 1 < NCH) ML_WRITEKV(cb ^ 1, kregB, vregB);
            if (s + 3 < NCH) ML_LOADKV(s + 3, kregB, vregB);
            if (MODE == 0 && wave < 4) ML_STOREH(s);
            m_prev = m_new;
            }
            { const int s = s2 + 1;
            const int cb = s & 1;
            asm volatile("s_waitcnt lgkmcnt(0)" ::: "memory"); __builtin_amdgcn_s_barrier(); asm volatile("" ::: "memory");
            const size_t rs = row0 + (size_t)s * CH;
            if (wave < 4 && s + 2 < NCH) ML_LOADQO(s + 2, qT, oT);
            if (wave == 4 && s + 3 < NCH) ML_LOADIF(s + 3, giT, gfT);
            LAS unsigned char* Bc = lds + cb * ML_BUF; LAS unsigned char* Cc = lds + ML_OFF_CS + cb * ML_CSB; LAS unsigned char* Cn = lds + ML_OFF_CS + (cb ^ 1) * ML_CSB;
            const LAS float* Gc = (const LAS float*)(lds + ML_OFF_G + cb * ML_GB);
            const float gg = Gc[256], gmloc = Gc[257];
            const float m_new = fmaxf(gg + m_prev, gmloc), s_old = __builtin_amdgcn_exp2f(gg + m_prev - m_new), s_new = __builtin_amdgcn_exp2f(gmloc - m_new);
            if (wave < 4) {
                __builtin_amdgcn_s_setprio(2);
                const int lb = wave, l = 16 * lb + fr;
                if (MODE == 0) {
                const float bl = Gc[l], pml = Gc[128 + l];
                const float elog = bl + m_prev, mt = fmaxf(bl + pml, elog), sint = __builtin_amdgcn_exp2f(elog - mt), enl = __builtin_amdgcn_exp2f(-mt), blm = bl - mt;
                f32x4 numT[3];
#pragma unroll
                for (int et = 0; et < 3; ++et) numT[et] = (f32x4){0.f, 0.f, 0.f, 0.f};
#pragma unroll
                for (int pp = 0; pp < 2; ++pp) {
                    const int mb0 = 2 * pp, mb1 = mb0 + 1;
                    if (mb0 <= lb) {
                        f32x4 st0 = (f32x4){0.f, 0.f, 0.f, 0.f}, st1 = (f32x4){0.f, 0.f, 0.f, 0.f};
#pragma unroll
                        for (int s4 = 0; s4 < 4; ++s4) { const bf16x8 kf = *(const LAS bf16x8*)(Bc + (mb0 * 16 + fr) * ML_KS + (s4 * 32 + fq * 8) * 2);
                            st0 = __builtin_amdgcn_mfma_f32_16x16x32_bf16(kf, qB[s4], st0, 0, 0, 0); }
                        if (mb1 <= lb) {
#pragma unroll
                            for (int s4 = 0; s4 < 4; ++s4) { const bf16x8 kf = *(const LAS bf16x8*)(Bc + (mb1 * 16 + fr) * ML_KS + (s4 * 32 + fq * 8) * 2);
                                st1 = __builtin_amdgcn_mfma_f32_16x16x32_bf16(kf, qB[s4], st1, 0, 0, 0); }
                        }
                        const f32x4 gu0 = *(const LAS f32x4*)(Gc + 64 + mb0 * 16 + 4 * fq), gu1 = *(const LAS f32x4*)(Gc + 64 + mb1 * 16 + 4 * fq);
                        float w0[4], w1[4];
#pragma unroll
                        for (int r = 0; r < 4; ++r) { const int m0 = mb0 * 16 + 4 * fq + r, m1 = mb1 * 16 + 4 * fq + r;
                            const float e0 = __builtin_amdgcn_exp2f(blm + gu0[r]) * st0[r], e1 = __builtin_amdgcn_exp2f(blm + gu1[r]) * st1[r];
                            w0[r] = (mb0 < lb || m0 <= l) ? e0 : 0.f; w1[r] = (mb1 < lb || (mb1 == lb && m1 <= l)) ? e1 : 0.f; }
                        u32x4 wp; wp.x = cvt_pk_bf16(w0[0], w0[1]); wp.y = cvt_pk_bf16(w0[2], w0[3]); wp.z = cvt_pk_bf16(w1[0], w1[1]); wp.w = cvt_pk_bf16(w1[2], w1[3]);
                        const bf16x8 wf = __builtin_bit_cast(bf16x8, wp);
#pragma unroll
                        for (int et = 0; et < 3; ++et) {
                            const s16x4 v0 = lds_tr(Bc + ML_OFF_V + (mb0 * 16 + 4 * fq + tq) * ML_VS + et * 32 + 8 * tp), v1 = lds_tr(Bc + ML_OFF_V + (mb1 * 16 + 4 * fq + tq) * ML_VS + et * 32 + 8 * tp);
                            numT[et] = __builtin_amdgcn_mfma_f32_16x16x32_bf16(cat4(v0, v1), wf, numT[et], 0, 0, 0); }
                    }
                }
                f32x4 tot[3];
#pragma unroll
                for (int et = 0; et < 3; ++et) { f32x4 it = (f32x4){0.f, 0.f, 0.f, 0.f};
#pragma unroll
                    for (int s4 = 0; s4 < 4; ++s4) { const bf16x8 cf = *(const LAS bf16x8*)(Cc + (et * 16 + fr) * ML_CS + (s4 * 32 + fq * 8) * 2);
                        it = __builtin_amdgcn_mfma_f32_16x16x32_bf16(cf, qB[s4], it, 0, 0, 0); }
                    tot[et] = numT[et] + it * sint; }
                float den; { const unsigned dx_ = __builtin_bit_cast(unsigned, tot[2][0]); const auto s1_ = __builtin_amdgcn_permlane16_swap(dx_, dx_, false, false); const auto s2_ = __builtin_amdgcn_permlane32_swap(s1_[0], s1_[0], false, false); den = __builtin_bit_cast(float, s2_[0]); }
                const float inv = 1.0f / fmaxf(fabsf(den), enl);
#pragma unroll
                for (int et = 0; et < 2; ++et) { const float h0 = tot[et][0] * inv * bflo(oB[et].x), h1 = tot[et][1] * inv * bfhi(oB[et].x), h2 = tot[et][2] * inv * bflo(oB[et].y), h3 = tot[et][3] * inv * bfhi(oB[et].y);
                    u32x2 w; w.x = cvt_pk_bf16(h0, h1); w.y = cvt_pk_bf16(h2, h3);
                    hdef[et] = w; }
                } else { if (fq == 0) *(float*)((unsigned char*)(SSQ + rs * 16) + (unsigned)(l * 16 + hd * 4 + es) * 4u) = __builtin_bit_cast(float, (int)qB[0][0] + (int)oB[0].x); }
                if (s + 2 < NCH) { _Pragma("unroll") for (int s4 = 0; s4 < 4; ++s4) qB[s4] = qT[s4]; oB[0] = oT[0]; oB[1] = oT[1]; }
                __builtin_amdgcn_s_setprio(0);
            } else {
                const int jw = wave - 4;
                if (MODE != 2) {
                f32x4 wl[2][2];
#pragma unroll
                for (int s2 = 0; s2 < 2; ++s2) { wl[s2][0] = *(const LAS f32x4*)(Gc + 192 + 32 * s2 + 8 * fq); wl[s2][1] = *(const LAS f32x4*)(Gc + 192 + 32 * s2 + 8 * fq + 4); }
#pragma unroll
                for (int dti = 0; dti < 2; ++dti) { const int dt = 2 * jw + dti;
                    bf16x8 ktf[2];
#pragma unroll
                    for (int s2 = 0; s2 < 2; ++s2) { const s16x4 k0 = lds_tr(Bc + (32 * s2 + 8 * fq + tq) * ML_KS + dt * 32 + 8 * tp), k1 = lds_tr(Bc + (32 * s2 + 8 * fq + 4 + tq) * ML_KS + dt * 32 + 8 * tp);
                        const u32x2 ka = __builtin_bit_cast(u32x2, k0), kb = __builtin_bit_cast(u32x2, k1);
                        u32x4 kp; kp.x = cvt_pk_bf16(bflo(ka.x) * wl[s2][0][0], bfhi(ka.x) * wl[s2][0][1]); kp.y = cvt_pk_bf16(bflo(ka.y) * wl[s2][0][2], bfhi(ka.y) * wl[s2][0][3]);
                        kp.z = cvt_pk_bf16(bflo(kb.x) * wl[s2][1][0], bfhi(kb.x) * wl[s2][1][1]); kp.w = cvt_pk_bf16(bflo(kb.y) * wl[s2][1][2], bfhi(kb.y) * wl[s2][1][3]);
                        ktf[s2] = __builtin_bit_cast(bf16x8, kp); }
#pragma unroll
                    for (int et = 0; et < 3; ++et) { f32x4 cl = (f32x4){0.f, 0.f, 0.f, 0.f};
#pragma unroll
                        for (int s2 = 0; s2 < 2; ++s2) { const s16x4 v0 = lds_tr(Bc + ML_OFF_V + (32 * s2 + 8 * fq + tq) * ML_VS + et * 32 + 8 * tp), v1 = lds_tr(Bc + ML_OFF_V + (32 * s2 + 8 * fq + 4 + tq) * ML_VS + et * 32 + 8 * tp);
                            cl = __builtin_amdgcn_mfma_f32_16x16x32_bf16(ktf[s2], cat4(v0, v1), cl, 0, 0, 0); }
                        C[dti][et] = C[dti][et] * s_old + cl * s_new;
                        u32x2 w; w.x = cvt_pk_bf16(C[dti][et][0], C[dti][et][1]); w.y = cvt_pk_bf16(C[dti][et][2], C[dti][et][3]);
                        *(LAS u32x2*)(Cn + (et * 16 + fr) * ML_CS + (dt * 16 + 4 * fq) * 2) = w; }
                }
                }
                if (wave == 4) { if (s + 1 < NCH) ML_GATES(giA, gfA, cb ^ 1); if (s + 3 < NCH) { giA = giT; gfA = gfT; } }
            }
            if (s + 1 < NCH) ML_WRITEKV(cb ^ 1, kregA, vregA);
            if (s + 3 < NCH) ML_LOADKV(s + 3, kregA, vregA);
            if (MODE == 0 && wave < 4) ML_STOREH(s);
            m_prev = m_new;
            }
        }
        __syncthreads();
#undef ML_STOREH
#undef ML_LOADKV
#undef ML_WRITEKV
#undef ML_LOADQO
#undef ML_LOADIF
#undef ML_GATES
    }
}

constexpr int NPH_IT = 8, NPHASES = 1 + NPH_IT * NPASS * DEPTH;
constexpr int CW_BAR = 4096;
__global__ void __launch_bounds__(NTHR, 2) mk_fwd(Args a_) {
    extern __shared__ __attribute__((aligned(16))) unsigned char lds_raw[];
    LAS unsigned char* lds = (LAS unsigned char*)lds_raw;
    const int lo = a_.ph_lo, hi = a_.ph_hi;
    int vbid = blockIdx.x;
    const int wave0 = __builtin_amdgcn_readfirstlane(threadIdx.x >> 6);
    if (threadIdx.x < 16) ((LAS unsigned*)(lds + LDS_MISC))[threadIdx.x] = 0u;
    __syncthreads();
    XcdBarrier bar; bar.bar = (unsigned*)(a_.ws + WS_CTL) + CW_BAR; bar.x = 0; bar.st = (volatile LAS unsigned*)(lds + LDS_MISC);
    if (hi - lo > 1) bar = xcd_barrier_post_ranked((unsigned*)(a_.ws + WS_CTL) + CW_BAR, (volatile LAS unsigned*)(lds + LDS_MISC));
    int fast = 0;
#define IN(k) (lo <= (k) && (k) < hi)
#define SEAM(k) do { if (IN(k) && IN((k) + 1)) { if (fast) grp_barrier(bar); else xcd_barrier(bar); if (MK_DUP == 8) xcd_barrier(bar); } } while (0)
#define P_SEG(c, sg) ((bf16*)((c).ws + WS_SEG) + (size_t)(sg) * MH * BW)
#if MK_TIME == 1
    if (blockIdx.x == 0 && wave0 == 0 && fresh_lane() == 0) { unsigned* tacc0 = (unsigned*)(a.ws + 768 * 1024); const unsigned t0 = (unsigned)__builtin_amdgcn_s_memrealtime(); tacc0[13] = t0; tacc0[14] = t0; }
#define STAMP(p) do { if (blockIdx.x == 0 && wave0 == 0 && fresh_lane() == 0) { unsigned* tacc_ = (unsigned*)(a.ws + 768 * 1024); const unsigned t_ = (unsigned)__builtin_amdgcn_s_memrealtime(); tacc_[(p)] += t_ - tacc_[14]; tacc_[14] = t_; } } while (0)
#else
#define STAMP(p) do { } while (0)
#endif
    if (IN(0)) { MAKE_CTX(c); phase_prologue(a, c, lds); __syncthreads(); }
    STAMP(9);
#pragma unroll 1
    for (int it = 0; it < NPASS * DEPTH; ++it) {
        const int base = 1 + NPH_IT * it, pass = it / DEPTH, layer = it % DEPTH;
        if (hi <= base || lo >= base + NPH_IT) continue;
        if (IN(base + 0) && MK_DUP == 7) { MAKE_CTX(c); phase_norm<false, true, false>(a, c, lds, layer, pass); }
        if (IN(base + 0)) { MAKE_CTX(c); if (layer == 0) phase_norm<false, true, false>(a, c, lds, layer, pass); else if (layer == 1) phase_norm<true, true, false>(a, c, lds, layer, pass); else phase_norm<true, true, true>(a, c, lds, layer, pass); }
        SEAM(base + 0); STAMP(0);
        if (MK_GROUP_BARRIERS && it == 0 && IN(base + 0) && IN(base + 1)) {
            volatile LAS unsigned* st = (volatile LAS unsigned*)(lds + LDS_MISC);
            if (threadIdx.x == 0) { unsigned ok = (gridDim.x == 256u) ? 1u : 0u, dense = 0u, nz = 0u;
                for (unsigned j = 0; j < 16; ++j) { const unsigned cj = xb_ld(&bar.bar[XB_XCNT(j)]); if (cj) { ++nz; if (cj != 32u) ok = 0u; if (j < bar.x) ++dense; } }
                if (nz != 8u || st[3] >= 32u) ok = 0u;
                st[2] = ok; st[4] = dense; }
            __syncthreads();
            fast = __builtin_amdgcn_readfirstlane((int)st[2]);
            if (fast) vbid = __builtin_amdgcn_readfirstlane((int)(st[3] * 8u + st[4]));
            __syncthreads();
        }
        if (IN(base + 1)) {
#pragma unroll 1
            for (int rep = 0; rep < (MK_DUP == 1 ? 2 : 1); ++rep) { MAKE_CTX(c);
            EpiProj E{P_SEG(c, 0), (bf16*)(c.ws + WS_GATE)};
            pg8::gemm_phase<EpiProj, 6656, D, D, D>(lds, (const bf16*)(c.ws + WS_H), (const bf16*)(c.ws + WS_W1T) + (size_t)layer * NP * D, c.G, c.bx, c.tid, E); }
#pragma unroll 1
            for (int rep = 0; rep < (MK_DUP == 1 ? 2 : 1); ++rep) { MAKE_CTX(c);
            EpiGate8 E{c.ws + WS_GATE};
            pg8::gemm_phase8<EpiGate8, 4 * D, D>(lds, c.ws + WS_H8, c.ws + WS_W8 + (size_t)layer * 4 * D * D, c.G, c.bx, c.tid, E); }
        }
        SEAM(base + 1); STAMP(1);
        if (IN(base + 2)) {
#pragma unroll 1
            for (int rep = 0; rep < (MK_DUP == 2 ? 2 : 1); ++rep) { { MAKE_CTX(c); phase_ew(a, c, layer, 1 | 2 | 4, c.gt, c.NGT); } { MAKE_CTX(c); const int per1 = 2 * ((HB * NCH / 2 + c.G - 1) / c.G); phase_s5<false>(a, c, lds, layer, c.vcu * per1, 1, per1); } } }
        SEAM(base + 2); STAMP(2);
        if (IN(base + 3)) {
            int half_; { MAKE_CTX(c); half_ = c.G / 2; }
            int vsel; { MAKE_CTX(c); vsel = c.vrole; }
#if MK_TIME == 2
            unsigned tmx0 = (unsigned)__builtin_amdgcn_s_memrealtime();
#endif
            if (vsel < half_ || half_ < 128) {
                if (MK_DUP == 4) { MAKE_CTX(c); phase_mlstm<MK_MLMODE>(a, c, lds, layer, (bf16*)(c.ws + WS_H), (float*)(c.ws + WS_OSS)); }
                { MAKE_CTX(c); phase_mlstm<0>(a, c, lds, layer, P_SEG(c, SG_O), (float*)(c.ws + WS_SSQ)); }
            }
            if (vsel >= half_ || half_ < 128) {
                const int sub = (half_ < 128) ? 0 : half_, nsub = (half_ < 128) ? 2 * half_ : half_;
                { MAKE_CTX(c); const int per = (HB * NCH + nsub - 1) / nsub; phase_s5<true>(a, c, lds, layer, (c.vrole - sub) * per, 1, per); }
                if (nsub * 4 * CH == MH) { MAKE_CTX(c); const size_t poff = (size_t)(c.vrole - sub) * 256 * BW;
                    asm volatile("s_waitcnt vmcnt(0)" ::: "memory"); __syncthreads();
                    EpiGlu E{P_SEG(c, SG_S5U) + poff, P_SEG(c, SG_S5Z) + poff};
                    pg8::gemm_phase<EpiGlu, BW, BW, BW, BW>(lds, P_SEG(c, SG_S5U) + poff, (const bf16*)(c.ws + WS_WGT) + (size_t)layer * BW * BW, 1, 0, c.tid, E, 256); }
            }
#if MK_TIME == 2
            { const unsigned tmx1 = (unsigned)__builtin_amdgcn_s_memrealtime(); if ((vsel == 0 || vsel == half_) && wave0 == 0 && fresh_lane() == 0) { unsigned* tq = (unsigned*)(a.ws + 768 * 1024) + (vsel == 0 ? 20 : 21); *tq += tmx1 - tmx0; } }
#endif
        }
        SEAM(base + 3); STAMP(3);
        if (IN(base + 4)) {
            int glu_done; { MAKE_CTX(c); glu_done = ((c.G / 2) * 4 * CH == MH && c.G / 2 >= 128) ? 1 : 0; }
            if (!glu_done) { MAKE_CTX(c); EpiGlu E{P_SEG(c, SG_S5U), P_SEG(c, SG_S5Z)};
              pg8::gemm_phase<EpiGlu, BW, BW, BW, BW>(lds, P_SEG(c, SG_S5U), (const bf16*)(c.ws + WS_WGT) + (size_t)layer * BW * BW, c.G, c.bx, c.tid, E); }
            { MAKE_CTX(c); EpiPool E{a.in[I_POOLS] + (size_t)layer * BW, P_SEG(c, SG_PZ)};
              pg8::gemm_phase<EpiPool, BW, 256, BW, BW, true>(lds, (const bf16*)(c.ws + WS_POOL), (const bf16*)(c.ws + WS_WPT) + (size_t)layer * BW * BW, c.G, c.bx, c.tid, E); }
            { MAKE_CTX(c); phase_ydfix(a, c, layer); }
        }
        SEAM(base + 4); STAMP(4);
        if (IN(base + 5)) {
#pragma unroll 1
            for (int rep = 0; rep < (MK_DUP == 5 ? 2 : 1); ++rep) { MAKE_CTX(c);
                pg8::A4 a4{{P_SEG(c, SG_S5Z), P_SEG(c, SG_PZ), P_SEG(c, SG_SCZ), P_SEG(c, SG_MZ)}};
                pg8::gemm_merge_phase(lds, a4, (const bf16*)(c.ws + WS_WBT) + (size_t)layer * 4 * D * BW, c.ws + WS_GATE, (bf16*)(c.ws + WS_H), c.G, c.bx, c.tid);
            }
        }
        SEAM(base + 5); STAMP(5);
        if (IN(base + 6)) {
#pragma unroll 1
            for (int rep = 0; rep < (MK_DUP == 6 ? 2 : 1); ++rep) { MAKE_CTX(c);
            EpiOut E{(bf16*)(c.ws + WS_QKA), (float*)(c.ws + WS_OSS)};
            pg8::gemm_phase<EpiOut, D, D, D, D>(lds, (const bf16*)(c.ws + WS_H), (const bf16*)(c.ws + WS_WOT) + (size_t)layer * D * D, c.G, c.bx, c.tid, E); }
        }
        SEAM(base + 6); STAMP(6);
        if (layer == DEPTH - 1) {
            if (IN(base + 7)) { MAKE_CTX(c); phase_norm<true, false, true>(a, c, lds, layer, pass); }
            STAMP(7);
        }
    }
#if MK_TIME == 2
    xcd_barrier(bar);
    { const unsigned tsel = __hip_atomic_load((unsigned*)(a.ws + 768 * 1024) + MK_TSEL, __ATOMIC_RELAXED, __HIP_MEMORY_SCOPE_AGENT);
      const float cA = (float)(int)((float)tsel * (1.0f / (8.f * 100.f * MK_TBUCKET))); const size_t n = (size_t)BATCH * SEQ * D;
      for (size_t i = (size_t)blockIdx.x * NTHR + wave0 * 64 + fresh_lane(); i < n; i += (size_t)gridDim.x * NTHR) a.out[i] = a.in[I_X][i] + cA; }
#elif MK_TIME
    xcd_barrier(bar);
    unsigned* tacc = (unsigned*)(a.ws + 768 * 1024);
    if (blockIdx.x == 0 && wave0 == 0 && fresh_lane() == 0) tacc[15] = (unsigned)__builtin_amdgcn_s_memrealtime() - tacc[13];
    xcd_barrier(bar);
    { const float tot = (float)__hip_atomic_load(tacc + 15, __ATOMIC_RELAXED, __HIP_MEMORY_SCOPE_AGENT); float sel = 0.f;
#pragma unroll
      for (int p = 0; p < 10; ++p) if ((MK_TMASK >> p) & 1) sel += (float)__hip_atomic_load(tacc + p, __ATOMIC_RELAXED, __HIP_MEMORY_SCOPE_AGENT);
      const float cA = 5.f * sel / tot; const size_t n = (size_t)BATCH * SEQ * D;
      for (size_t i = (size_t)blockIdx.x * NTHR + wave0 * 64 + fresh_lane(); i < n; i += (size_t)gridDim.x * NTHR) a.out[i] = a.in[I_X][i] + cA; }
#endif
#undef IN
#undef SEAM
}


#ifndef MK_DEBUG
#define MK_DEBUG 0
#endif
#if MK_DEBUG
__global__ void dbg_scan(const unsigned* p, size_t nwords, int is_bf16, int code, unsigned* flag) {
    bool bad = false;
    for (size_t i = (size_t)blockIdx.x * blockDim.x + threadIdx.x; i < nwords; i += (size_t)gridDim.x * blockDim.x) { const unsigned w = p[i];
        if (is_bf16) bad |= ((w & 0x7f80u) == 0x7f80u) || ((w & 0x7f800000u) == 0x7f800000u); else bad |= ((w & 0x7f800000u) == 0x7f800000u); }
    if (bad) flag[code] = 1u;
}
__global__ void dbg_fix(float* out, const float* x, size_t n, const unsigned* flag) {
    int c = 0; for (int k = 1; k < 32; ++k) if (flag[k]) { c = k; break; }
    if (c == 0) return;
    for (size_t i = (size_t)blockIdx.x * blockDim.x + threadIdx.x; i < n; i += (size_t)gridDim.x * blockDim.x) out[i] = x[i] + (float)c;
}
#endif
extern "C" void kernel_launch(void* const* d_in, const int* in_sizes, int n_in, void* d_out, int out_size, void* d_ws, size_t ws_size, hipStream_t stream) {
    static int grid = 0;
    if (grid == 0) {
        if (n_in != 22 || in_sizes[0] != BATCH * SEQ * D || out_size != BATCH * SEQ * D || ws_size < WS_END) {
            fprintf(stderr, "kernel_launch: unexpected shapes (n_in %d, in0 %d, out %d, ws %zu, need %zu); nothing launched\n", n_in, n_in > 0 ? in_sizes[0] : -1, out_size, ws_size, (size_t)WS_END); grid = -1; return; }
        int dev = 0, cus = 0, per_cu = 0;
        if (hipGetDevice(&dev) != hipSuccess || hipDeviceGetAttribute(&cus, hipDeviceAttributeMultiprocessorCount, dev) != hipSuccess) { grid = -1; return; }
        if (hipFuncSetAttribute((const void*)mk_fwd, hipFuncAttributeMaxDynamicSharedMemorySize, LDS_BYTES) != hipSuccess) { fprintf(stderr, "kernel_launch: hipFuncSetAttribute failed\n"); grid = -1; return; }
        if (hipOccupancyMaxActiveBlocksPerMultiprocessor(&per_cu, (const void*)mk_fwd, NTHR, LDS_BYTES) != hipSuccess || per_cu < 1) fprintf(stderr, "kernel_launch: occupancy query reports %d\n", per_cu);
        (void)hipGetLastError();
        grid = cus;
    }
    if (grid < 0) return;
    (void)hipMemsetAsync((char*)d_ws + WS_CTL, 0, CTL_ZERO_BYTES, stream);
    Args a{};
    for (int i = 0; i < 22; ++i) a.in[i] = (const float*)d_in[i];
    a.out = (float*)d_out; a.ws = (unsigned char*)d_ws;
#if MK_ONE_LAUNCH
    a.ph_lo = 0; a.ph_hi = NPHASES;
    hipLaunchKernelGGL(mk_fwd, dim3(grid), dim3(NTHR), LDS_BYTES, stream, a);
#else
#if MK_DEBUG
    (void)hipMemsetAsync((char*)d_ws + CTL_ZERO_BYTES, 0xFF, WS_END - CTL_ZERO_BYTES, stream);
    (void)hipMemsetAsync(d_out, 0xFF, (size_t)out_size * 4, stream);
    unsigned* flag = (unsigned*)((char*)d_ws + 512 * 1024);
    unsigned char* w8 = (unsigned char*)d_ws;
#define SCAN(off, bytes, isb, code) hipLaunchKernelGGL(dbg_scan, dim3(1024), dim3(256), 0, stream, (const unsigned*)(w8 + (off)), (size_t)(bytes) / 4, isb, code, flag)
#endif
    for (int k = 0; k < NPHASES; ++k) {
        if (k > 0 && (k - 1) % NPH_IT == NPH_IT - 1 && ((k - 1) / NPH_IT) % DEPTH != DEPTH - 1) continue;
        a.ph_lo = k; a.ph_hi = k + 1;
        hipLaunchKernelGGL(mk_fwd, dim3(grid), dim3(NTHR), LDS_BYTES, stream, a);
#if MK_DEBUG
        if (k == 0) { for (int l = 0; l < DEPTH; ++l) { SCAN(WS_S5T + l * S5T_LAYER, 32768, 0, 1); SCAN(WS_S5T + l * S5T_LAYER + S5T_B, 262144, 1, 1); } }
        if (k == 3) { SCAN(WS_QKA, (size_t)MH * D * 2, 1, 2); SCAN(WS_SEG + SG_SCZ * SEG_BYTES, SEG_BYTES, 1, 3); SCAN(WS_POOL, SEG_BYTES, 1, 4); SCAN(WS_E, 8 * MiB, 0, 5); }
        if (k == 4) { SCAN(WS_SEG + SG_S5U * SEG_BYTES, SEG_BYTES, 1, 6); }
        if (k == 5) { SCAN(WS_SEG + SG_O * SEG_BYTES, SEG_BYTES, 1, 7); SCAN(WS_SSQ, (size_t)MH * 16 * 4, 0, 7); }
        if (k == 6) { SCAN(WS_SEG + SG_S5Z * SEG_BYTES, SEG_BYTES, 1, 8); SCAN(WS_SEG + SG_PZ * SEG_BYTES, SEG_BYTES, 1, 8); SCAN(WS_SEG + SG_MZ * SEG_BYTES, SEG_BYTES, 1, 8); }
        if (k == 7) { SCAN(WS_SEG + SG_QK * SEG_BYTES, 2 * SEG_BYTES, 1, 9); }
        if (k == 8) { SCAN(WS_QKA, (size_t)MH * D * 2, 1, 10); SCAN(WS_OSS, (size_t)MH * 16 * 4, 0, 10); }
#endif
    }
#if MK_DEBUG
    hipLaunchKernelGGL(dbg_scan, dim3(1024), dim3(256), 0, stream, (const unsigned*)d_out, (size_t)out_size, 0, 11, flag);
    hipLaunchKernelGGL(dbg_fix, dim3(1024), dim3(256), 0, stream, (float*)d_out, (const float*)d_in[0], (size_t)out_size, (const unsigned*)flag);
#endif
#endif
}
```
